# Optimizing an MI355X kernel written in HIP

```python
import math
import jax, jax.numpy as jnp
from jax import lax
import numpy as np

D_MODEL = 1024
BATCH = 8
SEQ = 2048
DEPTH = 2
DEC_BATCH = 128
DEC_SEQ = 1
PAST_LEN = 16384
PAGE_SIZE = 128

F32 = jnp.float32
EPS = 1e-6
CHUNK = 64
DN_HEADS = 4
DN_DK = 128
DN_DV = 128
CONV_W = 4
GLA_HEADS = 4
GLA_DK = 64
GLA_DV = 128
GLA_RANK = 16
GLA_TAU = 16.0
RW_HEADS = 8
RW_N = 64
RW_DECAY_RANK = 64
RW_A_RANK = 64
RW_LN_EPS = 64e-5

DN_QK = DN_HEADS * DN_DK
DN_V = DN_HEADS * DN_DV
DN_CONV_DIM = 2 * DN_QK + DN_V
GLA_QK = GLA_HEADS * GLA_DK
GLA_V = GLA_HEADS * GLA_DV
RW_C = RW_HEADS * RW_N
RW_SHIFT_DIM = 3 * RW_C + RW_DECAY_RANK + RW_A_RANK
D_MIX = DN_V + GLA_V + RW_C
DN_PROJ = DN_CONV_DIM + DN_V + 2 * DN_HEADS
GLA_PROJ = 2 * GLA_QK + 2 * GLA_V + GLA_RANK
RW_PROJ = RW_SHIFT_DIM + RW_C
D_PROJ = DN_PROJ + GLA_PROJ + RW_PROJ

kernel_name = 'hybrid_deltanet_gla_rwkv7_decoder_step'


def rmsnorm(x, g, eps=EPS):
    xf = x.astype(F32)
    return xf * lax.rsqrt(jnp.mean(xf * xf, axis=-1, keepdims=True) + eps) * g.astype(F32)


def l2norm(x, eps=EPS):
    return x * lax.rsqrt(jnp.sum(x * x, axis=-1, keepdims=True) + eps)


def _chunkify(x, C):
    B, T = x.shape[:2]
    n = -(-T // C)
    x = jnp.pad(x, [(0, 0), (0, n * C - T)] + [(0, 0)] * (x.ndim - 2))
    x = x.reshape((B, n, C) + x.shape[2:])
    return jnp.swapaxes(jnp.moveaxis(x, 1, 0), 2, 3)


def _unchunk(o, T):
    o = jnp.moveaxis(jnp.swapaxes(o, 2, 3), 0, 1)
    B, n, C = o.shape[:3]
    return o.reshape((B, n * C) + o.shape[3:])[:, :T]


def gated_delta_rule(q, k, v, beta, g, S0):
    T = q.shape[1]
    C = min(CHUNK, T)
    causal = jnp.tril(jnp.ones((C, C), bool))
    strict = jnp.tril(jnp.ones((C, C), bool), -1)
    eye = jnp.eye(C, dtype=F32)

    def step(S, inp):
        q_, k_, v_, b_, g_ = inp
        G = jnp.cumsum(g_, axis=-1)
        decay = jnp.exp(jnp.where(causal, G[..., :, None] - G[..., None, :], -jnp.inf))
        kb = k_ * b_[..., None]
        L = jnp.where(strict, jnp.einsum('bhik,bhjk->bhij', kb, k_) * decay, 0.0)
        rhs = jnp.concatenate([v_ * b_[..., None], kb * jnp.exp(G)[..., None]], axis=-1)
        sol = lax.linalg.triangular_solve(L + eye, rhs, left_side=True, lower=True, unit_diagonal=True)
        u, w = sol[..., :DN_DV], sol[..., DN_DV:]
        v_new = u - jnp.einsum('bhck,bhkv->bhcv', w, S)
        A = jnp.einsum('bhik,bhjk->bhij', q_, k_) * decay
        o = (jnp.einsum('bhck,bhkv->bhcv', q_ * jnp.exp(G)[..., None], S)
             + jnp.einsum('bhij,bhjv->bhiv', A, v_new))
        G_last = G[..., -1]
        S = (S * jnp.exp(G_last)[..., None, None]
             + jnp.einsum('bhck,bhcv->bhkv', k_ * jnp.exp(G_last[..., None] - G)[..., None], v_new))
        return S, o

    xs = tuple(_chunkify(a, C) for a in (q, k, v, beta, g))
    S, o = lax.scan(step, S0.astype(F32), xs)
    return _unchunk(o, T), S


def gla_chunked(q, k, v, lf, S0):
    T = q.shape[1]
    C = min(CHUNK, T)
    causal = jnp.tril(jnp.ones((C, C), bool))

    def step(S, inp):
        q_, k_, v_, f_ = inp
        G = jnp.cumsum(f_, axis=2)
        diff = G[:, :, :, None, :] - G[:, :, None, :, :]
        rel = jnp.exp(jnp.where(causal[:, :, None], diff, -jnp.inf))
        A = jnp.einsum('bhik,bhjk,bhijk->bhij', q_, k_, rel)
        o = (jnp.einsum('bhik,bhkv->bhiv', q_ * jnp.exp(G), S)
             + jnp.einsum('bhij,bhjv->bhiv', A, v_))
        G_last = G[:, :, -1:]
        S = (S * jnp.exp(G_last[:, :, 0])[..., None]
             + jnp.einsum('bhjk,bhjv->bhkv', k_ * jnp.exp(G_last - G), v_))
        return S, o

    xs = tuple(_chunkify(a, C) for a in (q, k, v, lf))
    S, o = lax.scan(step, S0.astype(F32), xs)
    return _unchunk(o, T), S


def rwkv7_scan(r, w, k, v, kk, a, S0):
    def step(S, inp):
        r_, w_, k_, v_, kk_, a_ = inp
        Skk = jnp.einsum('bhvk,bhk->bhv', S, kk_)
        S = (S * w_[:, :, None, :] - Skk[..., None] * (kk_ * a_)[:, :, None, :]
             + v_[..., None] * k_[:, :, None, :])
        return S, jnp.einsum('bhvk,bhk->bhv', S, r_)

    xs = tuple(jnp.moveaxis(t, 1, 0) for t in (r, w, k, v, kk, a))
    S, o = lax.scan(step, S0.astype(F32), xs)
    return jnp.moveaxis(o, 0, 1), S


def hybrid_layer(x, c, conv_st, dn_st, gla_st, rs_st, rw_st,
                 norm_g, ada_w, ada_b, w_in, dn_conv_w, dn_a_log, dn_dt_bias, dn_norm_g,
                 gla_wf, gla_bf, gla_norm_g, rw_mu, rw_w0, rw_w2, rw_a0, rw_a2,
                 rw_k_k, rw_k_a, rw_r_k, rw_ln_w, rw_ln_b, w_out):
    B, T, _ = x.shape
    mod = jax.nn.silu(c.astype(F32)) @ ada_w + ada_b
    shift, scale, gate = jnp.split(mod, 3, axis=-1)
    h = rmsnorm(x, norm_g) * (1.0 + scale[:, None]) + shift[:, None]
    proj = jnp.einsum('btd,de->bte', h, w_in)
    dn_p = proj[..., :DN_PROJ]
    gla_p = proj[..., DN_PROJ:DN_PROJ + GLA_PROJ]
    rw_p = proj[..., DN_PROJ + GLA_PROJ:]

    qkv = dn_p[..., :DN_CONV_DIM]
    z_dn = dn_p[..., DN_CONV_DIM:DN_CONV_DIM + DN_V].reshape(B, T, DN_HEADS, DN_DV)
    b_raw = dn_p[..., DN_CONV_DIM + DN_V:DN_CONV_DIM + DN_V + DN_HEADS]
    a_raw = dn_p[..., DN_CONV_DIM + DN_V + DN_HEADS:]
    full = jnp.concatenate([conv_st.astype(F32), qkv], axis=1)
    conv = full[:, :T] * dn_conv_w[0]
    for j in range(1, CONV_W):
        conv = conv + full[:, j:j + T] * dn_conv_w[j]
    conv = jax.nn.silu(conv)
    conv_new = full[:, T:]
    dq = l2norm(conv[..., :DN_QK].reshape(B, T, DN_HEADS, DN_DK)) * (DN_DK ** -0.5)
    dk = l2norm(conv[..., DN_QK:2 * DN_QK].reshape(B, T, DN_HEADS, DN_DK))
    dv = conv[..., 2 * DN_QK:].reshape(B, T, DN_HEADS, DN_DV)
    beta = jax.nn.sigmoid(b_raw)
    g = -jnp.exp(dn_a_log.astype(F32)) * jax.nn.softplus(a_raw + dn_dt_bias)
    o_dn, dn_new = gated_delta_rule(dq, dk, dv, beta, g, dn_st)
    o_dn = (rmsnorm(o_dn, dn_norm_g) * jax.nn.silu(z_dn)).reshape(B, T, DN_V)

    gq = gla_p[..., :GLA_QK].reshape(B, T, GLA_HEADS, GLA_DK) * (GLA_DK ** -0.5)
    gk = gla_p[..., GLA_QK:2 * GLA_QK].reshape(B, T, GLA_HEADS, GLA_DK)
    gv = gla_p[..., 2 * GLA_QK:2 * GLA_QK + GLA_V].reshape(B, T, GLA_HEADS, GLA_DV)
    gz = gla_p[..., 2 * GLA_QK + GLA_V:2 * GLA_QK + 2 * GLA_V].reshape(B, T, GLA_HEADS, GLA_DV)
    glo = gla_p[..., 2 * GLA_QK + 2 * GLA_V:]
    lf = (jax.nn.log_sigmoid(glo @ gla_wf + gla_bf) / GLA_TAU).reshape(B, T, GLA_HEADS, GLA_DK)
    o_gla, gla_new = gla_chunked(gq, gk, gv, lf, gla_st)
    o_gla = (rmsnorm(o_gla, gla_norm_g) * jax.nn.silu(gz)).reshape(B, T, GLA_V)

    xs = rw_p[..., :RW_SHIFT_DIM]
    rz = rw_p[..., RW_SHIFT_DIM:]
    prev = jnp.concatenate([rs_st[:, None].astype(F32), xs[:, :-1]], axis=1)
    rs_new = xs[:, -1]
    xm = xs + (prev - xs) * rw_mu
    r = xm[..., :RW_C]
    k = xm[..., RW_C:2 * RW_C]
    v = xm[..., 2 * RW_C:3 * RW_C]
    wlo = xm[..., 3 * RW_C:3 * RW_C + RW_DECAY_RANK]
    alo = xm[..., 3 * RW_C + RW_DECAY_RANK:]
    w_log = -jax.nn.softplus(-(rw_w0 + jnp.tanh(wlo) @ rw_w2)) - 0.5
    decay = jnp.exp(-jnp.exp(w_log))
    a = jax.nn.sigmoid(rw_a0 + alo @ rw_a2)
    hs = (B, T, RW_HEADS, RW_N)
    kk = l2norm((k * rw_k_k).reshape(hs))
    k = k * (1.0 + (a - 1.0) * rw_k_a)
    r, k, v, decay, a = (t.reshape(hs) for t in (r, k, v, decay, a))
    o_rw, rw_new = rwkv7_scan(r, decay, k, v, kk, a, rw_st)
    mu = jnp.mean(o_rw, axis=-1, keepdims=True)
    var = jnp.mean(jnp.square(o_rw - mu), axis=-1, keepdims=True)
    o_rw = ((o_rw - mu) * lax.rsqrt(var + RW_LN_EPS)).reshape(B, T, RW_C) * rw_ln_w + rw_ln_b
    bonus = (jnp.sum(r * k * rw_r_k, axis=-1, keepdims=True) * v).reshape(B, T, RW_C)
    o_rw = (o_rw + bonus) * jax.nn.silu(rz)

    o = jnp.concatenate([o_dn, o_gla, o_rw], axis=-1)
    x = x + gate[:, None] * jnp.einsum('bte,ed->btd', o, w_out)
    return x, (conv_new, dn_new, gla_new, rs_new, rw_new)


def setup_inputs(seed: int = 0) -> dict:
    key = jax.random.key(seed)
    ks = jax.random.split(key, 32)

    def nrm(i, shape, s):
        return s * jax.random.normal(ks[i], shape, F32)

    def uni(i, shape, lo, hi):
        return jax.random.uniform(ks[i], shape, F32, lo, hi)

    L, D = DEPTH, D_MODEL
    dt = jnp.exp(uni(15, (L, DN_HEADS), math.log(1e-3), math.log(1e-1)))
    return {
        'x_prompt': nrm(0, (BATCH, SEQ, D), 1.0),
        'x_sample': nrm(1, (DEC_BATCH, DEC_SEQ, D), 1.0),
        'c_prompt': nrm(2, (BATCH, D), 1.0),
        'c_sample': nrm(3, (DEC_BATCH, D), 1.0),
        'state_dn_conv': nrm(4, (L, DEC_BATCH, CONV_W - 1, DN_CONV_DIM), 1.0),
        'state_dn': nrm(5, (L, DEC_BATCH, DN_HEADS, DN_DK, DN_DV), 0.05),
        'state_gla': nrm(6, (L, DEC_BATCH, GLA_HEADS, GLA_DK, GLA_DV), 0.1),
        'state_rwkv_shift': nrm(7, (L, DEC_BATCH, RW_SHIFT_DIM), 1.0),
        'state_rwkv': nrm(8, (L, DEC_BATCH, RW_HEADS, RW_N, RW_N), 0.05),
        'norm_g': 1.0 + nrm(9, (L, D), 0.05),
        'ada_w': nrm(10, (L, D, 3 * D), 0.5 * D ** -0.5),
        'ada_b': nrm(11, (L, 3 * D), 0.02),
        'w_in': nrm(12, (L, D, D_PROJ), D ** -0.5),
        'dn_conv_w': nrm(13, (L, CONV_W, DN_CONV_DIM), CONV_W ** -0.5),
        'dn_a_log': jnp.log(uni(14, (L, DN_HEADS), 1.0, 16.0)),
        'dn_dt_bias': dt + jnp.log(-jnp.expm1(-dt)),
        'dn_norm_g': 1.0 + nrm(16, (L, DN_DV), 0.05),
        'gla_wf': nrm(17, (L, GLA_RANK, GLA_QK), GLA_RANK ** -0.5),
        'gla_bf': 1.0 + nrm(18, (L, GLA_QK), 0.5),
        'gla_norm_g': 1.0 + nrm(19, (L, GLA_DV), 0.05),
        'rw_mu': uni(20, (L, RW_SHIFT_DIM), 0.0, 1.0),
        'rw_w0': uni(21, (L, RW_C), -6.0, -1.0),
        'rw_w2': nrm(22, (L, RW_DECAY_RANK, RW_C), 0.1 * RW_DECAY_RANK ** -0.5),
        'rw_a0': nrm(23, (L, RW_C), 0.1),
        'rw_a2': nrm(24, (L, RW_A_RANK, RW_C), RW_A_RANK ** -0.5),
        'rw_k_k': 0.85 + nrm(25, (L, RW_C), 0.05),
        'rw_k_a': 1.0 + nrm(26, (L, RW_C), 0.05),
        'rw_r_k': nrm(27, (L, RW_HEADS, RW_N), 0.1),
        'rw_ln_w': 1.0 + nrm(28, (L, RW_C), 0.05),
        'rw_ln_b': nrm(29, (L, RW_C), 0.02),
        'w_out': nrm(30, (L, D_MIX, D), D_MIX ** -0.5),
        'final_norm_g': 1.0 + nrm(31, (D,), 0.05),
    }


def reference(x_prompt, x_sample, c_prompt, c_sample, state_dn_conv, state_dn, state_gla,
              state_rwkv_shift, state_rwkv, norm_g, ada_w, ada_b, w_in, dn_conv_w, dn_a_log,
              dn_dt_bias, dn_norm_g, gla_wf, gla_bf, gla_norm_g, rw_mu, rw_w0, rw_w2, rw_a0,
              rw_a2, rw_k_k, rw_k_a, rw_r_k, rw_ln_w, rw_ln_b, w_out, final_norm_g):
    def trunk(x, c, conv_s, dn_s, gla_s, rs_s, rw_s):
        hcur = x.astype(F32)
        outs = []
        for l in range(DEPTH):
            hcur, st = hybrid_layer(
                hcur, c, conv_s[l], dn_s[l], gla_s[l], rs_s[l], rw_s[l],
                norm_g[l], ada_w[l], ada_b[l], w_in[l], dn_conv_w[l], dn_a_log[l], dn_dt_bias[l],
                dn_norm_g[l], gla_wf[l], gla_bf[l], gla_norm_g[l], rw_mu[l], rw_w0[l], rw_w2[l],
                rw_a0[l], rw_a2[l], rw_k_k[l], rw_k_a[l], rw_r_k[l], rw_ln_w[l], rw_ln_b[l], w_out[l])
            outs.append(st)
        y = rmsnorm(hcur, final_norm_g).astype(x.dtype)
        n_conv = jnp.stack([s[0] for s in outs])
        n_dn = jnp.stack([s[1] for s in outs])
        n_gla = jnp.stack([s[2] for s in outs])
        n_rs = jnp.stack([s[3] for s in outs])
        n_rw = jnp.stack([s[4] for s in outs])
        return y, n_conv, n_dn, n_gla, n_rs, n_rw

    Bp = x_prompt.shape[0]
    y_prompt, p_conv, p_dn, p_gla, p_rs, p_rw = trunk(
        x_prompt, c_prompt,
        jnp.zeros((DEPTH, Bp, CONV_W - 1, DN_CONV_DIM), F32),
        jnp.zeros((DEPTH, Bp, DN_HEADS, DN_DK, DN_DV), F32),
        jnp.zeros((DEPTH, Bp, GLA_HEADS, GLA_DK, GLA_DV), F32),
        jnp.zeros((DEPTH, Bp, RW_SHIFT_DIM), F32),
        jnp.zeros((DEPTH, Bp, RW_HEADS, RW_N, RW_N), F32))
    y_sample, s_conv, s_dn, s_gla, s_rs, s_rw = trunk(
        x_sample, c_sample, state_dn_conv, state_dn, state_gla, state_rwkv_shift, state_rwkv)
    return (y_prompt, y_sample, p_conv, p_dn, p_gla, p_rs, p_rw, s_conv, s_dn, s_gla, s_rs, s_rw)
```

```cpp
#include <hip/hip_runtime.h>
#include <hip/hip_cooperative_groups.h>
#include <cstdio>
namespace cg = cooperative_groups;

#ifndef COOP
#define COOP 0
#endif

#define DEVI __device__ __forceinline__
typedef unsigned short bf16_t;
typedef short bf16x8 __attribute__((ext_vector_type(8)));
typedef float f32x4 __attribute__((ext_vector_type(4)));

constexpr int NT = 512;
constexpr int DM = 1024;
constexpr int NPR = 16384;
constexpr int NR = 16512;
constexpr int NRP = 16640;
constexpr int LDP = 5888;
constexpr int DPROJ = 5784;
constexpr int NSEQ = 136;
constexpr int C_DNQ = 0, C_DNK = 512, C_DNV = 1024, C_DNZ = 1536, C_DNB = 2048, C_DNA = 2052;
constexpr int C_GQ = 2056, C_GK = 2312, C_GV = 2568, C_GZ = 3080, C_GLO = 3592;
constexpr int C_RX = 3608, C_RZ = 5272;
constexpr size_t O_YP = 0;
constexpr size_t O_YS = O_YP + (size_t)16384 * 1024;
constexpr size_t O_PCONV = O_YS + (size_t)128 * 1024;
constexpr size_t O_PDN = O_PCONV + (size_t)2 * 8 * 3 * 1536;
constexpr size_t O_PGLA = O_PDN + (size_t)2 * 8 * 4 * 128 * 128;
constexpr size_t O_PRS = O_PGLA + (size_t)2 * 8 * 4 * 64 * 128;
constexpr size_t O_PRW = O_PRS + (size_t)2 * 8 * 1664;
constexpr size_t O_SCONV = O_PRW + (size_t)2 * 8 * 8 * 64 * 64;
constexpr size_t O_SDN = O_SCONV + (size_t)2 * 128 * 3 * 1536;
constexpr size_t O_SGLA = O_SDN + (size_t)2 * 128 * 4 * 128 * 128;
constexpr size_t O_SRS = O_SGLA + (size_t)2 * 128 * 4 * 64 * 128;
constexpr size_t O_SRW = O_SRS + (size_t)2 * 128 * 1664;

struct Params {
    const float *x_prompt, *x_sample, *c_prompt, *c_sample, *st_conv, *st_dn, *st_gla, *st_rs, *st_rw;
    const float *norm_g, *ada_w, *ada_b, *w_in, *conv_w, *a_log, *dt_bias, *dn_norm_g, *gla_wf, *gla_bf, *gla_norm_g;
    const float *rw_mu, *rw_w0, *rw_w2, *rw_a0, *rw_a2, *rw_k_k, *rw_k_a, *rw_r_k, *rw_ln_w, *rw_ln_b, *w_out, *final_g;
    float* out;
    bf16_t *WinT, *WoutT, *h, *proj, *obf;
    float *mod, *x, *dnq, *dnk, *dnv, *dnbeta, *dna, *glf, *rr, *rk, *rv, *rw, *rkk, *rb, *rbonus, *oraw;
    int p0, p1;
};

typedef const __attribute__((address_space(4))) Params* KP;
DEVI KP launder(KP q) { asm volatile("" : "+s"(q)); return q; }
DEVI bf16_t f2bf(float f) { unsigned u = __float_as_uint(f); u += 0x7fffu + ((u >> 16) & 1u); return (bf16_t)(u >> 16); }
DEVI float bf2f(bf16_t b) { return __uint_as_float(((unsigned)b) << 16); }
DEVI float wsum(float v) {
#pragma unroll
    for (int o = 32; o > 0; o >>= 1) v += __shfl_xor(v, o);
    return v;
}
DEVI float siluf(float x) { return x / (1.f + expf(-x)); }
DEVI float sigmf(float x) { return 1.f / (1.f + expf(-x)); }
DEVI float softplusf(float x) { return x > 20.f ? x : log1pf(expf(x)); }
DEVI void wave_sync() {
    __builtin_amdgcn_fence(__ATOMIC_RELEASE, "wavefront");
    __builtin_amdgcn_wave_barrier();
    __builtin_amdgcn_fence(__ATOMIC_ACQUIRE, "wavefront");
}
DEVI int mod_row(int row) { return row < NPR ? (row >> 11) : (8 + row - NPR); }

DEVI void transpose_tile(const float* src, bf16_t* dst, int K, int N, int k0, int n0, float* tl) {
    const int tid = threadIdx.x;
#pragma unroll
    for (int i = 0; i < 8; ++i) {
        int kk = (tid >> 6) + i * 8, nn = tid & 63;
        float v = (n0 + nn < N) ? src[(size_t)(k0 + kk) * N + n0 + nn] : 0.f;
        tl[kk * 65 + nn] = v;
    }
    __syncthreads();
#pragma unroll
    for (int i = 0; i < 8; ++i) {
        int nn = (tid >> 6) + i * 8, kk = tid & 63;
        dst[(size_t)(n0 + nn) * K + k0 + kk] = f2bf(tl[kk * 65 + nn]);
    }
    __syncthreads();
}

DEVI void phase_setup(KP p_, unsigned char* smem) {
    KP p = launder(p_);
    const int tid = threadIdx.x;
    float* tl = (float*)smem;
    for (int it = blockIdx.x; it < 2 * 16 * 92; it += gridDim.x) {
        int l = it / (16 * 92), r = it % (16 * 92), kt = r / 92, nt = r % 92;
        transpose_tile(p->w_in + (size_t)l * 1024 * DPROJ, p->WinT + (size_t)l * LDP * 1024, 1024, DPROJ, kt * 64, nt * 64, tl);
    }
    for (int it = blockIdx.x; it < 2 * 24 * 16; it += gridDim.x) {
        int l = it / (24 * 16), r = it % (24 * 16), kt = r / 16, nt = r % 16;
        transpose_tile(p->w_out + (size_t)l * 1536 * 1024, p->WoutT + (size_t)l * 1024 * 1536, 1536, 1024, kt * 64, nt * 64, tl);
    }
    {
        const float4* s0 = (const float4*)p->x_prompt; const float4* s1 = (const float4*)p->x_sample; float4* d = (float4*)p->x;
        const size_t n0 = (size_t)NPR * 256, n1 = (size_t)NR * 256;
        for (size_t i = (size_t)blockIdx.x * NT + tid; i < n1; i += (size_t)gridDim.x * NT) d[i] = i < n0 ? s0[i] : s1[i - n0];
        for (size_t i = (size_t)blockIdx.x * NT + tid; i < (size_t)(NRP - NR) * 1024; i += (size_t)gridDim.x * NT) p->h[(size_t)NR * 1024 + i] = 0;
        for (size_t i = (size_t)blockIdx.x * NT + tid; i < (size_t)(NRP - NR) * 1536; i += (size_t)gridDim.x * NT) p->obf[(size_t)NR * 1536 + i] = 0;
    }
    float* sc = (float*)smem;
    for (int it = blockIdx.x; it < 2 * 6 * 17; it += gridDim.x) {
        int l = it / 102, r = it % 102, jt = r / 17, rg = r % 17;
        for (int idx = tid; idx < 8192; idx += NT) {
            int rr = idx >> 10, k = idx & 1023, mb = rg * 8 + rr;
            float c = mb < 8 ? p->c_prompt[mb * 1024 + k] : p->c_sample[(mb - 8) * 1024 + k];
            sc[k * 8 + rr] = siluf(c);
        }
        __syncthreads();
        const int col = jt * 512 + tid;
        float acc[8];
#pragma unroll
        for (int i = 0; i < 8; ++i) acc[i] = 0.f;
        const float* aw = p->ada_w + (size_t)l * 1024 * 3072 + col;
#pragma unroll 4
        for (int k = 0; k < 1024; ++k) {
            float a = aw[(size_t)k * 3072];
            float4 s0 = ((const float4*)sc)[k * 2], s1 = ((const float4*)sc)[k * 2 + 1];
            acc[0] += s0.x * a; acc[1] += s0.y * a; acc[2] += s0.z * a; acc[3] += s0.w * a;
            acc[4] += s1.x * a; acc[5] += s1.y * a; acc[6] += s1.z * a; acc[7] += s1.w * a;
        }
        float bb = p->ada_b[l * 3072 + col];
#pragma unroll
        for (int i = 0; i < 8; ++i) p->mod[((size_t)l * NSEQ + rg * 8 + i) * 3072 + col] = acc[i] + bb;
        __syncthreads();
    }
}

DEVI void phase_norm(KP p_, int l) {
    KP p = launder(p_);
    const int lane = threadIdx.x & 63, wid = threadIdx.x >> 6;
    for (int row = blockIdx.x * 8 + wid; row < NR; row += gridDim.x * 8) {
        const float4* xr = (const float4*)(p->x + (size_t)row * 1024);
        float4 v[4]; float ss = 0.f;
#pragma unroll
        for (int i = 0; i < 4; ++i) { v[i] = xr[lane + i * 64]; ss += v[i].x * v[i].x + v[i].y * v[i].y + v[i].z * v[i].z + v[i].w * v[i].w; }
        ss = wsum(ss);
        const float rstd = rsqrtf(ss * (1.f / 1024.f) + 1e-6f);
        const float* md = p->mod + ((size_t)l * NSEQ + mod_row(row)) * 3072;
#pragma unroll
        for (int i = 0; i < 4; ++i) {
            const int c = (lane + i * 64) * 4;
            float4 g = *(const float4*)(p->norm_g + l * 1024 + c), sh = *(const float4*)(md + c), sc = *(const float4*)(md + 1024 + c);
            ushort4 o;
            o.x = f2bf(v[i].x * rstd * g.x * (1.f + sc.x) + sh.x);
            o.y = f2bf(v[i].y * rstd * g.y * (1.f + sc.y) + sh.y);
            o.z = f2bf(v[i].z * rstd * g.z * (1.f + sc.z) + sh.z);
            o.w = f2bf(v[i].w * rstd * g.w * (1.f + sc.w) + sh.w);
            *(ushort4*)(p->h + (size_t)row * 1024 + c) = o;
        }
    }
}

constexpr int G_BM = 256, G_BN = 128, G_BK = 64, G_LDS = 72;
template <class Epi>
DEVI void gemm_phase(unsigned char* smem, const bf16_t* A, int lda, const bf16_t* Bt, int ldb, int Mtiles, int Ntiles, int K, const Epi& epi) {
    bf16_t* As = (bf16_t*)smem;
    bf16_t* Bs = As + G_BM * G_LDS;
    const int tid = threadIdx.x, lane = tid & 63, wid = tid >> 6, wm = wid >> 1, wn = wid & 1;
    const int fr = lane & 15, fq = lane >> 4;
    const int nk = K / G_BK;
    for (int t = blockIdx.x; t < Mtiles * Ntiles; t += gridDim.x) {
        const int mt = t / Ntiles, nt = t % Ntiles;
        const bf16_t* Ag = A + (size_t)mt * G_BM * lda;
        const bf16_t* Bg = Bt + (size_t)nt * G_BN * ldb;
        f32x4 acc[4][4];
#pragma unroll
        for (int i = 0; i < 4; ++i)
#pragma unroll
            for (int j = 0; j < 4; ++j) acc[i][j] = (f32x4){0.f, 0.f, 0.f, 0.f};
        const int sr = tid >> 3, scol = (tid & 7) * 8;
        const bf16_t* Ap = Ag + (size_t)sr * lda + scol;
        const bf16_t* Bp = Bg + (size_t)sr * ldb + scol;
        uint4 ra0 = *(const uint4*)(Ap), ra1 = *(const uint4*)(Ap + (size_t)64 * lda), ra2 = *(const uint4*)(Ap + (size_t)128 * lda), ra3 = *(const uint4*)(Ap + (size_t)192 * lda);
        uint4 rb0 = *(const uint4*)(Bp), rb1 = *(const uint4*)(Bp + (size_t)64 * ldb);
        for (int kt = 0; kt < nk; ++kt) {
            *(uint4*)(As + sr * G_LDS + scol) = ra0; *(uint4*)(As + (sr + 64) * G_LDS + scol) = ra1;
            *(uint4*)(As + (sr + 128) * G_LDS + scol) = ra2; *(uint4*)(As + (sr + 192) * G_LDS + scol) = ra3;
            *(uint4*)(Bs + sr * G_LDS + scol) = rb0; *(uint4*)(Bs + (sr + 64) * G_LDS + scol) = rb1;
            __syncthreads();
            if (kt + 1 < nk) {
                const int k0 = (kt + 1) * G_BK;
                ra0 = *(const uint4*)(Ap + k0); ra1 = *(const uint4*)(Ap + (size_t)64 * lda + k0); ra2 = *(const uint4*)(Ap + (size_t)128 * lda + k0); ra3 = *(const uint4*)(Ap + (size_t)192 * lda + k0);
                rb0 = *(const uint4*)(Bp + k0); rb1 = *(const uint4*)(Bp + (size_t)64 * ldb + k0);
            }
#pragma unroll
            for (int ks = 0; ks < 2; ++ks) {
                bf16x8 af[4], bfr[4];
#pragma unroll
                for (int i = 0; i < 4; ++i) af[i] = *(const bf16x8*)(As + (wm * 64 + i * 16 + fr) * G_LDS + ks * 32 + fq * 8);
#pragma unroll
                for (int j = 0; j < 4; ++j) bfr[j] = *(const bf16x8*)(Bs + (wn * 64 + j * 16 + fr) * G_LDS + ks * 32 + fq * 8);
#pragma unroll
                for (int i = 0; i < 4; ++i)
#pragma unroll
                    for (int j = 0; j < 4; ++j) acc[i][j] = __builtin_amdgcn_mfma_f32_16x16x32_bf16(bfr[j], af[i], acc[i][j], 0, 0, 0);
            }
            __syncthreads();
        }
#pragma unroll
        for (int i = 0; i < 4; ++i)
#pragma unroll
            for (int j = 0; j < 4; ++j) epi(mt * G_BM + wm * 64 + i * 16 + fr, nt * G_BN + wn * 64 + j * 16 + fq * 4, acc[i][j]);
    }
}
struct EpiProj {
    bf16_t* proj;
    DEVI void operator()(int m, int n, f32x4 v) const {
        ushort4 o; o.x = f2bf(v[0]); o.y = f2bf(v[1]); o.z = f2bf(v[2]); o.w = f2bf(v[3]);
        *(ushort4*)(proj + (size_t)m * LDP + n) = o;
    }
};
struct EpiOut {
    float* x; const float* mod;
    DEVI void operator()(int m, int n, f32x4 v) const {
        if (m >= NR) return;
        const float4 g = *(const float4*)(mod + (size_t)mod_row(m) * 3072 + 2048 + n);
        float4* xp = (float4*)(x + (size_t)m * 1024 + n);
        float4 xv = *xp;
        xv.x += g.x * v[0]; xv.y += g.y * v[1]; xv.z += g.z * v[2]; xv.w += g.w * v[3];
        *xp = xv;
    }
};

DEVI float dn_full(KP p, int l, int s, int row0, int f, int col) {
    if (f < 3) { if (s < 8) return 0.f; return p->st_conv[((size_t)(l * 128 + (s - 8)) * 3 + f) * 1536 + col]; }
    return bf2f(p->proj[(size_t)(row0 + f - 3) * LDP + col]);
}
DEVI void seq_of_row(int row, int& s, int& t, int& T, int& row0) {
    if (row < NPR) { s = row >> 11; t = row & 2047; T = 2048; row0 = s * 2048; }
    else { s = 8 + row - NPR; t = 0; T = 1; row0 = row; }
}

DEVI void phase_prep(KP p_, int l, unsigned char* smem) {
    KP p = launder(p_);
    const int tid = threadIdx.x, lane = tid & 63, wid = tid >> 6;
    for (int it = blockIdx.x * 8 + wid; it < NR * 4; it += gridDim.x * 8) {
        const int row = it >> 2, h = it & 3;
        int s, t, T, row0; seq_of_row(row, s, t, T, row0);
        float val[3][2];
#pragma unroll
        for (int seg = 0; seg < 3; ++seg)
#pragma unroll
            for (int e = 0; e < 2; ++e) {
                const int col = seg * 512 + h * 128 + lane * 2 + e;
                float a = 0.f;
#pragma unroll
                for (int j = 0; j < 4; ++j) a += dn_full(p, l, s, row0, t + j, col) * p->conv_w[(l * 4 + j) * 1536 + col];
                val[seg][e] = siluf(a);
            }
        float sq = wsum(val[0][0] * val[0][0] + val[0][1] * val[0][1]);
        float sk = wsum(val[1][0] * val[1][0] + val[1][1] * val[1][1]);
        const float rq = rsqrtf(sq + 1e-6f) * 0.08838834764831845f, rk = rsqrtf(sk + 1e-6f);
        const size_t o = (size_t)row * 512 + h * 128 + lane * 2;
        *(float2*)(p->dnq + o) = make_float2(val[0][0] * rq, val[0][1] * rq);
        *(float2*)(p->dnk + o) = make_float2(val[1][0] * rk, val[1][1] * rk);
        *(float2*)(p->dnv + o) = make_float2(val[2][0], val[2][1]);
        if (lane == 0) {
            float braw = bf2f(p->proj[(size_t)row * LDP + C_DNB + h]), araw = bf2f(p->proj[(size_t)row * LDP + C_DNA + h]);
            p->dnbeta[row * 4 + h] = sigmf(braw);
            float g = -expf(p->a_log[l * 4 + h]) * softplusf(araw + p->dt_bias[l * 4 + h]);
            p->dna[row * 4 + h] = expf(g);
        }
        if (t == T - 1) {
            float* dst = (s < 8) ? p->out + O_PCONV + (size_t)(l * 8 + s) * 3 * 1536 : p->out + O_SCONV + (size_t)(l * 128 + s - 8) * 3 * 1536;
#pragma unroll
            for (int j = 0; j < 3; ++j)
#pragma unroll
                for (int seg = 0; seg < 3; ++seg)
#pragma unroll
                    for (int e = 0; e < 2; ++e) {
                        const int col = seg * 512 + h * 128 + lane * 2 + e;
                        dst[j * 1536 + col] = dn_full(p, l, s, row0, T + j, col);
                    }
        }
    }
    for (int row = blockIdx.x * 8 + wid; row < NR; row += gridDim.x * 8) {
        float glo[16];
#pragma unroll
        for (int j = 0; j < 16; ++j) glo[j] = bf2f(p->proj[(size_t)row * LDP + C_GLO + j]);
#pragma unroll
        for (int i = 0; i < 4; ++i) {
            const int c = lane + i * 64;
            float z = p->gla_bf[l * 256 + c];
#pragma unroll
            for (int j = 0; j < 16; ++j) z += glo[j] * p->gla_wf[(l * 16 + j) * 256 + c];
            p->glf[(size_t)row * 256 + c] = -softplusf(-z) * (1.f / 16.f);
        }
    }
    float* twT = (float*)smem;
    float* alT = twT + 64 * 8;
    for (int tile = blockIdx.x; tile < NR / 8; tile += gridDim.x) {
        const int c = tid;
        const int rbase = tile * 8;
        const bool samp = rbase >= NPR;
        const float mur = p->rw_mu[l * 1664 + c], muk = p->rw_mu[l * 1664 + 512 + c], muv = p->rw_mu[l * 1664 + 1024 + c];
        float xr[8], xk[8], xv[8];
        float pr = 0.f, pk = 0.f, pv = 0.f;
        if (!samp && (rbase & 2047) != 0) {
            const bf16_t* pp = p->proj + (size_t)(rbase - 1) * LDP + C_RX;
            pr = bf2f(pp[c]); pk = bf2f(pp[512 + c]); pv = bf2f(pp[1024 + c]);
        }
#pragma unroll
        for (int r = 0; r < 8; ++r) {
            const int row = rbase + r;
            const bf16_t* pp = p->proj + (size_t)row * LDP + C_RX;
            const float cr = bf2f(pp[c]), ck = bf2f(pp[512 + c]), cv = bf2f(pp[1024 + c]);
            if (samp) { const float* st = p->st_rs + (size_t)(l * 128 + row - NPR) * 1664; pr = st[c]; pk = st[512 + c]; pv = st[1024 + c]; }
            xr[r] = cr + (pr - cr) * mur; xk[r] = ck + (pk - ck) * muk; xv[r] = cv + (pv - cv) * muv;
            pr = cr; pk = ck; pv = cv;
            if (samp || (row & 2047) == 2047) {
                float* dst = samp ? p->out + O_SRS + (size_t)(l * 128 + row - NPR) * 1664 : p->out + O_PRS + (size_t)(l * 8 + (row >> 11)) * 1664;
                dst[c] = cr; dst[512 + c] = ck; dst[1024 + c] = cv;
                if (c < 128) dst[1536 + c] = bf2f(pp[1536 + c]);
            }
        }
        if (c < 128) {
            const int col = 1536 + c, j = c & 63;
            const float mu = p->rw_mu[l * 1664 + col];
            float pw = 0.f;
            if (!samp && (rbase & 2047) != 0) pw = bf2f(p->proj[(size_t)(rbase - 1) * LDP + C_RX + col]);
#pragma unroll
            for (int r = 0; r < 8; ++r) {
                const int row = rbase + r;
                const float cw = bf2f(p->proj[(size_t)row * LDP + C_RX + col]);
                if (samp) pw = p->st_rs[(size_t)(l * 128 + row - NPR) * 1664 + col];
                const float xm = cw + (pw - cw) * mu;
                pw = cw;
                if (c < 64) twT[j * 8 + r] = tanhf(xm); else alT[j * 8 + r] = xm;
            }
        }
        __syncthreads();
        float aw[8], aa[8];
#pragma unroll
        for (int r = 0; r < 8; ++r) { aw[r] = 0.f; aa[r] = 0.f; }
#pragma unroll 2
        for (int j = 0; j < 64; ++j) {
            const float w2v = p->rw_w2[((size_t)l * 64 + j) * 512 + c], a2v = p->rw_a2[((size_t)l * 64 + j) * 512 + c];
#pragma unroll
            for (int q = 0; q < 2; ++q) {
                const float4 t4 = ((const float4*)twT)[j * 2 + q], a4 = ((const float4*)alT)[j * 2 + q];
                aw[q * 4 + 0] += t4.x * w2v; aw[q * 4 + 1] += t4.y * w2v; aw[q * 4 + 2] += t4.z * w2v; aw[q * 4 + 3] += t4.w * w2v;
                aa[q * 4 + 0] += a4.x * a2v; aa[q * 4 + 1] += a4.y * a2v; aa[q * 4 + 2] += a4.z * a2v; aa[q * 4 + 3] += a4.w * a2v;
            }
        }
        const float w0 = p->rw_w0[l * 512 + c], a0 = p->rw_a0[l * 512 + c], kkc = p->rw_k_k[l * 512 + c], kac = p->rw_k_a[l * 512 + c], rkc = p->rw_r_k[l * 512 + c];
#pragma unroll
        for (int r = 0; r < 8; ++r) {
            const size_t o = (size_t)(rbase + r) * 512 + c;
            const float wl = -softplusf(-(w0 + aw[r])) - 0.5f;
            const float decay = expf(-expf(wl));
            const float a = sigmf(a0 + aa[r]);
            const float kr = xk[r] * kkc;
            const float ss = wsum(kr * kr);
            const float kk = kr * rsqrtf(ss + 1e-6f);
            const float k2 = xk[r] * (1.f + (a - 1.f) * kac);
            const float bon = wsum(xr[r] * k2 * rkc) * xv[r];
            p->rr[o] = xr[r]; p->rk[o] = k2; p->rv[o] = xv[r]; p->rw[o] = decay; p->rkk[o] = kk; p->rb[o] = kk * a; p->rbonus[o] = bon;
        }
        __syncthreads();
    }
}

DEVI void dn_scan_item(KP p, int l, int s, int h, int quarter, float* wl) {
    const int lane = threadIdx.x & 63, kh = lane & 1;
    int T, row0; const float* Sin; float* Sout;
    if (s < 8) { T = 2048; row0 = s * 2048; Sin = nullptr; Sout = p->out + O_PDN + (size_t)((l * 8 + s) * 4 + h) * 16384; }
    else { T = 1; row0 = NPR + s - 8; Sin = p->st_dn + (size_t)((l * 128 + s - 8) * 4 + h) * 16384; Sout = p->out + O_SDN + (size_t)((l * 128 + s - 8) * 4 + h) * 16384; }
    const int col = quarter * 32 + (lane >> 1);
    float S[64];
#pragma unroll
    for (int k = 0; k < 64; ++k) S[k] = Sin ? Sin[(kh * 64 + k) * 128 + col] : 0.f;
    float nq0, nq1, nk0, nk1, nv, nb, na;
    {
        const size_t o = (size_t)row0 * 512 + h * 128;
        nq0 = p->dnq[o + lane]; nq1 = p->dnq[o + 64 + lane]; nk0 = p->dnk[o + lane]; nk1 = p->dnk[o + 64 + lane];
        nv = p->dnv[o + col]; nb = p->dnbeta[row0 * 4 + h]; na = p->dna[row0 * 4 + h];
    }
    for (int t = 0; t < T; ++t) {
        const int row = row0 + t;
        wave_sync();
        wl[lane] = nq0; wl[64 + lane] = nq1; wl[128 + lane] = nk0; wl[192 + lane] = nk1;
        const float v = nv, beta = nb, a = na;
        wave_sync();
        {
            const int rn = (t + 1 < T) ? row + 1 : row;
            const size_t o = (size_t)rn * 512 + h * 128;
            nq0 = p->dnq[o + lane]; nq1 = p->dnq[o + 64 + lane]; nk0 = p->dnk[o + lane]; nk1 = p->dnk[o + 64 + lane];
            nv = p->dnv[o + col]; nb = p->dnbeta[rn * 4 + h]; na = p->dna[rn * 4 + h];
        }
        const float4* kp = (const float4*)(wl + 128 + kh * 64);
        const float4* qp = (const float4*)(wl + kh * 64);
        float x0 = 0.f, x1 = 0.f, x2 = 0.f, x3 = 0.f;
#pragma unroll
        for (int k4 = 0; k4 < 16; ++k4) {
            const float4 kv = kp[k4];
            x0 += S[k4 * 4 + 0] * kv.x; x1 += S[k4 * 4 + 1] * kv.y; x2 += S[k4 * 4 + 2] * kv.z; x3 += S[k4 * 4 + 3] * kv.w;
        }
        float x = (x0 + x1) + (x2 + x3);
        x += __shfl_xor(x, 1);
        const float coef = beta * (v - a * x);
        float o0 = 0.f, o1 = 0.f, o2 = 0.f, o3 = 0.f;
#pragma unroll
        for (int k4 = 0; k4 < 16; ++k4) {
            const float4 kv = kp[k4];
            const float4 qv = qp[k4];
            S[k4 * 4 + 0] = a * S[k4 * 4 + 0] + coef * kv.x; o0 += S[k4 * 4 + 0] * qv.x;
            S[k4 * 4 + 1] = a * S[k4 * 4 + 1] + coef * kv.y; o1 += S[k4 * 4 + 1] * qv.y;
            S[k4 * 4 + 2] = a * S[k4 * 4 + 2] + coef * kv.z; o2 += S[k4 * 4 + 2] * qv.z;
            S[k4 * 4 + 3] = a * S[k4 * 4 + 3] + coef * kv.w; o3 += S[k4 * 4 + 3] * qv.w;
        }
        float o = (o0 + o1) + (o2 + o3);
        o += __shfl_xor(o, 1);
        if (kh == 0) p->oraw[(size_t)row * 1536 + h * 128 + col] = o;
    }
#pragma unroll
    for (int k = 0; k < 64; ++k) Sout[(kh * 64 + k) * 128 + col] = S[k];
}

DEVI void gla_scan_item(KP p, int l, int s, int h, int half, float* wl) {
    const int lane = threadIdx.x & 63;
    int T, row0; const float* Sin; float* Sout;
    if (s < 8) { T = 2048; row0 = s * 2048; Sin = nullptr; Sout = p->out + O_PGLA + (size_t)((l * 8 + s) * 4 + h) * 8192; }
    else { T = 1; row0 = NPR + s - 8; Sin = p->st_gla + (size_t)((l * 128 + s - 8) * 4 + h) * 8192; Sout = p->out + O_SGLA + (size_t)((l * 128 + s - 8) * 4 + h) * 8192; }
    const int col = half * 64 + lane;
    float S[64];
#pragma unroll
    for (int k = 0; k < 64; ++k) S[k] = Sin ? Sin[k * 128 + col] : 0.f;
    float nq, nk, nf, nv;
    {
        const bf16_t* pp = p->proj + (size_t)row0 * LDP;
        nq = bf2f(pp[C_GQ + h * 64 + lane]) * 0.125f; nk = bf2f(pp[C_GK + h * 64 + lane]); nv = bf2f(pp[C_GV + h * 128 + col]);
        nf = expf(p->glf[(size_t)row0 * 256 + h * 64 + lane]);
    }
    for (int t = 0; t < T; ++t) {
        const int row = row0 + t;
        wave_sync();
        wl[lane] = nq; wl[64 + lane] = nk; wl[128 + lane] = nf;
        const float v = nv;
        wave_sync();
        {
            const int rn = (t + 1 < T) ? row + 1 : row;
            const bf16_t* pp = p->proj + (size_t)rn * LDP;
            nq = bf2f(pp[C_GQ + h * 64 + lane]) * 0.125f; nk = bf2f(pp[C_GK + h * 64 + lane]); nv = bf2f(pp[C_GV + h * 128 + col]);
            nf = expf(p->glf[(size_t)rn * 256 + h * 64 + lane]);
        }
        float o0 = 0.f, o1 = 0.f, o2 = 0.f, o3 = 0.f;
#pragma unroll
        for (int k4 = 0; k4 < 16; ++k4) {
            const float4 qv = ((const float4*)wl)[k4], kv = ((const float4*)(wl + 64))[k4], fv = ((const float4*)(wl + 128))[k4];
            S[k4 * 4 + 0] = fv.x * S[k4 * 4 + 0] + kv.x * v; o0 += S[k4 * 4 + 0] * qv.x;
            S[k4 * 4 + 1] = fv.y * S[k4 * 4 + 1] + kv.y * v; o1 += S[k4 * 4 + 1] * qv.y;
            S[k4 * 4 + 2] = fv.z * S[k4 * 4 + 2] + kv.z * v; o2 += S[k4 * 4 + 2] * qv.z;
            S[k4 * 4 + 3] = fv.w * S[k4 * 4 + 3] + kv.w * v; o3 += S[k4 * 4 + 3] * qv.w;
        }
        p->oraw[(size_t)row * 1536 + 512 + h * 128 + col] = (o0 + o1) + (o2 + o3);
    }
#pragma unroll
    for (int k = 0; k < 64; ++k) Sout[k * 128 + col] = S[k];
}

DEVI void rw_scan_item(KP p, int l, int s, int h, float* wl) {
    const int lane = threadIdx.x & 63;
    int T, row0; const float* Sin; float* Sout;
    if (s < 8) { T = 2048; row0 = s * 2048; Sin = nullptr; Sout = p->out + O_PRW + (size_t)((l * 8 + s) * 8 + h) * 4096; }
    else { T = 1; row0 = NPR + s - 8; Sin = p->st_rw + (size_t)((l * 128 + s - 8) * 8 + h) * 4096; Sout = p->out + O_SRW + (size_t)((l * 128 + s - 8) * 8 + h) * 4096; }
    float S[64];
#pragma unroll
    for (int k4 = 0; k4 < 16; ++k4) {
        float4 v4 = Sin ? ((const float4*)(Sin + lane * 64))[k4] : make_float4(0.f, 0.f, 0.f, 0.f);
        S[k4 * 4 + 0] = v4.x; S[k4 * 4 + 1] = v4.y; S[k4 * 4 + 2] = v4.z; S[k4 * 4 + 3] = v4.w;
    }
    float nr, nw, nk, nv, nkk, nb;
    {
        const size_t o = (size_t)row0 * 512 + h * 64 + lane;
        nr = p->rr[o]; nw = p->rw[o]; nk = p->rk[o]; nv = p->rv[o]; nkk = p->rkk[o]; nb = p->rb[o];
    }
    for (int t = 0; t < T; ++t) {
        const int row = row0 + t;
        wave_sync();
        wl[lane] = nr; wl[64 + lane] = nw; wl[128 + lane] = nk; wl[192 + lane] = nkk; wl[256 + lane] = nb;
        const float v = nv;
        wave_sync();
        {
            const int rn = (t + 1 < T) ? row + 1 : row;
            const size_t o = (size_t)rn * 512 + h * 64 + lane;
            nr = p->rr[o]; nw = p->rw[o]; nk = p->rk[o]; nv = p->rv[o]; nkk = p->rkk[o]; nb = p->rb[o];
        }
        float x0 = 0.f, x1 = 0.f, x2 = 0.f, x3 = 0.f;
#pragma unroll
        for (int k4 = 0; k4 < 16; ++k4) {
            const float4 kv = ((const float4*)(wl + 192))[k4];
            x0 += S[k4 * 4 + 0] * kv.x; x1 += S[k4 * 4 + 1] * kv.y; x2 += S[k4 * 4 + 2] * kv.z; x3 += S[k4 * 4 + 3] * kv.w;
        }
        const float x = (x0 + x1) + (x2 + x3);
        float o0 = 0.f, o1 = 0.f, o2 = 0.f, o3 = 0.f;
#pragma unroll
        for (int k4 = 0; k4 < 16; ++k4) {
            const float4 rv = ((const float4*)wl)[k4], wv = ((const float4*)(wl + 64))[k4], kv = ((const float4*)(wl + 128))[k4], bv = ((const float4*)(wl + 256))[k4];
            S[k4 * 4 + 0] = S[k4 * 4 + 0] * wv.x - x * bv.x + v * kv.x; o0 += S[k4 * 4 + 0] * rv.x;
            S[k4 * 4 + 1] = S[k4 * 4 + 1] * wv.y - x * bv.y + v * kv.y; o1 += S[k4 * 4 + 1] * rv.y;
            S[k4 * 4 + 2] = S[k4 * 4 + 2] * wv.z - x * bv.z + v * kv.z; o2 += S[k4 * 4 + 2] * rv.z;
            S[k4 * 4 + 3] = S[k4 * 4 + 3] * wv.w - x * bv.w + v * kv.w; o3 += S[k4 * 4 + 3] * rv.w;
        }
        p->oraw[(size_t)row * 1536 + 1024 + h * 64 + lane] = (o0 + o1) + (o2 + o3);
    }
#pragma unroll
    for (int k4 = 0; k4 < 16; ++k4)
        ((float4*)(Sout + lane * 64))[k4] = make_float4(S[k4 * 4 + 0], S[k4 * 4 + 1], S[k4 * 4 + 2], S[k4 * 4 + 3]);
}

DEVI void phase_scan(KP p_, int l, unsigned char* smem) {
    KP p = launder(p_);
    const int wid = threadIdx.x >> 6;
    float* wl = (float*)smem + wid * 512;
    const int nw = gridDim.x * 8;
    for (int it = wid * gridDim.x + blockIdx.x; it < 256 + 4096; it += nw) {
        int type, i, sbase;
        if (it < 256) { type = it < 128 ? 0 : (it < 192 ? 1 : 2); i = it < 128 ? it : (it & 63); sbase = 0; }
        else { const int j = it - 256; type = j < 2048 ? 0 : (j < 3072 ? 1 : 2); i = j < 2048 ? j : (j & 1023); sbase = 8; }
#ifdef ONLY_ENGINE
        if (type != ONLY_ENGINE) continue;
#endif
        if (type == 0) dn_scan_item(p, l, sbase + (i >> 4), (i >> 2) & 3, i & 3, wl);
        else if (type == 1) gla_scan_item(p, l, sbase + (i >> 3), (i >> 1) & 3, i & 1, wl);
        else rw_scan_item(p, l, sbase + (i >> 3), i & 7, wl);
    }
}

DEVI void phase_post(KP p_, int l) {
    KP p = launder(p_);
    const int lane = threadIdx.x & 63, wid = threadIdx.x >> 6;
    for (int row = blockIdx.x * 8 + wid; row < NR; row += gridDim.x * 8) {
        const float* orow = p->oraw + (size_t)row * 1536;
        const bf16_t* pr = p->proj + (size_t)row * LDP;
        bf16_t* ob = p->obf + (size_t)row * 1536;
#pragma unroll
        for (int h = 0; h < 4; ++h) {
            {
                const float2 o = *(const float2*)(orow + h * 128 + lane * 2);
                const float ss = wsum(o.x * o.x + o.y * o.y);
                const float rs = rsqrtf(ss * (1.f / 128.f) + 1e-6f);
                const float2 g = *(const float2*)(p->dn_norm_g + l * 128 + lane * 2);
                const float z0 = bf2f(pr[C_DNZ + h * 128 + lane * 2]), z1 = bf2f(pr[C_DNZ + h * 128 + lane * 2 + 1]);
                ushort2 w; w.x = f2bf(o.x * rs * g.x * siluf(z0)); w.y = f2bf(o.y * rs * g.y * siluf(z1));
                *(ushort2*)(ob + h * 128 + lane * 2) = w;
            }
            {
                const float2 o = *(const float2*)(orow + 512 + h * 128 + lane * 2);
                const float ss = wsum(o.x * o.x + o.y * o.y);
                const float rs = rsqrtf(ss * (1.f / 128.f) + 1e-6f);
                const float2 g = *(const float2*)(p->gla_norm_g + l * 128 + lane * 2);
                const float z0 = bf2f(pr[C_GZ + h * 128 + lane * 2]), z1 = bf2f(pr[C_GZ + h * 128 + lane * 2 + 1]);
                ushort2 w; w.x = f2bf(o.x * rs * g.x * siluf(z0)); w.y = f2bf(o.y * rs * g.y * siluf(z1));
                *(ushort2*)(ob + 512 + h * 128 + lane * 2) = w;
            }
        }
#pragma unroll
        for (int h = 0; h < 8; ++h) {
            const int c = h * 64 + lane;
            const float o = orow[1024 + c];
            const float mu = wsum(o) * (1.f / 64.f);
            const float d = o - mu;
            const float var = wsum(d * d) * (1.f / 64.f);
            float y = d * rsqrtf(var + 64e-5f) * p->rw_ln_w[l * 512 + c] + p->rw_ln_b[l * 512 + c];
            y += p->rbonus[(size_t)row * 512 + c];
            y *= siluf(bf2f(pr[C_RZ + c]));
            ob[1024 + c] = f2bf(y);
        }
    }
}

DEVI void phase_final(KP p_) {
    KP p = launder(p_);
    const int lane = threadIdx.x & 63, wid = threadIdx.x >> 6;
    for (int row = blockIdx.x * 8 + wid; row < NR; row += gridDim.x * 8) {
        const float4* xr = (const float4*)(p->x + (size_t)row * 1024);
        float4 v[4]; float ss = 0.f;
#pragma unroll
        for (int i = 0; i < 4; ++i) { v[i] = xr[lane + i * 64]; ss += v[i].x * v[i].x + v[i].y * v[i].y + v[i].z * v[i].z + v[i].w * v[i].w; }
        ss = wsum(ss);
        const float rstd = rsqrtf(ss * (1.f / 1024.f) + 1e-6f);
        float4* yo = (float4*)(p->out + (size_t)row * 1024);
#pragma unroll
        for (int i = 0; i < 4; ++i) {
            const float4 g = ((const float4*)p->final_g)[lane + i * 64];
            yo[lane + i * 64] = make_float4(v[i].x * rstd * g.x, v[i].y * rstd * g.y, v[i].z * rstd * g.z, v[i].w * rstd * g.w);
        }
    }
}

constexpr int SMEM_BYTES = (G_BM + G_BN) * G_LDS * 2;
template <bool kCoop>
__global__ void __launch_bounds__(NT) fwd_kernel(Params p_arg) {
    KP p = (KP)__builtin_amdgcn_kernarg_segment_ptr();
    __shared__ __attribute__((aligned(16))) unsigned char smem[SMEM_BYTES];
#if COOP
    for (int ph = p->p0; ph < p->p1; ++ph) {
#else
    for (int ph = p->p0, once = 1; once; once = 0) {
#endif
#ifdef ONLY_SUB
        if (ph == 0) { if (ONLY_SUB == 6) phase_setup(p, smem); }
        else if (ph == 13) { if (ONLY_SUB == 7) phase_final(p); }
#else
        if (ph == 0) phase_setup(p, smem);
        else if (ph == 13) phase_final(p);
#endif
        else {
            const int l = (ph - 1) / 6, sub = (ph - 1) % 6;
#ifdef ONLY_SUB
            if (sub != ONLY_SUB) continue;
#endif
#ifdef SKIP_SUB
            if (sub == SKIP_SUB) continue;
#endif
            if (sub == 0) phase_norm(p, l);
            else if (sub == 1) { KP q = launder(p); EpiProj e{q->proj}; gemm_phase(smem, q->h, 1024, q->WinT + (size_t)l * LDP * 1024, 1024, NRP / G_BM, LDP / G_BN, 1024, e); }
            else if (sub == 2) phase_prep(p, l, smem);
            else if (sub == 3) phase_scan(p, l, smem);
            else if (sub == 4) phase_post(p, l);
            else { KP q = launder(p); EpiOut e{q->x, q->mod + (size_t)l * NSEQ * 3072}; gemm_phase(smem, q->obf, 1536, q->WoutT + (size_t)l * 1024 * 1536, 1536, NRP / G_BM, 1024 / G_BN, 1536, e); }
        }
        if (kCoop && ph + 1 < p->p1) cg::this_grid().sync();
    }
}

extern "C" void kernel_launch(void* const* d_in, const int* in_sizes, int n_in, void* d_out, int out_size, void* d_ws, size_t ws_size, hipStream_t stream) {
    Params hp{};
    const float** pf = (const float**)&hp;
    for (int i = 0; i < 32; ++i) pf[i] = (const float*)d_in[i];
    hp.out = (float*)d_out;
    char* w = (char*)d_ws;
    auto take = [&](size_t bytes) { char* r = w; w += (bytes + 255) & ~(size_t)255; return r; };
    hp.WinT = (bf16_t*)take((size_t)2 * LDP * 1024 * 2);
    hp.WoutT = (bf16_t*)take((size_t)2 * 1024 * 1536 * 2);
    hp.h = (bf16_t*)take((size_t)NRP * 1024 * 2);
    hp.proj = (bf16_t*)take((size_t)NRP * LDP * 2);
    hp.obf = (bf16_t*)take((size_t)NRP * 1536 * 2);
    hp.mod = (float*)take((size_t)2 * NSEQ * 3072 * 4);
    hp.x = (float*)take((size_t)NR * 1024 * 4);
    hp.dnq = (float*)take((size_t)NR * 512 * 4);
    hp.dnk = (float*)take((size_t)NR * 512 * 4);
    hp.dnv = (float*)take((size_t)NR * 512 * 4);
    hp.dnbeta = (float*)take((size_t)NR * 4 * 4);
    hp.dna = (float*)take((size_t)NR * 4 * 4);
    hp.glf = (float*)take((size_t)NR * 256 * 4);
    hp.rr = (float*)take((size_t)NR * 512 * 4);
    hp.rk = (float*)take((size_t)NR * 512 * 4);
    hp.rv = (float*)take((size_t)NR * 512 * 4);
    hp.rw = (float*)take((size_t)NR * 512 * 4);
    hp.rkk = (float*)take((size_t)NR * 512 * 4);
    hp.rb = (float*)take((size_t)NR * 512 * 4);
    hp.rbonus = (float*)take((size_t)NR * 512 * 4);
    hp.oraw = (float*)take((size_t)NR * 1536 * 4);
    static int grid_blocks = 0;
    if (!grid_blocks) {
        int dev = 0, cus = 0, per_cu = 0;
        hipGetDevice(&dev);
        hipDeviceGetAttribute(&cus, hipDeviceAttributeMultiprocessorCount, dev);
        hipOccupancyMaxActiveBlocksPerMultiprocessor(&per_cu, fwd_kernel<COOP != 0>, NT, 0);
        if (per_cu < 1) fprintf(stderr, "occupancy query returned %d\n", per_cu);
        grid_blocks = cus;
    }
#if COOP
    hp.p0 = 0; hp.p1 = 14;
    void* args[] = {&hp};
    hipError_t e = hipLaunchCooperativeKernel((void*)fwd_kernel<true>, dim3(grid_blocks), dim3(NT), args, 0, stream);
    if (e != hipSuccess) fprintf(stderr, "cooperative launch failed: %s (grid %d)\n", hipGetErrorString(e), grid_blocks);
#else
    for (int ph = 0; ph < 14; ++ph) {
        hp.p0 = ph; hp.p1 = ph + 1;
        fwd_kernel<false><<<grid_blocks, NT, 0, stream>>>(hp);
    }
#endif
}
```

```cpp
#include <hip/hip_runtime.h>
#include <hip/hip_cooperative_groups.h>
#include <cstdio>
namespace cg = cooperative_groups;

#ifndef COOP
#define COOP 1
#endif

#define DEVI __device__ __forceinline__
typedef unsigned short bf16_t;
typedef short bf16x8 __attribute__((ext_vector_type(8)));
typedef float f32x4 __attribute__((ext_vector_type(4)));

constexpr int NT = 512;
constexpr int DM = 1024;
constexpr int NPR = 16384;
constexpr int NR = 16512;
constexpr int NRP = 16640;
constexpr int LDP = 5888;
constexpr int DPROJ = 5784;
constexpr int NSEQ = 136;
constexpr int C_DNQ = 0, C_DNK = 512, C_DNV = 1024, C_DNZ = 1536, C_DNB = 2048, C_DNA = 2052;
constexpr int C_GQ = 2056, C_GK = 2312, C_GV = 2568, C_GZ = 3080, C_GLO = 3592;
constexpr int C_RX = 3608, C_RZ = 5272;
constexpr size_t O_YP = 0;
constexpr size_t O_YS = O_YP + (size_t)16384 * 1024;
constexpr size_t O_PCONV = O_YS + (size_t)128 * 1024;
constexpr size_t O_PDN = O_PCONV + (size_t)2 * 8 * 3 * 1536;
constexpr size_t O_PGLA = O_PDN + (size_t)2 * 8 * 4 * 128 * 128;
constexpr size_t O_PRS = O_PGLA + (size_t)2 * 8 * 4 * 64 * 128;
constexpr size_t O_PRW = O_PRS + (size_t)2 * 8 * 1664;
constexpr size_t O_SCONV = O_PRW + (size_t)2 * 8 * 8 * 64 * 64;
constexpr size_t O_SDN = O_SCONV + (size_t)2 * 128 * 3 * 1536;
constexpr size_t O_SGLA = O_SDN + (size_t)2 * 128 * 4 * 128 * 128;
constexpr size_t O_SRS = O_SGLA + (size_t)2 * 128 * 4 * 64 * 128;
constexpr size_t O_SRW = O_SRS + (size_t)2 * 128 * 1664;

struct Params {
    const float *x_prompt, *x_sample, *c_prompt, *c_sample, *st_conv, *st_dn, *st_gla, *st_rs, *st_rw;
    const float *norm_g, *ada_w, *ada_b, *w_in, *conv_w, *a_log, *dt_bias, *dn_norm_g, *gla_wf, *gla_bf, *gla_norm_g;
    const float *rw_mu, *rw_w0, *rw_w2, *rw_a0, *rw_a2, *rw_k_k, *rw_k_a, *rw_r_k, *rw_ln_w, *rw_ln_b, *w_out, *final_g;
    float* out;
    bf16_t *WinT, *WoutT, *h, *proj, *obf;
    float *mod, *x, *dnq, *dnk, *dnv, *dnbeta, *dna, *glf, *rr, *rk, *rv, *rw, *rkk, *rb, *rbonus, *oraw;
    int p0, p1;
};

typedef const __attribute__((address_space(4))) Params* KP;
DEVI KP launder(KP q) { asm volatile("" : "+s"(q)); return q; }
DEVI int tidx() { int v = threadIdx.x; asm volatile("" : "+v"(v)); return v; }
DEVI int bidx() { int v = blockIdx.x; asm volatile("" : "+s"(v)); return v; }
DEVI int gdim() { int v = gridDim.x; asm volatile("" : "+s"(v)); return v; }
DEVI bf16_t f2bf(float f) { unsigned u = __float_as_uint(f); u += 0x7fffu + ((u >> 16) & 1u); return (bf16_t)(u >> 16); }
DEVI float bf2f(bf16_t b) { return __uint_as_float(((unsigned)b) << 16); }
DEVI float wsum(float v) {
#pragma unroll
    for (int o = 32; o > 0; o >>= 1) v += __shfl_xor(v, o);
    return v;
}
DEVI float siluf(float x) { return x / (1.f + expf(-x)); }
DEVI float sigmf(float x) { return 1.f / (1.f + expf(-x)); }
DEVI float softplusf(float x) { return x > 20.f ? x : log1pf(expf(x)); }
DEVI void wave_sync() {
    __builtin_amdgcn_fence(__ATOMIC_RELEASE, "wavefront");
    __builtin_amdgcn_wave_barrier();
    __builtin_amdgcn_fence(__ATOMIC_ACQUIRE, "wavefront");
}
DEVI int mod_row(int row) { return row < NPR ? (row >> 11) : (8 + row - NPR); }

DEVI void transpose_tile(const float* src, bf16_t* dst, int K, int N, int k0, int n0, float* tl) {
    const int tid = tidx();
#pragma unroll
    for (int i = 0; i < 8; ++i) {
        int kk = (tid >> 6) + i * 8, nn = tid & 63;
        float v = (n0 + nn < N) ? src[(size_t)(k0 + kk) * N + n0 + nn] : 0.f;
        tl[kk * 65 + nn] = v;
    }
    __syncthreads();
#pragma unroll
    for (int i = 0; i < 8; ++i) {
        int nn = (tid >> 6) + i * 8, kk = tid & 63;
        dst[(size_t)(n0 + nn) * K + k0 + kk] = f2bf(tl[kk * 65 + nn]);
    }
    __syncthreads();
}

DEVI void phase_setup(KP p_, unsigned char* smem) {
    KP p = launder(p_);
    const int tid = tidx();
    float* tl = (float*)smem;
    for (int it = bidx(); it < 2 * 16 * 92; it += gdim()) {
        int l = it / (16 * 92), r = it % (16 * 92), kt = r / 92, nt = r % 92;
        transpose_tile(p->w_in + (size_t)l * 1024 * DPROJ, p->WinT + (size_t)l * LDP * 1024, 1024, DPROJ, kt * 64, nt * 64, tl);
    }
    for (int it = bidx(); it < 2 * 24 * 16; it += gdim()) {
        int l = it / (24 * 16), r = it % (24 * 16), kt = r / 16, nt = r % 16;
        transpose_tile(p->w_out + (size_t)l * 1536 * 1024, p->WoutT + (size_t)l * 1024 * 1536, 1536, 1024, kt * 64, nt * 64, tl);
    }
    {
        const float4* s0 = (const float4*)p->x_prompt; const float4* s1 = (const float4*)p->x_sample; float4* d = (float4*)p->x;
        const size_t n0 = (size_t)NPR * 256, n1 = (size_t)NR * 256;
        for (size_t i = (size_t)bidx() * NT + tid; i < n1; i += (size_t)gdim() * NT) d[i] = i < n0 ? s0[i] : s1[i - n0];
        for (size_t i = (size_t)bidx() * NT + tid; i < (size_t)(NRP - NR) * 1024; i += (size_t)gdim() * NT) p->h[(size_t)NR * 1024 + i] = 0;
        for (size_t i = (size_t)bidx() * NT + tid; i < (size_t)(NRP - NR) * 1536; i += (size_t)gdim() * NT) p->obf[(size_t)NR * 1536 + i] = 0;
    }
    float* sc = (float*)smem;
    for (int it = bidx(); it < 2 * 6 * 17; it += gdim()) {
        int l = it / 102, r = it % 102, jt = r / 17, rg = r % 17;
        for (int idx = tid; idx < 8192; idx += NT) {
            int rr = idx >> 10, k = idx & 1023, mb = rg * 8 + rr;
            float c = mb < 8 ? p->c_prompt[mb * 1024 + k] : p->c_sample[(mb - 8) * 1024 + k];
            sc[k * 8 + rr] = siluf(c);
        }
        __syncthreads();
        const int col = jt * 512 + tid;
        float acc[8];
#pragma unroll
        for (int i = 0; i < 8; ++i) acc[i] = 0.f;
        const float* aw = p->ada_w + (size_t)l * 1024 * 3072 + col;
#pragma unroll 4
        for (int k = 0; k < 1024; ++k) {
            float a = aw[(size_t)k * 3072];
            float4 s0 = ((const float4*)sc)[k * 2], s1 = ((const float4*)sc)[k * 2 + 1];
            acc[0] += s0.x * a; acc[1] += s0.y * a; acc[2] += s0.z * a; acc[3] += s0.w * a;
            acc[4] += s1.x * a; acc[5] += s1.y * a; acc[6] += s1.z * a; acc[7] += s1.w * a;
        }
        float bb = p->ada_b[l * 3072 + col];
#pragma unroll
        for (int i = 0; i < 8; ++i) p->mod[((size_t)l * NSEQ + rg * 8 + i) * 3072 + col] = acc[i] + bb;
        __syncthreads();
    }
}

DEVI void phase_norm(KP p_, int l) {
    KP p = launder(p_);
    const int lane = tidx() & 63, wid = tidx() >> 6;
    for (int row = bidx() * 8 + wid; row < NR; row += gdim() * 8) {
        const float4* xr = (const float4*)(p->x + (size_t)row * 1024);
        float4 v[4]; float ss = 0.f;
#pragma unroll
        for (int i = 0; i < 4; ++i) { v[i] = xr[lane + i * 64]; ss += v[i].x * v[i].x + v[i].y * v[i].y + v[i].z * v[i].z + v[i].w * v[i].w; }
        ss = wsum(ss);
        const float rstd = rsqrtf(ss * (1.f / 1024.f) + 1e-6f);
        const float* md = p->mod + ((size_t)l * NSEQ + mod_row(row)) * 3072;
#pragma unroll
        for (int i = 0; i < 4; ++i) {
            const int c = (lane + i * 64) * 4;
            float4 g = *(const float4*)(p->norm_g + l * 1024 + c), sh = *(const float4*)(md + c), sc = *(const float4*)(md + 1024 + c);
            ushort4 o;
            o.x = f2bf(v[i].x * rstd * g.x * (1.f + sc.x) + sh.x);
            o.y = f2bf(v[i].y * rstd * g.y * (1.f + sc.y) + sh.y);
            o.z = f2bf(v[i].z * rstd * g.z * (1.f + sc.z) + sh.z);
            o.w = f2bf(v[i].w * rstd * g.w * (1.f + sc.w) + sh.w);
            *(ushort4*)(p->h + (size_t)row * 1024 + c) = o;
        }
    }
}

constexpr int G_BM = 256, G_BN = 128, G_BK = 64, G_LDS = 72;
template <class Epi>
DEVI void gemm_phase(unsigned char* smem, const bf16_t* A, int lda, const bf16_t* Bt, int ldb, int Mtiles, int Ntiles, int K, const Epi& epi) {
    bf16_t* As = (bf16_t*)smem;
    bf16_t* Bs = As + G_BM * G_LDS;
    const int tid = tidx(), lane = tid & 63, wid = tid >> 6, wm = wid >> 1, wn = wid & 1;
    const int fr = lane & 15, fq = lane >> 4;
    const int nk = K / G_BK;
    for (int t = bidx(); t < Mtiles * Ntiles; t += gdim()) {
        const int mt = t / Ntiles, nt = t % Ntiles;
        const bf16_t* Ag = A + (size_t)mt * G_BM * lda;
        const bf16_t* Bg = Bt + (size_t)nt * G_BN * ldb;
        f32x4 acc[4][4];
#pragma unroll
        for (int i = 0; i < 4; ++i)
#pragma unroll
            for (int j = 0; j < 4; ++j) acc[i][j] = (f32x4){0.f, 0.f, 0.f, 0.f};
        const int sr = tid >> 3, scol = (tid & 7) * 8;
        const bf16_t* Ap = Ag + (size_t)sr * lda + scol;
        const bf16_t* Bp = Bg + (size_t)sr * ldb + scol;
        uint4 ra0 = *(const uint4*)(Ap), ra1 = *(const uint4*)(Ap + (size_t)64 * lda), ra2 = *(const uint4*)(Ap + (size_t)128 * lda), ra3 = *(const uint4*)(Ap + (size_t)192 * lda);
        uint4 rb0 = *(const uint4*)(Bp), rb1 = *(const uint4*)(Bp + (size_t)64 * ldb);
        for (int kt = 0; kt < nk; ++kt) {
            *(uint4*)(As + sr * G_LDS + scol) = ra0; *(uint4*)(As + (sr + 64) * G_LDS + scol) = ra1;
            *(uint4*)(As + (sr + 128) * G_LDS + scol) = ra2; *(uint4*)(As + (sr + 192) * G_LDS + scol) = ra3;
            *(uint4*)(Bs + sr * G_LDS + scol) = rb0; *(uint4*)(Bs + (sr + 64) * G_LDS + scol) = rb1;
            __syncthreads();
            if (kt + 1 < nk) {
                const int k0 = (kt + 1) * G_BK;
                ra0 = *(const uint4*)(Ap + k0); ra1 = *(const uint4*)(Ap + (size_t)64 * lda + k0); ra2 = *(const uint4*)(Ap + (size_t)128 * lda + k0); ra3 = *(const uint4*)(Ap + (size_t)192 * lda + k0);
                rb0 = *(const uint4*)(Bp + k0); rb1 = *(const uint4*)(Bp + (size_t)64 * ldb + k0);
            }
#pragma unroll
            for (int ks = 0; ks < 2; ++ks) {
                bf16x8 af[4], bfr[4];
#pragma unroll
                for (int i = 0; i < 4; ++i) af[i] = *(const bf16x8*)(As + (wm * 64 + i * 16 + fr) * G_LDS + ks * 32 + fq * 8);
#pragma unroll
                for (int j = 0; j < 4; ++j) bfr[j] = *(const bf16x8*)(Bs + (wn * 64 + j * 16 + fr) * G_LDS + ks * 32 + fq * 8);
#pragma unroll
                for (int i = 0; i < 4; ++i)
#pragma unroll
                    for (int j = 0; j < 4; ++j) acc[i][j] = __builtin_amdgcn_mfma_f32_16x16x32_bf16(bfr[j], af[i], acc[i][j], 0, 0, 0);
            }
            __syncthreads();
        }
#pragma unroll
        for (int i = 0; i < 4; ++i)
#pragma unroll
            for (int j = 0; j < 4; ++j) epi(mt * G_BM + wm * 64 + i * 16 + fr, nt * G_BN + wn * 64 + j * 16 + fq * 4, acc[i][j]);
    }
}
struct EpiProj {
    bf16_t* proj;
    DEVI void operator()(int m, int n, f32x4 v) const {
        ushort4 o; o.x = f2bf(v[0]); o.y = f2bf(v[1]); o.z = f2bf(v[2]); o.w = f2bf(v[3]);
        *(ushort4*)(proj + (size_t)m * LDP + n) = o;
    }
};
struct EpiOut {
    float* x; const float* mod;
    DEVI void operator()(int m, int n, f32x4 v) const {
        if (m >= NR) return;
        const float4 g = *(const float4*)(mod + (size_t)mod_row(m) * 3072 + 2048 + n);
        float4* xp = (float4*)(x + (size_t)m * 1024 + n);
        float4 xv = *xp;
        xv.x += g.x * v[0]; xv.y += g.y * v[1]; xv.z += g.z * v[2]; xv.w += g.w * v[3];
        *xp = xv;
    }
};

DEVI float dn_full(KP p, int l, int s, int row0, int f, int col) {
    if (f < 3) { if (s < 8) return 0.f; return p->st_conv[((size_t)(l * 128 + (s - 8)) * 3 + f) * 1536 + col]; }
    return bf2f(p->proj[(size_t)(row0 + f - 3) * LDP + col]);
}
DEVI void seq_of_row(int row, int& s, int& t, int& T, int& row0) {
    if (row < NPR) { s = row >> 11; t = row & 2047; T = 2048; row0 = s * 2048; }
    else { s = 8 + row - NPR; t = 0; T = 1; row0 = row; }
}

DEVI void phase_prep(KP p_, int l, unsigned char* smem) {
    KP p = launder(p_);
    const int tid = tidx(), lane = tid & 63, wid = tid >> 6;
    for (int it = bidx() * 8 + wid; it < NR * 4; it += gdim() * 8) {
        const int row = it >> 2, h = it & 3;
        int s, t, T, row0; seq_of_row(row, s, t, T, row0);
        float val[3][2];
#pragma unroll
        for (int seg = 0; seg < 3; ++seg)
#pragma unroll
            for (int e = 0; e < 2; ++e) {
                const int col = seg * 512 + h * 128 + lane * 2 + e;
                float a = 0.f;
#pragma unroll
                for (int j = 0; j < 4; ++j) a += dn_full(p, l, s, row0, t + j, col) * p->conv_w[(l * 4 + j) * 1536 + col];
                val[seg][e] = siluf(a);
            }
        float sq = wsum(val[0][0] * val[0][0] + val[0][1] * val[0][1]);
        float sk = wsum(val[1][0] * val[1][0] + val[1][1] * val[1][1]);
        const float rq = rsqrtf(sq + 1e-6f) * 0.08838834764831845f, rk = rsqrtf(sk + 1e-6f);
        const size_t o = (size_t)row * 512 + h * 128 + lane * 2;
        *(float2*)(p->dnq + o) = make_float2(val[0][0] * rq, val[0][1] * rq);
        *(float2*)(p->dnk + o) = make_float2(val[1][0] * rk, val[1][1] * rk);
        *(float2*)(p->dnv + o) = make_float2(val[2][0], val[2][1]);
        if (lane == 0) {
            float braw = bf2f(p->proj[(size_t)row * LDP + C_DNB + h]), araw = bf2f(p->proj[(size_t)row * LDP + C_DNA + h]);
            p->dnbeta[row * 4 + h] = sigmf(braw);
            float g = -expf(p->a_log[l * 4 + h]) * softplusf(araw + p->dt_bias[l * 4 + h]);
            p->dna[row * 4 + h] = expf(g);
        }
        if (t == T - 1) {
            float* dst = (s < 8) ? p->out + O_PCONV + (size_t)(l * 8 + s) * 3 * 1536 : p->out + O_SCONV + (size_t)(l * 128 + s - 8) * 3 * 1536;
#pragma unroll
            for (int j = 0; j < 3; ++j)
#pragma unroll
                for (int seg = 0; seg < 3; ++seg)
#pragma unroll
                    for (int e = 0; e < 2; ++e) {
                        const int col = seg * 512 + h * 128 + lane * 2 + e;
                        dst[j * 1536 + col] = dn_full(p, l, s, row0, T + j, col);
                    }
        }
    }
    for (int row = bidx() * 8 + wid; row < NR; row += gdim() * 8) {
        float glo[16];
#pragma unroll
        for (int j = 0; j < 16; ++j) glo[j] = bf2f(p->proj[(size_t)row * LDP + C_GLO + j]);
#pragma unroll
        for (int i = 0; i < 4; ++i) {
            const int c = lane + i * 64;
            float z = p->gla_bf[l * 256 + c];
#pragma unroll
            for (int j = 0; j < 16; ++j) z += glo[j] * p->gla_wf[(l * 16 + j) * 256 + c];
            p->glf[(size_t)row * 256 + c] = -softplusf(-z) * (1.f / 16.f);
        }
    }
    float* twT = (float*)smem;
    float* alT = twT + 64 * 8;
    for (int tile = bidx(); tile < NR / 8; tile += gdim()) {
        const int c = tid;
        const int rbase = tile * 8;
        const bool samp = rbase >= NPR;
        const float mur = p->rw_mu[l * 1664 + c], muk = p->rw_mu[l * 1664 + 512 + c], muv = p->rw_mu[l * 1664 + 1024 + c];
        float xr[8], xk[8], xv[8];
        float pr = 0.f, pk = 0.f, pv = 0.f;
        if (!samp && (rbase & 2047) != 0) {
            const bf16_t* pp = p->proj + (size_t)(rbase - 1) * LDP + C_RX;
            pr = bf2f(pp[c]); pk = bf2f(pp[512 + c]); pv = bf2f(pp[1024 + c]);
        }
#pragma unroll
        for (int r = 0; r < 8; ++r) {
            const int row = rbase + r;
            const bf16_t* pp = p->proj + (size_t)row * LDP + C_RX;
            const float cr = bf2f(pp[c]), ck = bf2f(pp[512 + c]), cv = bf2f(pp[1024 + c]);
            if (samp) { const float* st = p->st_rs + (size_t)(l * 128 + row - NPR) * 1664; pr = st[c]; pk = st[512 + c]; pv = st[1024 + c]; }
            xr[r] = cr + (pr - cr) * mur; xk[r] = ck + (pk - ck) * muk; xv[r] = cv + (pv - cv) * muv;
            pr = cr; pk = ck; pv = cv;
            if (samp || (row & 2047) == 2047) {
                float* dst = samp ? p->out + O_SRS + (size_t)(l * 128 + row - NPR) * 1664 : p->out + O_PRS + (size_t)(l * 8 + (row >> 11)) * 1664;
                dst[c] = cr; dst[512 + c] = ck; dst[1024 + c] = cv;
                if (c < 128) dst[1536 + c] = bf2f(pp[1536 + c]);
            }
        }
        if (c < 128) {
            const int col = 1536 + c, j = c & 63;
            const float mu = p->rw_mu[l * 1664 + col];
            float pw = 0.f;
            if (!samp && (rbase & 2047) != 0) pw = bf2f(p->proj[(size_t)(rbase - 1) * LDP + C_RX + col]);
#pragma unroll
            for (int r = 0; r < 8; ++r) {
                const int row = rbase + r;
                const float cw = bf2f(p->proj[(size_t)row * LDP + C_RX + col]);
                if (samp) pw = p->st_rs[(size_t)(l * 128 + row - NPR) * 1664 + col];
                const float xm = cw + (pw - cw) * mu;
                pw = cw;
                if (c < 64) twT[j * 8 + r] = tanhf(xm); else alT[j * 8 + r] = xm;
            }
        }
        __syncthreads();
        float aw[8], aa[8];
#pragma unroll
        for (int r = 0; r < 8; ++r) { aw[r] = 0.f; aa[r] = 0.f; }
#pragma unroll 2
        for (int j = 0; j < 64; ++j) {
            const float w2v = p->rw_w2[((size_t)l * 64 + j) * 512 + c], a2v = p->rw_a2[((size_t)l * 64 + j) * 512 + c];
#pragma unroll
            for (int q = 0; q < 2; ++q) {
                const float4 t4 = ((const float4*)twT)[j * 2 + q], a4 = ((const float4*)alT)[j * 2 + q];
                aw[q * 4 + 0] += t4.x * w2v; aw[q * 4 + 1] += t4.y * w2v; aw[q * 4 + 2] += t4.z * w2v; aw[q * 4 + 3] += t4.w * w2v;
                aa[q * 4 + 0] += a4.x * a2v; aa[q * 4 + 1] += a4.y * a2v; aa[q * 4 + 2] += a4.z * a2v; aa[q * 4 + 3] += a4.w * a2v;
            }
        }
        const float w0 = p->rw_w0[l * 512 + c], a0 = p->rw_a0[l * 512 + c], kkc = p->rw_k_k[l * 512 + c], kac = p->rw_k_a[l * 512 + c], rkc = p->rw_r_k[l * 512 + c];
#pragma unroll
        for (int r = 0; r < 8; ++r) {
            const size_t o = (size_t)(rbase + r) * 512 + c;
            const float wl = -softplusf(-(w0 + aw[r])) - 0.5f;
            const float decay = expf(-expf(wl));
            const float a = sigmf(a0 + aa[r]);
            const float kr = xk[r] * kkc;
            const float ss = wsum(kr * kr);
            const float kk = kr * rsqrtf(ss + 1e-6f);
            const float k2 = xk[r] * (1.f + (a - 1.f) * kac);
            const float bon = wsum(xr[r] * k2 * rkc) * xv[r];
            p->rr[o] = xr[r]; p->rk[o] = k2; p->rv[o] = xv[r]; p->rw[o] = decay; p->rkk[o] = kk; p->rb[o] = kk * a; p->rbonus[o] = bon;
        }
        __syncthreads();
    }
}

DEVI void dn_scan_item(KP p, int l, int s, int h, int quarter, float* wl) {
    const int lane = tidx() & 63, kh = lane & 1;
    int T, row0; const float* Sin; float* Sout;
    if (s < 8) { T = 2048; row0 = s * 2048; Sin = nullptr; Sout = p->out + O_PDN + (size_t)((l * 8 + s) * 4 + h) * 16384; }
    else { T = 1; row0 = NPR + s - 8; Sin = p->st_dn + (size_t)((l * 128 + s - 8) * 4 + h) * 16384; Sout = p->out + O_SDN + (size_t)((l * 128 + s - 8) * 4 + h) * 16384; }
    const int col = quarter * 32 + (lane >> 1);
    float S[64];
#pragma unroll
    for (int k = 0; k < 64; ++k) S[k] = Sin ? Sin[(kh * 64 + k) * 128 + col] : 0.f;
    float nq0, nq1, nk0, nk1, nv, nb, na;
    {
        const size_t o = (size_t)row0 * 512 + h * 128;
        nq0 = p->dnq[o + lane]; nq1 = p->dnq[o + 64 + lane]; nk0 = p->dnk[o + lane]; nk1 = p->dnk[o + 64 + lane];
        nv = p->dnv[o + col]; nb = p->dnbeta[row0 * 4 + h]; na = p->dna[row0 * 4 + h];
    }
    for (int t = 0; t < T; ++t) {
        const int row = row0 + t;
        wave_sync();
        wl[lane] = nq0; wl[64 + lane] = nq1; wl[128 + lane] = nk0; wl[192 + lane] = nk1;
        const float v = nv, beta = nb, a = na;
        wave_sync();
        {
            const int rn = (t + 1 < T) ? row + 1 : row;
            const size_t o = (size_t)rn * 512 + h * 128;
            nq0 = p->dnq[o + lane]; nq1 = p->dnq[o + 64 + lane]; nk0 = p->dnk[o + lane]; nk1 = p->dnk[o + 64 + lane];
            nv = p->dnv[o + col]; nb = p->dnbeta[rn * 4 + h]; na = p->dna[rn * 4 + h];
        }
        const float4* kp = (const float4*)(wl + 128 + kh * 64);
        const float4* qp = (const float4*)(wl + kh * 64);
        float x0 = 0.f, x1 = 0.f, x2 = 0.f, x3 = 0.f;
#pragma unroll
        for (int k4 = 0; k4 < 16; ++k4) {
            const float4 kv = kp[k4];
            x0 += S[k4 * 4 + 0] * kv.x; x1 += S[k4 * 4 + 1] * kv.y; x2 += S[k4 * 4 + 2] * kv.z; x3 += S[k4 * 4 + 3] * kv.w;
        }
        float x = (x0 + x1) + (x2 + x3);
        x += __shfl_xor(x, 1);
        const float coef = beta * (v - a * x);
        float o0 = 0.f, o1 = 0.f, o2 = 0.f, o3 = 0.f;
#pragma unroll
        for (int k4 = 0; k4 < 16; ++k4) {
            const float4 kv = kp[k4];
            const float4 qv = qp[k4];
            S[k4 * 4 + 0] = a * S[k4 * 4 + 0] + coef * kv.x; o0 += S[k4 * 4 + 0] * qv.x;
            S[k4 * 4 + 1] = a * S[k4 * 4 + 1] + coef * kv.y; o1 += S[k4 * 4 + 1] * qv.y;
            S[k4 * 4 + 2] = a * S[k4 * 4 + 2] + coef * kv.z; o2 += S[k4 * 4 + 2] * qv.z;
            S[k4 * 4 + 3] = a * S[k4 * 4 + 3] + coef * kv.w; o3 += S[k4 * 4 + 3] * qv.w;
        }
        float o = (o0 + o1) + (o2 + o3);
        o += __shfl_xor(o, 1);
        if (kh == 0) p->oraw[(size_t)row * 1536 + h * 128 + col] = o;
    }
#pragma unroll
    for (int k = 0; k < 64; ++k) Sout[(kh * 64 + k) * 128 + col] = S[k];
}

DEVI void gla_scan_item(KP p, int l, int s, int h, int half, float* wl) {
    const int lane = tidx() & 63;
    int T, row0; const float* Sin; float* Sout;
    if (s < 8) { T = 2048; row0 = s * 2048; Sin = nullptr; Sout = p->out + O_PGLA + (size_t)((l * 8 + s) * 4 + h) * 8192; }
    else { T = 1; row0 = NPR + s - 8; Sin = p->st_gla + (size_t)((l * 128 + s - 8) * 4 + h) * 8192; Sout = p->out + O_SGLA + (size_t)((l * 128 + s - 8) * 4 + h) * 8192; }
    const int col = half * 64 + lane;
    float S[64];
#pragma unroll
    for (int k = 0; k < 64; ++k) S[k] = Sin ? Sin[k * 128 + col] : 0.f;
    float nq, nk, nf, nv;
    {
        const bf16_t* pp = p->proj + (size_t)row0 * LDP;
        nq = bf2f(pp[C_GQ + h * 64 + lane]) * 0.125f; nk = bf2f(pp[C_GK + h * 64 + lane]); nv = bf2f(pp[C_GV + h * 128 + col]);
        nf = expf(p->glf[(size_t)row0 * 256 + h * 64 + lane]);
    }
    for (int t = 0; t < T; ++t) {
        const int row = row0 + t;
        wave_sync();
        wl[lane] = nq; wl[64 + lane] = nk; wl[128 + lane] = nf;
        const float v = nv;
        wave_sync();
        {
            const int rn = (t + 1 < T) ? row + 1 : row;
            const bf16_t* pp = p->proj + (size_t)rn * LDP;
            nq = bf2f(pp[C_GQ + h * 64 + lane]) * 0.125f; nk = bf2f(pp[C_GK + h * 64 + lane]); nv = bf2f(pp[C_GV + h * 128 + col]);
            nf = expf(p->glf[(size_t)rn * 256 + h * 64 + lane]);
        }
        float o0 = 0.f, o1 = 0.f, o2 = 0.f, o3 = 0.f;
#pragma unroll
        for (int k4 = 0; k4 < 16; ++k4) {
            const float4 qv = ((const float4*)wl)[k4], kv = ((const float4*)(wl + 64))[k4], fv = ((const float4*)(wl + 128))[k4];
            S[k4 * 4 + 0] = fv.x * S[k4 * 4 + 0] + kv.x * v; o0 += S[k4 * 4 + 0] * qv.x;
            S[k4 * 4 + 1] = fv.y * S[k4 * 4 + 1] + kv.y * v; o1 += S[k4 * 4 + 1] * qv.y;
            S[k4 * 4 + 2] = fv.z * S[k4 * 4 + 2] + kv.z * v; o2 += S[k4 * 4 + 2] * qv.z;
            S[k4 * 4 + 3] = fv.w * S[k4 * 4 + 3] + kv.w * v; o3 += S[k4 * 4 + 3] * qv.w;
        }
        p->oraw[(size_t)row * 1536 + 512 + h * 128 + col] = (o0 + o1) + (o2 + o3);
    }
#pragma unroll
    for (int k = 0; k < 64; ++k) Sout[k * 128 + col] = S[k];
}

DEVI void rw_scan_item(KP p, int l, int s, int h, float* wl) {
    const int lane = tidx() & 63;
    int T, row0; const float* Sin; float* Sout;
    if (s < 8) { T = 2048; row0 = s * 2048; Sin = nullptr; Sout = p->out + O_PRW + (size_t)((l * 8 + s) * 8 + h) * 4096; }
    else { T = 1; row0 = NPR + s - 8; Sin = p->st_rw + (size_t)((l * 128 + s - 8) * 8 + h) * 4096; Sout = p->out + O_SRW + (size_t)((l * 128 + s - 8) * 8 + h) * 4096; }
    float S[64];
#pragma unroll
    for (int k4 = 0; k4 < 16; ++k4) {
        float4 v4 = Sin ? ((const float4*)(Sin + lane * 64))[k4] : make_float4(0.f, 0.f, 0.f, 0.f);
        S[k4 * 4 + 0] = v4.x; S[k4 * 4 + 1] = v4.y; S[k4 * 4 + 2] = v4.z; S[k4 * 4 + 3] = v4.w;
    }
    float nr, nw, nk, nv, nkk, nb;
    {
        const size_t o = (size_t)row0 * 512 + h * 64 + lane;
        nr = p->rr[o]; nw = p->rw[o]; nk = p->rk[o]; nv = p->rv[o]; nkk = p->rkk[o]; nb = p->rb[o];
    }
    for (int t = 0; t < T; ++t) {
        const int row = row0 + t;
        wave_sync();
        wl[lane] = nr; wl[64 + lane] = nw; wl[128 + lane] = nk; wl[192 + lane] = nkk; wl[256 + lane] = nb;
        const float v = nv;
        wave_sync();
        {
            const int rn = (t + 1 < T) ? row + 1 : row;
            const size_t o = (size_t)rn * 512 + h * 64 + lane;
            nr = p->rr[o]; nw = p->rw[o]; nk = p->rk[o]; nv = p->rv[o]; nkk = p->rkk[o]; nb = p->rb[o];
        }
        float x0 = 0.f, x1 = 0.f, x2 = 0.f, x3 = 0.f;
#pragma unroll
        for (int k4 = 0; k4 < 16; ++k4) {
            const float4 kv = ((const float4*)(wl + 192))[k4];
            x0 += S[k4 * 4 + 0] * kv.x; x1 += S[k4 * 4 + 1] * kv.y; x2 += S[k4 * 4 + 2] * kv.z; x3 += S[k4 * 4 + 3] * kv.w;
        }
        const float x = (x0 + x1) + (x2 + x3);
        float o0 = 0.f, o1 = 0.f, o2 = 0.f, o3 = 0.f;
#pragma unroll
        for (int k4 = 0; k4 < 16; ++k4) {
            const float4 rv = ((const float4*)wl)[k4], wv = ((const float4*)(wl + 64))[k4], kv = ((const float4*)(wl + 128))[k4], bv = ((const float4*)(wl + 256))[k4];
            S[k4 * 4 + 0] = S[k4 * 4 + 0] * wv.x - x * bv.x + v * kv.x; o0 += S[k4 * 4 + 0] * rv.x;
            S[k4 * 4 + 1] = S[k4 * 4 + 1] * wv.y - x * bv.y + v * kv.y; o1 += S[k4 * 4 + 1] * rv.y;
            S[k4 * 4 + 2] = S[k4 * 4 + 2] * wv.z - x * bv.z + v * kv.z; o2 += S[k4 * 4 + 2] * rv.z;
            S[k4 * 4 + 3] = S[k4 * 4 + 3] * wv.w - x * bv.w + v * kv.w; o3 += S[k4 * 4 + 3] * rv.w;
        }
        p->oraw[(size_t)row * 1536 + 1024 + h * 64 + lane] = (o0 + o1) + (o2 + o3);
    }
#pragma unroll
    for (int k4 = 0; k4 < 16; ++k4)
        ((float4*)(Sout + lane * 64))[k4] = make_float4(S[k4 * 4 + 0], S[k4 * 4 + 1], S[k4 * 4 + 2], S[k4 * 4 + 3]);
}

DEVI void phase_scan(KP p_, int l, unsigned char* smem) {
    KP p = launder(p_);
    const int wid = tidx() >> 6;
    float* wl = (float*)smem + wid * 512;
    const int nw = gdim() * 8;
    for (int it = wid * gdim() + bidx(); it < 256 + 4096; it += nw) {
        int type, i, sbase;
        if (it < 256) { type = it < 128 ? 0 : (it < 192 ? 1 : 2); i = it < 128 ? it : (it & 63); sbase = 0; }
        else { const int j = it - 256; type = j < 2048 ? 0 : (j < 3072 ? 1 : 2); i = j < 2048 ? j : (j & 1023); sbase = 8; }
#ifdef ONLY_ENGINE
        if (type != ONLY_ENGINE) continue;
#endif
        if (type == 0) dn_scan_item(p, l, sbase + (i >> 4), (i >> 2) & 3, i & 3, wl);
        else if (type == 1) gla_scan_item(p, l, sbase + (i >> 3), (i >> 1) & 3, i & 1, wl);
        else rw_scan_item(p, l, sbase + (i >> 3), i & 7, wl);
    }
}

DEVI void phase_post(KP p_, int l) {
    KP p = launder(p_);
    const int lane = tidx() & 63, wid = tidx() >> 6;
    for (int row = bidx() * 8 + wid; row < NR; row += gdim() * 8) {
        const float* orow = p->oraw + (size_t)row * 1536;
        const bf16_t* pr = p->proj + (size_t)row * LDP;
        bf16_t* ob = p->obf + (size_t)row * 1536;
#pragma unroll
        for (int h = 0; h < 4; ++h) {
            {
                const float2 o = *(const float2*)(orow + h * 128 + lane * 2);
                const float ss = wsum(o.x * o.x + o.y * o.y);
                const float rs = rsqrtf(ss * (1.f / 128.f) + 1e-6f);
                const float2 g = *(const float2*)(p->dn_norm_g + l * 128 + lane * 2);
                const float z0 = bf2f(pr[C_DNZ + h * 128 + lane * 2]), z1 = bf2f(pr[C_DNZ + h * 128 + lane * 2 + 1]);
                ushort2 w; w.x = f2bf(o.x * rs * g.x * siluf(z0)); w.y = f2bf(o.y * rs * g.y * siluf(z1));
                *(ushort2*)(ob + h * 128 + lane * 2) = w;
            }
            {
                const float2 o = *(const float2*)(orow + 512 + h * 128 + lane * 2);
                const float ss = wsum(o.x * o.x + o.y * o.y);
                const float rs = rsqrtf(ss * (1.f / 128.f) + 1e-6f);
                const float2 g = *(const float2*)(p->gla_norm_g + l * 128 + lane * 2);
                const float z0 = bf2f(pr[C_GZ + h * 128 + lane * 2]), z1 = bf2f(pr[C_GZ + h * 128 + lane * 2 + 1]);
                ushort2 w; w.x = f2bf(o.x * rs * g.x * siluf(z0)); w.y = f2bf(o.y * rs * g.y * siluf(z1));
                *(ushort2*)(ob + 512 + h * 128 + lane * 2) = w;
            }
        }
#pragma unroll
        for (int h = 0; h < 8; ++h) {
            const int c = h * 64 + lane;
            const float o = orow[1024 + c];
            const float mu = wsum(o) * (1.f / 64.f);
            const float d = o - mu;
            const float var = wsum(d * d) * (1.f / 64.f);
            float y = d * rsqrtf(var + 64e-5f) * p->rw_ln_w[l * 512 + c] + p->rw_ln_b[l * 512 + c];
            y += p->rbonus[(size_t)row * 512 + c];
            y *= siluf(bf2f(pr[C_RZ + c]));
            ob[1024 + c] = f2bf(y);
        }
    }
}

DEVI void phase_final(KP p_) {
    KP p = launder(p_);
    const int lane = tidx() & 63, wid = tidx() >> 6;
    for (int row = bidx() * 8 + wid; row < NR; row += gdim() * 8) {
        const float4* xr = (const float4*)(p->x + (size_t)row * 1024);
        float4 v[4]; float ss = 0.f;
#pragma unroll
        for (int i = 0; i < 4; ++i) { v[i] = xr[lane + i * 64]; ss += v[i].x * v[i].x + v[i].y * v[i].y + v[i].z * v[i].z + v[i].w * v[i].w; }
        ss = wsum(ss);
        const float rstd = rsqrtf(ss * (1.f / 1024.f) + 1e-6f);
        float4* yo = (float4*)(p->out + (size_t)row * 1024);
#pragma unroll
        for (int i = 0; i < 4; ++i) {
            const float4 g = ((const float4*)p->final_g)[lane + i * 64];
            yo[lane + i * 64] = make_float4(v[i].x * rstd * g.x, v[i].y * rstd * g.y, v[i].z * rstd * g.z, v[i].w * rstd * g.w);
        }
    }
}

constexpr int SMEM_BYTES = (G_BM + G_BN) * G_LDS * 2;
DEVI void run_sub(KP p, int l, int sub, unsigned char* smem) {
    if (sub == 0) phase_norm(p, l);
    else if (sub == 1) { KP q = launder(p); EpiProj e{q->proj}; gemm_phase(smem, q->h, 1024, q->WinT + (size_t)l * LDP * 1024, 1024, NRP / G_BM, LDP / G_BN, 1024, e); }
    else if (sub == 2) phase_prep(p, l, smem);
    else if (sub == 3) phase_scan(p, l, smem);
    else if (sub == 4) phase_post(p, l);
    else { KP q = launder(p); EpiOut e{q->x, q->mod + (size_t)l * NSEQ * 3072}; gemm_phase(smem, q->obf, 1536, q->WoutT + (size_t)l * 1024 * 1536, 1536, NRP / G_BM, 1024 / G_BN, 1536, e); }
}
template <bool kCoop>
__global__ void __launch_bounds__(NT) fwd_kernel(Params p_arg) {
    KP p = (KP)__builtin_amdgcn_kernarg_segment_ptr();
    __shared__ __attribute__((aligned(16))) unsigned char smem[SMEM_BYTES];
    if (kCoop) {
        cg::grid_group grid = cg::this_grid();
        phase_setup(p, smem);
        grid.sync();
#pragma unroll 1
        for (int l = 0; l < 2; ++l) {
            phase_norm(p, l); grid.sync();
            run_sub(p, l, 1, smem); grid.sync();
            phase_prep(p, l, smem); grid.sync();
            phase_scan(p, l, smem); grid.sync();
            phase_post(p, l); grid.sync();
            run_sub(p, l, 5, smem); grid.sync();
        }
        phase_final(p);
    } else {
        const int ph = launder(p)->p0;
        if (ph == 0) phase_setup(p, smem);
        else if (ph == 13) phase_final(p);
        else run_sub(p, (ph - 1) / 6, (ph - 1) % 6, smem);
    }
}

extern "C" void kernel_launch(void* const* d_in, const int* in_sizes, int n_in, void* d_out, int out_size, void* d_ws, size_t ws_size, hipStream_t stream) {
    Params hp{};
    const float** pf = (const float**)&hp;
    for (int i = 0; i < 32; ++i) pf[i] = (const float*)d_in[i];
    hp.out = (float*)d_out;
    char* w = (char*)d_ws;
    auto take = [&](size_t bytes) { char* r = w; w += (bytes + 255) & ~(size_t)255; return r; };
    hp.WinT = (bf16_t*)take((size_t)2 * LDP * 1024 * 2);
    hp.WoutT = (bf16_t*)take((size_t)2 * 1024 * 1536 * 2);
    hp.h = (bf16_t*)take((size_t)NRP * 1024 * 2);
    hp.proj = (bf16_t*)take((size_t)NRP * LDP * 2);
    hp.obf = (bf16_t*)take((size_t)NRP * 1536 * 2);
    hp.mod = (float*)take((size_t)2 * NSEQ * 3072 * 4);
    hp.x = (float*)take((size_t)NR * 1024 * 4);
    hp.dnq = (float*)take((size_t)NR * 512 * 4);
    hp.dnk = (float*)take((size_t)NR * 512 * 4);
    hp.dnv = (float*)take((size_t)NR * 512 * 4);
    hp.dnbeta = (float*)take((size_t)NR * 4 * 4);
    hp.dna = (float*)take((size_t)NR * 4 * 4);
    hp.glf = (float*)take((size_t)NR * 256 * 4);
    hp.rr = (float*)take((size_t)NR * 512 * 4);
    hp.rk = (float*)take((size_t)NR * 512 * 4);
    hp.rv = (float*)take((size_t)NR * 512 * 4);
    hp.rw = (float*)take((size_t)NR * 512 * 4);
    hp.rkk = (float*)take((size_t)NR * 512 * 4);
    hp.rb = (float*)take((size_t)NR * 512 * 4);
    hp.rbonus = (float*)take((size_t)NR * 512 * 4);
    hp.oraw = (float*)take((size_t)NR * 1536 * 4);
    static int grid_blocks = 0;
    if (!grid_blocks) {
        int dev = 0, cus = 0, per_cu = 0;
        hipGetDevice(&dev);
        hipDeviceGetAttribute(&cus, hipDeviceAttributeMultiprocessorCount, dev);
        hipOccupancyMaxActiveBlocksPerMultiprocessor(&per_cu, fwd_kernel<COOP != 0>, NT, 0);
        if (per_cu < 1) fprintf(stderr, "occupancy query returned %d\n", per_cu);
        grid_blocks = cus;
    }
#if COOP
    hp.p0 = 0; hp.p1 = 14;
    void* args[] = {&hp};
    hipError_t e = hipLaunchCooperativeKernel((void*)fwd_kernel<true>, dim3(grid_blocks), dim3(NT), args, 0, stream);
    if (e != hipSuccess) fprintf(stderr, "cooperative launch failed: %s (grid %d)\n", hipGetErrorString(e), grid_blocks);
#else
    for (int ph = 0; ph < 14; ++ph) {
        hp.p0 = ph; hp.p1 = ph + 1;
        fwd_kernel<false><<<grid_blocks, NT, 0, stream>>>(hp);
    }
#endif
}
```

```cpp
#include <hip/hip_runtime.h>
#include <hip/hip_cooperative_groups.h>
#include <cstdio>
namespace cg = cooperative_groups;

#ifndef COOP
#define COOP 1
#endif

#define DEVI __device__ __forceinline__
typedef unsigned short bf16_t;
typedef short bf16x8 __attribute__((ext_vector_type(8)));
typedef float f32x4 __attribute__((ext_vector_type(4)));

constexpr int NT = 512;
constexpr int DM = 1024;
constexpr int NPR = 16384;
constexpr int NR = 16512;
constexpr int NRP = 16640;
constexpr int LDP = 5888;
constexpr int DPROJ = 5784;
constexpr int NSEQ = 136;
constexpr int C_DNQ = 0, C_DNK = 512, C_DNV = 1024, C_DNZ = 1536, C_DNB = 2048, C_DNA = 2052;
constexpr int C_GQ = 2056, C_GK = 2312, C_GV = 2568, C_GZ = 3080, C_GLO = 3592;
constexpr int C_RX = 3608, C_RZ = 5272;
constexpr size_t O_YP = 0;
constexpr size_t O_YS = O_YP + (size_t)16384 * 1024;
constexpr size_t O_PCONV = O_YS + (size_t)128 * 1024;
constexpr size_t O_PDN = O_PCONV + (size_t)2 * 8 * 3 * 1536;
constexpr size_t O_PGLA = O_PDN + (size_t)2 * 8 * 4 * 128 * 128;
constexpr size_t O_PRS = O_PGLA + (size_t)2 * 8 * 4 * 64 * 128;
constexpr size_t O_PRW = O_PRS + (size_t)2 * 8 * 1664;
constexpr size_t O_SCONV = O_PRW + (size_t)2 * 8 * 8 * 64 * 64;
constexpr size_t O_SDN = O_SCONV + (size_t)2 * 128 * 3 * 1536;
constexpr size_t O_SGLA = O_SDN + (size_t)2 * 128 * 4 * 128 * 128;
constexpr size_t O_SRS = O_SGLA + (size_t)2 * 128 * 4 * 64 * 128;
constexpr size_t O_SRW = O_SRS + (size_t)2 * 128 * 1664;

struct Params {
    const float *x_prompt, *x_sample, *c_prompt, *c_sample, *st_conv, *st_dn, *st_gla, *st_rs, *st_rw;
    const float *norm_g, *ada_w, *ada_b, *w_in, *conv_w, *a_log, *dt_bias, *dn_norm_g, *gla_wf, *gla_bf, *gla_norm_g;
    const float *rw_mu, *rw_w0, *rw_w2, *rw_a0, *rw_a2, *rw_k_k, *rw_k_a, *rw_r_k, *rw_ln_w, *rw_ln_b, *w_out, *final_g;
    float* out;
    bf16_t *WinT, *WoutT, *h, *proj, *obf;
    float *mod, *x, *dnq, *dnk, *dnv, *dnbeta, *dna, *glf, *rr, *rk, *rv, *rw, *rkk, *rb, *rbonus, *oraw;
    bf16_t *dnW, *dnR, *dnKT, *dnM, *dnUT, *dnO1, *dnVT, *rwW, *rwR, *rwKT, *rwBT, *rwM, *rwUT, *rwO1, *rwVT, *glR, *glKT, *glO1, *glVT;
    float *dnpc, *dnav, *rwpc, *glpc;
    int p0, p1;
};

typedef const __attribute__((address_space(4))) Params* KP;
DEVI KP launder(KP q) { asm volatile("" : "+s"(q)); return q; }
DEVI int tidx() { int v = threadIdx.x; asm volatile("" : "+v"(v)); return v; }
DEVI int bidx() { int v = blockIdx.x; asm volatile("" : "+s"(v)); return v; }
DEVI int gdim() { int v = gridDim.x; asm volatile("" : "+s"(v)); return v; }
DEVI bf16_t f2bf(float f) { unsigned u = __float_as_uint(f); u += 0x7fffu + ((u >> 16) & 1u); return (bf16_t)(u >> 16); }
DEVI float bf2f(bf16_t b) { return __uint_as_float(((unsigned)b) << 16); }
DEVI float wsum(float v) {
#pragma unroll
    for (int o = 32; o > 0; o >>= 1) v += __shfl_xor(v, o);
    return v;
}
DEVI float siluf(float x) { return x / (1.f + expf(-x)); }
DEVI float sigmf(float x) { return 1.f / (1.f + expf(-x)); }
DEVI float softplusf(float x) { return x > 20.f ? x : log1pf(expf(x)); }
DEVI void wave_sync() {
    __builtin_amdgcn_fence(__ATOMIC_RELEASE, "wavefront");
    __builtin_amdgcn_wave_barrier();
    __builtin_amdgcn_fence(__ATOMIC_ACQUIRE, "wavefront");
}
DEVI int mod_row(int row) { return row < NPR ? (row >> 11) : (8 + row - NPR); }

DEVI void transpose_tile(const float* src, bf16_t* dst, int K, int N, int k0, int n0, float* tl) {
    const int tid = tidx();
#pragma unroll
    for (int i = 0; i < 8; ++i) {
        int kk = (tid >> 6) + i * 8, nn = tid & 63;
        float v = (n0 + nn < N) ? src[(size_t)(k0 + kk) * N + n0 + nn] : 0.f;
        tl[kk * 65 + nn] = v;
    }
    __syncthreads();
#pragma unroll
    for (int i = 0; i < 8; ++i) {
        int nn = (tid >> 6) + i * 8, kk = tid & 63;
        dst[(size_t)(n0 + nn) * K + k0 + kk] = f2bf(tl[kk * 65 + nn]);
    }
    __syncthreads();
}

DEVI void phase_setup(KP p_, unsigned char* smem) {
    KP p = launder(p_);
    const int tid = tidx();
    float* tl = (float*)smem;
    for (int it = bidx(); it < 2 * 16 * 92; it += gdim()) {
        int l = it / (16 * 92), r = it % (16 * 92), kt = r / 92, nt = r % 92;
        transpose_tile(p->w_in + (size_t)l * 1024 * DPROJ, p->WinT + (size_t)l * LDP * 1024, 1024, DPROJ, kt * 64, nt * 64, tl);
    }
    for (int it = bidx(); it < 2 * 24 * 16; it += gdim()) {
        int l = it / (24 * 16), r = it % (24 * 16), kt = r / 16, nt = r % 16;
        transpose_tile(p->w_out + (size_t)l * 1536 * 1024, p->WoutT + (size_t)l * 1024 * 1536, 1536, 1024, kt * 64, nt * 64, tl);
    }
    {
        const float4* s0 = (const float4*)p->x_prompt; const float4* s1 = (const float4*)p->x_sample; float4* d = (float4*)p->x;
        const size_t n0 = (size_t)NPR * 256, n1 = (size_t)NR * 256;
        for (size_t i = (size_t)bidx() * NT + tid; i < n1; i += (size_t)gdim() * NT) d[i] = i < n0 ? s0[i] : s1[i - n0];
        for (size_t i = (size_t)bidx() * NT + tid; i < (size_t)(NRP - NR) * 1024; i += (size_t)gdim() * NT) p->h[(size_t)NR * 1024 + i] = 0;
        for (size_t i = (size_t)bidx() * NT + tid; i < (size_t)(NRP - NR) * 1536; i += (size_t)gdim() * NT) p->obf[(size_t)NR * 1536 + i] = 0;
    }
    float* sc = (float*)smem;
    for (int it = bidx(); it < 2 * 6 * 17; it += gdim()) {
        int l = it / 102, r = it % 102, jt = r / 17, rg = r % 17;
        for (int idx = tid; idx < 8192; idx += NT) {
            int rr = idx >> 10, k = idx & 1023, mb = rg * 8 + rr;
            float c = mb < 8 ? p->c_prompt[mb * 1024 + k] : p->c_sample[(mb - 8) * 1024 + k];
            sc[k * 8 + rr] = siluf(c);
        }
        __syncthreads();
        const int col = jt * 512 + tid;
        float acc[8];
#pragma unroll
        for (int i = 0; i < 8; ++i) acc[i] = 0.f;
        const float* aw = p->ada_w + (size_t)l * 1024 * 3072 + col;
#pragma unroll 4
        for (int k = 0; k < 1024; ++k) {
            float a = aw[(size_t)k * 3072];
            float4 s0 = ((const float4*)sc)[k * 2], s1 = ((const float4*)sc)[k * 2 + 1];
            acc[0] += s0.x * a; acc[1] += s0.y * a; acc[2] += s0.z * a; acc[3] += s0.w * a;
            acc[4] += s1.x * a; acc[5] += s1.y * a; acc[6] += s1.z * a; acc[7] += s1.w * a;
        }
        float bb = p->ada_b[l * 3072 + col];
#pragma unroll
        for (int i = 0; i < 8; ++i) p->mod[((size_t)l * NSEQ + rg * 8 + i) * 3072 + col] = acc[i] + bb;
        __syncthreads();
    }
}

DEVI void phase_norm(KP p_, int l) {
    KP p = launder(p_);
    const int lane = tidx() & 63, wid = tidx() >> 6;
    for (int row = bidx() * 8 + wid; row < NR; row += gdim() * 8) {
        const float4* xr = (const float4*)(p->x + (size_t)row * 1024);
        float4 v[4]; float ss = 0.f;
#pragma unroll
        for (int i = 0; i < 4; ++i) { v[i] = xr[lane + i * 64]; ss += v[i].x * v[i].x + v[i].y * v[i].y + v[i].z * v[i].z + v[i].w * v[i].w; }
        ss = wsum(ss);
        const float rstd = rsqrtf(ss * (1.f / 1024.f) + 1e-6f);
        const float* md = p->mod + ((size_t)l * NSEQ + mod_row(row)) * 3072;
#pragma unroll
        for (int i = 0; i < 4; ++i) {
            const int c = (lane + i * 64) * 4;
            float4 g = *(const float4*)(p->norm_g + l * 1024 + c), sh = *(const float4*)(md + c), sc = *(const float4*)(md + 1024 + c);
            ushort4 o;
            o.x = f2bf(v[i].x * rstd * g.x * (1.f + sc.x) + sh.x);
            o.y = f2bf(v[i].y * rstd * g.y * (1.f + sc.y) + sh.y);
            o.z = f2bf(v[i].z * rstd * g.z * (1.f + sc.z) + sh.z);
            o.w = f2bf(v[i].w * rstd * g.w * (1.f + sc.w) + sh.w);
            *(ushort4*)(p->h + (size_t)row * 1024 + c) = o;
        }
    }
}

constexpr int G_BM = 256, G_BN = 128, G_BK = 64, G_LDS = 72;
template <class Epi>
DEVI void gemm_phase(unsigned char* smem, const bf16_t* A, int lda, const bf16_t* Bt, int ldb, int Mtiles, int Ntiles, int K, const Epi& epi) {
    bf16_t* As = (bf16_t*)smem;
    bf16_t* Bs = As + G_BM * G_LDS;
    const int tid = tidx(), lane = tid & 63, wid = tid >> 6, wm = wid >> 1, wn = wid & 1;
    const int fr = lane & 15, fq = lane >> 4;
    const int nk = K / G_BK;
    for (int t = bidx(); t < Mtiles * Ntiles; t += gdim()) {
        const int mt = t / Ntiles, nt = t % Ntiles;
        const bf16_t* Ag = A + (size_t)mt * G_BM * lda;
        const bf16_t* Bg = Bt + (size_t)nt * G_BN * ldb;
        f32x4 acc[4][4];
#pragma unroll
        for (int i = 0; i < 4; ++i)
#pragma unroll
            for (int j = 0; j < 4; ++j) acc[i][j] = (f32x4){0.f, 0.f, 0.f, 0.f};
        const int sr = tid >> 3, scol = (tid & 7) * 8;
        const bf16_t* Ap = Ag + (size_t)sr * lda + scol;
        const bf16_t* Bp = Bg + (size_t)sr * ldb + scol;
        uint4 ra0 = *(const uint4*)(Ap), ra1 = *(const uint4*)(Ap + (size_t)64 * lda), ra2 = *(const uint4*)(Ap + (size_t)128 * lda), ra3 = *(const uint4*)(Ap + (size_t)192 * lda);
        uint4 rb0 = *(const uint4*)(Bp), rb1 = *(const uint4*)(Bp + (size_t)64 * ldb);
        for (int kt = 0; kt < nk; ++kt) {
            *(uint4*)(As + sr * G_LDS + scol) = ra0; *(uint4*)(As + (sr + 64) * G_LDS + scol) = ra1;
            *(uint4*)(As + (sr + 128) * G_LDS + scol) = ra2; *(uint4*)(As + (sr + 192) * G_LDS + scol) = ra3;
            *(uint4*)(Bs + sr * G_LDS + scol) = rb0; *(uint4*)(Bs + (sr + 64) * G_LDS + scol) = rb1;
            __syncthreads();
            if (kt + 1 < nk) {
                const int k0 = (kt + 1) * G_BK;
                ra0 = *(const uint4*)(Ap + k0); ra1 = *(const uint4*)(Ap + (size_t)64 * lda + k0); ra2 = *(const uint4*)(Ap + (size_t)128 * lda + k0); ra3 = *(const uint4*)(Ap + (size_t)192 * lda + k0);
                rb0 = *(const uint4*)(Bp + k0); rb1 = *(const uint4*)(Bp + (size_t)64 * ldb + k0);
            }
#pragma unroll
            for (int ks = 0; ks < 2; ++ks) {
                bf16x8 af[4], bfr[4];
#pragma unroll
                for (int i = 0; i < 4; ++i) af[i] = *(const bf16x8*)(As + (wm * 64 + i * 16 + fr) * G_LDS + ks * 32 + fq * 8);
#pragma unroll
                for (int j = 0; j < 4; ++j) bfr[j] = *(const bf16x8*)(Bs + (wn * 64 + j * 16 + fr) * G_LDS + ks * 32 + fq * 8);
#pragma unroll
                for (int i = 0; i < 4; ++i)
#pragma unroll
                    for (int j = 0; j < 4; ++j) acc[i][j] = __builtin_amdgcn_mfma_f32_16x16x32_bf16(bfr[j], af[i], acc[i][j], 0, 0, 0);
            }
            __syncthreads();
        }
#pragma unroll
        for (int i = 0; i < 4; ++i)
#pragma unroll
            for (int j = 0; j < 4; ++j) epi(mt * G_BM + wm * 64 + i * 16 + fr, nt * G_BN + wn * 64 + j * 16 + fq * 4, acc[i][j]);
    }
}
struct EpiProj {
    bf16_t* proj;
    DEVI void operator()(int m, int n, f32x4 v) const {
        ushort4 o; o.x = f2bf(v[0]); o.y = f2bf(v[1]); o.z = f2bf(v[2]); o.w = f2bf(v[3]);
        *(ushort4*)(proj + (size_t)m * LDP + n) = o;
    }
};
struct EpiOut {
    float* x; const float* mod;
    DEVI void operator()(int m, int n, f32x4 v) const {
        if (m >= NR) return;
        const float4 g = *(const float4*)(mod + (size_t)mod_row(m) * 3072 + 2048 + n);
        float4* xp = (float4*)(x + (size_t)m * 1024 + n);
        float4 xv = *xp;
        xv.x += g.x * v[0]; xv.y += g.y * v[1]; xv.z += g.z * v[2]; xv.w += g.w * v[3];
        *xp = xv;
    }
};

DEVI float dn_full(KP p, int l, int s, int row0, int f, int col) {
    if (f < 3) { if (s < 8) return 0.f; return p->st_conv[((size_t)(l * 128 + (s - 8)) * 3 + f) * 1536 + col]; }
    return bf2f(p->proj[(size_t)(row0 + f - 3) * LDP + col]);
}
DEVI void seq_of_row(int row, int& s, int& t, int& T, int& row0) {
    if (row < NPR) { s = row >> 11; t = row & 2047; T = 2048; row0 = s * 2048; }
    else { s = 8 + row - NPR; t = 0; T = 1; row0 = row; }
}

DEVI void phase_prep(KP p_, int l, unsigned char* smem) {
    KP p = launder(p_);
    const int tid = tidx(), lane = tid & 63, wid = tid >> 6;
    for (int it = NPR * 4 + bidx() * 8 + wid; it < NR * 4; it += gdim() * 8) {
        const int row = it >> 2, h = it & 3;
        int s, t, T, row0; seq_of_row(row, s, t, T, row0);
        float val[3][2];
#pragma unroll
        for (int seg = 0; seg < 3; ++seg)
#pragma unroll
            for (int e = 0; e < 2; ++e) {
                const int col = seg * 512 + h * 128 + lane * 2 + e;
                float a = 0.f;
#pragma unroll
                for (int j = 0; j < 4; ++j) a += dn_full(p, l, s, row0, t + j, col) * p->conv_w[(l * 4 + j) * 1536 + col];
                val[seg][e] = siluf(a);
            }
        float sq = wsum(val[0][0] * val[0][0] + val[0][1] * val[0][1]);
        float sk = wsum(val[1][0] * val[1][0] + val[1][1] * val[1][1]);
        const float rq = rsqrtf(sq + 1e-6f) * 0.08838834764831845f, rk = rsqrtf(sk + 1e-6f);
        const size_t o = (size_t)row * 512 + h * 128 + lane * 2;
        *(float2*)(p->dnq + o) = make_float2(val[0][0] * rq, val[0][1] * rq);
        *(float2*)(p->dnk + o) = make_float2(val[1][0] * rk, val[1][1] * rk);
        *(float2*)(p->dnv + o) = make_float2(val[2][0], val[2][1]);
        if (lane == 0) {
            float braw = bf2f(p->proj[(size_t)row * LDP + C_DNB + h]), araw = bf2f(p->proj[(size_t)row * LDP + C_DNA + h]);
            p->dnbeta[row * 4 + h] = sigmf(braw);
            float g = -expf(p->a_log[l * 4 + h]) * softplusf(araw + p->dt_bias[l * 4 + h]);
            p->dna[row * 4 + h] = expf(g);
        }
        if (t == T - 1) {
            float* dst = (s < 8) ? p->out + O_PCONV + (size_t)(l * 8 + s) * 3 * 1536 : p->out + O_SCONV + (size_t)(l * 128 + s - 8) * 3 * 1536;
#pragma unroll
            for (int j = 0; j < 3; ++j)
#pragma unroll
                for (int seg = 0; seg < 3; ++seg)
#pragma unroll
                    for (int e = 0; e < 2; ++e) {
                        const int col = seg * 512 + h * 128 + lane * 2 + e;
                        dst[j * 1536 + col] = dn_full(p, l, s, row0, T + j, col);
                    }
        }
    }
    for (int row = NPR + bidx() * 8 + wid; row < NR; row += gdim() * 8) {
        float glo[16];
#pragma unroll
        for (int j = 0; j < 16; ++j) glo[j] = bf2f(p->proj[(size_t)row * LDP + C_GLO + j]);
#pragma unroll
        for (int i = 0; i < 4; ++i) {
            const int c = lane + i * 64;
            float z = p->gla_bf[l * 256 + c];
#pragma unroll
            for (int j = 0; j < 16; ++j) z += glo[j] * p->gla_wf[(l * 16 + j) * 256 + c];
            p->glf[(size_t)row * 256 + c] = -softplusf(-z) * (1.f / 16.f);
        }
    }
    float* twT = (float*)smem;
    float* alT = twT + 64 * 8;
    for (int tile = NPR / 8 + bidx(); tile < NR / 8; tile += gdim()) {
        const int c = tid;
        const int rbase = tile * 8;
        const bool samp = rbase >= NPR;
        const float mur = p->rw_mu[l * 1664 + c], muk = p->rw_mu[l * 1664 + 512 + c], muv = p->rw_mu[l * 1664 + 1024 + c];
        float xr[8], xk[8], xv[8];
        float pr = 0.f, pk = 0.f, pv = 0.f;
        if (!samp && (rbase & 2047) != 0) {
            const bf16_t* pp = p->proj + (size_t)(rbase - 1) * LDP + C_RX;
            pr = bf2f(pp[c]); pk = bf2f(pp[512 + c]); pv = bf2f(pp[1024 + c]);
        }
#pragma unroll
        for (int r = 0; r < 8; ++r) {
            const int row = rbase + r;
            const bf16_t* pp = p->proj + (size_t)row * LDP + C_RX;
            const float cr = bf2f(pp[c]), ck = bf2f(pp[512 + c]), cv = bf2f(pp[1024 + c]);
            if (samp) { const float* st = p->st_rs + (size_t)(l * 128 + row - NPR) * 1664; pr = st[c]; pk = st[512 + c]; pv = st[1024 + c]; }
            xr[r] = cr + (pr - cr) * mur; xk[r] = ck + (pk - ck) * muk; xv[r] = cv + (pv - cv) * muv;
            pr = cr; pk = ck; pv = cv;
            if (samp || (row & 2047) == 2047) {
                float* dst = samp ? p->out + O_SRS + (size_t)(l * 128 + row - NPR) * 1664 : p->out + O_PRS + (size_t)(l * 8 + (row >> 11)) * 1664;
                dst[c] = cr; dst[512 + c] = ck; dst[1024 + c] = cv;
                if (c < 128) dst[1536 + c] = bf2f(pp[1536 + c]);
            }
        }
        if (c < 128) {
            const int col = 1536 + c, j = c & 63;
            const float mu = p->rw_mu[l * 1664 + col];
            float pw = 0.f;
            if (!samp && (rbase & 2047) != 0) pw = bf2f(p->proj[(size_t)(rbase - 1) * LDP + C_RX + col]);
#pragma unroll
            for (int r = 0; r < 8; ++r) {
                const int row = rbase + r;
                const float cw = bf2f(p->proj[(size_t)row * LDP + C_RX + col]);
                if (samp) pw = p->st_rs[(size_t)(l * 128 + row - NPR) * 1664 + col];
                const float xm = cw + (pw - cw) * mu;
                pw = cw;
                if (c < 64) twT[j * 8 + r] = tanhf(xm); else alT[j * 8 + r] = xm;
            }
        }
        __syncthreads();
        float aw[8], aa[8];
#pragma unroll
        for (int r = 0; r < 8; ++r) { aw[r] = 0.f; aa[r] = 0.f; }
#pragma unroll 2
        for (int j = 0; j < 64; ++j) {
            const float w2v = p->rw_w2[((size_t)l * 64 + j) * 512 + c], a2v = p->rw_a2[((size_t)l * 64 + j) * 512 + c];
#pragma unroll
            for (int q = 0; q < 2; ++q) {
                const float4 t4 = ((const float4*)twT)[j * 2 + q], a4 = ((const float4*)alT)[j * 2 + q];
                aw[q * 4 + 0] += t4.x * w2v; aw[q * 4 + 1] += t4.y * w2v; aw[q * 4 + 2] += t4.z * w2v; aw[q * 4 + 3] += t4.w * w2v;
                aa[q * 4 + 0] += a4.x * a2v; aa[q * 4 + 1] += a4.y * a2v; aa[q * 4 + 2] += a4.z * a2v; aa[q * 4 + 3] += a4.w * a2v;
            }
        }
        const float w0 = p->rw_w0[l * 512 + c], a0 = p->rw_a0[l * 512 + c], kkc = p->rw_k_k[l * 512 + c], kac = p->rw_k_a[l * 512 + c], rkc = p->rw_r_k[l * 512 + c];
#pragma unroll
        for (int r = 0; r < 8; ++r) {
            const size_t o = (size_t)(rbase + r) * 512 + c;
            const float wl = -softplusf(-(w0 + aw[r])) - 0.5f;
            const float decay = expf(-expf(wl));
            const float a = sigmf(a0 + aa[r]);
            const float kr = xk[r] * kkc;
            const float ss = wsum(kr * kr);
            const float kk = kr * rsqrtf(ss + 1e-6f);
            const float k2 = xk[r] * (1.f + (a - 1.f) * kac);
            const float bon = wsum(xr[r] * k2 * rkc) * xv[r];
            p->rr[o] = xr[r]; p->rk[o] = k2; p->rv[o] = xv[r]; p->rw[o] = decay; p->rkk[o] = kk; p->rb[o] = kk * a; p->rbonus[o] = bon;
        }
        __syncthreads();
    }
}

DEVI void dn_scan_item(KP p, int l, int s, int h, int quarter, float* wl) {
    const int lane = tidx() & 63, kh = lane & 1;
    const int row = NPR + s - 8;
    const float* Sin = p->st_dn + (size_t)((l * 128 + s - 8) * 4 + h) * 16384;
    float* Sout = p->out + O_SDN + (size_t)((l * 128 + s - 8) * 4 + h) * 16384;
    const int col = quarter * 32 + (lane >> 1);
    float S[64];
#pragma unroll
    for (int k = 0; k < 64; ++k) S[k] = Sin[(kh * 64 + k) * 128 + col];
    const size_t o = (size_t)row * 512 + h * 128;
    wave_sync();
    wl[lane] = p->dnq[o + lane]; wl[64 + lane] = p->dnq[o + 64 + lane]; wl[128 + lane] = p->dnk[o + lane]; wl[192 + lane] = p->dnk[o + 64 + lane];
    const float v = p->dnv[o + col], beta = p->dnbeta[row * 4 + h], a = p->dna[row * 4 + h];
    wave_sync();
    const float4* kp = (const float4*)(wl + 128 + kh * 64);
    const float4* qp = (const float4*)(wl + kh * 64);
    float x0 = 0.f, x1 = 0.f, x2 = 0.f, x3 = 0.f;
#pragma unroll
    for (int k4 = 0; k4 < 16; ++k4) {
        const float4 kv = kp[k4];
        x0 += S[k4 * 4 + 0] * kv.x; x1 += S[k4 * 4 + 1] * kv.y; x2 += S[k4 * 4 + 2] * kv.z; x3 += S[k4 * 4 + 3] * kv.w;
    }
    float x = (x0 + x1) + (x2 + x3);
    x += __shfl_xor(x, 1);
    const float coef = beta * (v - a * x);
    float o0 = 0.f, o1 = 0.f, o2 = 0.f, o3 = 0.f;
#pragma unroll
    for (int k4 = 0; k4 < 16; ++k4) {
        const float4 kv = kp[k4];
        const float4 qv = qp[k4];
        S[k4 * 4 + 0] = a * S[k4 * 4 + 0] + coef * kv.x; o0 += S[k4 * 4 + 0] * qv.x;
        S[k4 * 4 + 1] = a * S[k4 * 4 + 1] + coef * kv.y; o1 += S[k4 * 4 + 1] * qv.y;
        S[k4 * 4 + 2] = a * S[k4 * 4 + 2] + coef * kv.z; o2 += S[k4 * 4 + 2] * qv.z;
        S[k4 * 4 + 3] = a * S[k4 * 4 + 3] + coef * kv.w; o3 += S[k4 * 4 + 3] * qv.w;
    }
    float ov = (o0 + o1) + (o2 + o3);
    ov += __shfl_xor(ov, 1);
    if (kh == 0) p->oraw[(size_t)row * 1536 + h * 128 + col] = ov;
#pragma unroll
    for (int k = 0; k < 64; ++k) Sout[(kh * 64 + k) * 128 + col] = S[k];
}

DEVI void gla_scan_item(KP p, int l, int s, int h, int half, float* wl) {
    const int lane = tidx() & 63;
    const int row = NPR + s - 8;
    const float* Sin = p->st_gla + (size_t)((l * 128 + s - 8) * 4 + h) * 8192;
    float* Sout = p->out + O_SGLA + (size_t)((l * 128 + s - 8) * 4 + h) * 8192;
    const int col = half * 64 + lane;
    float S[64];
#pragma unroll
    for (int k = 0; k < 64; ++k) S[k] = Sin[k * 128 + col];
    const bf16_t* pp = p->proj + (size_t)row * LDP;
    wave_sync();
    wl[lane] = bf2f(pp[C_GQ + h * 64 + lane]) * 0.125f; wl[64 + lane] = bf2f(pp[C_GK + h * 64 + lane]);
    wl[128 + lane] = expf(p->glf[(size_t)row * 256 + h * 64 + lane]);
    const float v = bf2f(pp[C_GV + h * 128 + col]);
    wave_sync();
    float o0 = 0.f, o1 = 0.f, o2 = 0.f, o3 = 0.f;
#pragma unroll
    for (int k4 = 0; k4 < 16; ++k4) {
        const float4 qv = ((const float4*)wl)[k4], kv = ((const float4*)(wl + 64))[k4], fv = ((const float4*)(wl + 128))[k4];
        S[k4 * 4 + 0] = fv.x * S[k4 * 4 + 0] + kv.x * v; o0 += S[k4 * 4 + 0] * qv.x;
        S[k4 * 4 + 1] = fv.y * S[k4 * 4 + 1] + kv.y * v; o1 += S[k4 * 4 + 1] * qv.y;
        S[k4 * 4 + 2] = fv.z * S[k4 * 4 + 2] + kv.z * v; o2 += S[k4 * 4 + 2] * qv.z;
        S[k4 * 4 + 3] = fv.w * S[k4 * 4 + 3] + kv.w * v; o3 += S[k4 * 4 + 3] * qv.w;
    }
    p->oraw[(size_t)row * 1536 + 512 + h * 128 + col] = (o0 + o1) + (o2 + o3);
#pragma unroll
    for (int k = 0; k < 64; ++k) Sout[k * 128 + col] = S[k];
}

DEVI void rw_scan_item(KP p, int l, int s, int h, float* wl) {
    const int lane = tidx() & 63;
    const int row = NPR + s - 8;
    const float* Sin = p->st_rw + (size_t)((l * 128 + s - 8) * 8 + h) * 4096;
    float* Sout = p->out + O_SRW + (size_t)((l * 128 + s - 8) * 8 + h) * 4096;
    float S[64];
#pragma unroll
    for (int k4 = 0; k4 < 16; ++k4) {
        const float4 v4 = ((const float4*)(Sin + lane * 64))[k4];
        S[k4 * 4 + 0] = v4.x; S[k4 * 4 + 1] = v4.y; S[k4 * 4 + 2] = v4.z; S[k4 * 4 + 3] = v4.w;
    }
    const size_t o = (size_t)row * 512 + h * 64 + lane;
    wave_sync();
    wl[lane] = p->rr[o]; wl[64 + lane] = p->rw[o]; wl[128 + lane] = p->rk[o]; wl[192 + lane] = p->rkk[o]; wl[256 + lane] = p->rb[o];
    const float v = p->rv[o];
    wave_sync();
    float x0 = 0.f, x1 = 0.f, x2 = 0.f, x3 = 0.f;
#pragma unroll
    for (int k4 = 0; k4 < 16; ++k4) {
        const float4 kv = ((const float4*)(wl + 192))[k4];
        x0 += S[k4 * 4 + 0] * kv.x; x1 += S[k4 * 4 + 1] * kv.y; x2 += S[k4 * 4 + 2] * kv.z; x3 += S[k4 * 4 + 3] * kv.w;
    }
    const float x = (x0 + x1) + (x2 + x3);
    float o0 = 0.f, o1 = 0.f, o2 = 0.f, o3 = 0.f;
#pragma unroll
    for (int k4 = 0; k4 < 16; ++k4) {
        const float4 rv = ((const float4*)wl)[k4], wv = ((const float4*)(wl + 64))[k4], kv = ((const float4*)(wl + 128))[k4], bv = ((const float4*)(wl + 256))[k4];
        S[k4 * 4 + 0] = S[k4 * 4 + 0] * wv.x - x * bv.x + v * kv.x; o0 += S[k4 * 4 + 0] * rv.x;
        S[k4 * 4 + 1] = S[k4 * 4 + 1] * wv.y - x * bv.y + v * kv.y; o1 += S[k4 * 4 + 1] * rv.y;
        S[k4 * 4 + 2] = S[k4 * 4 + 2] * wv.z - x * bv.z + v * kv.z; o2 += S[k4 * 4 + 2] * rv.z;
        S[k4 * 4 + 3] = S[k4 * 4 + 3] * wv.w - x * bv.w + v * kv.w; o3 += S[k4 * 4 + 3] * rv.w;
    }
    p->oraw[(size_t)row * 1536 + 1024 + h * 64 + lane] = (o0 + o1) + (o2 + o3);
#pragma unroll
    for (int k4 = 0; k4 < 16; ++k4)
        ((float4*)(Sout + lane * 64))[k4] = make_float4(S[k4 * 4 + 0], S[k4 * 4 + 1], S[k4 * 4 + 2], S[k4 * 4 + 3]);
}

typedef float f32x2 __attribute__((ext_vector_type(2)));
typedef __bf16 bf16x2_t __attribute__((ext_vector_type(2)));
typedef unsigned u32x2 __attribute__((ext_vector_type(2)));
typedef unsigned u32x4 __attribute__((ext_vector_type(4)));
DEVI unsigned pk2(float a, float b) { f32x2 v = {a, b}; bf16x2_t r = __builtin_convertvector(v, bf16x2_t); return __builtin_bit_cast(unsigned, r); }
DEVI bf16_t bfr(float a) { return (bf16_t)(pk2(a, 0.f) & 0xffffu); }
DEVI int permpos(int i) { return (i & ~31) | ((i & 12) << 1) | ((i & 16) >> 2) | (i & 3); }
DEVI float expc(float x) { return expf(fminf(x, 80.f)); }
#define MFMA16(a, b, c) __builtin_amdgcn_mfma_f32_16x16x32_bf16((a), (b), (c), 0, 0, 0)

template <class F>
DEVI void lds_mm(const bf16_t* A, int lda, const bf16_t* Bt, int ldb, int MT, int NTl, int KS, F epi) {
    const int tid = tidx(), lane = tid & 63, wid = tid >> 6, r = lane & 15, q = lane >> 4;
    for (int t = wid; t < MT * NTl; t += 8) {
        const int mt = t / NTl, nt = t % NTl;
        f32x4 acc = {0.f, 0.f, 0.f, 0.f};
        for (int ks = 0; ks < KS; ++ks) {
            const bf16x8 a = *(const bf16x8*)(A + (mt * 16 + r) * lda + ks * 32 + q * 8);
            const bf16x8 b = *(const bf16x8*)(Bt + (nt * 16 + r) * ldb + ks * 32 + q * 8);
            acc = MFMA16(a, b, acc);
        }
#pragma unroll
        for (int jj = 0; jj < 4; ++jj) epi(mt * 16 + q * 4 + jj, nt * 16 + r, acc[jj]);
    }
}

DEVI void tri_inverse(const float* Mab, bf16_t* bT, int lane) {
    float Tc[64];
#pragma unroll
    for (int i = 0; i < 64; ++i) {
        float a0 = (lane == i) ? 1.f : 0.f, a1 = 0.f, a2 = 0.f, a3 = 0.f;
#pragma unroll
        for (int j4 = 0; j4 < (i + 3) / 4; ++j4) {
            const float4 m = *(const float4*)(Mab + i * 68 + j4 * 4);
            if (j4 * 4 + 0 < i) a0 += m.x * Tc[j4 * 4 + 0];
            if (j4 * 4 + 1 < i) a1 += m.y * Tc[j4 * 4 + 1];
            if (j4 * 4 + 2 < i) a2 += m.z * Tc[j4 * 4 + 2];
            if (j4 * 4 + 3 < i) a3 += m.w * Tc[j4 * 4 + 3];
        }
        Tc[i] = (a0 + a1) + (a2 + a3);
        bT[i * 72 + lane] = bfr(Tc[i]);
    }
}

template <int DK, int DV>
DEVI void prepass_core(const float* Mab, const bf16_t* bMak, const bf16_t* bMrk, bf16_t* bT, bf16_t* bYT, const bf16_t* bAST, const bf16_t* bVT,
                       bf16_t* gW, bf16_t* gUT, bf16_t* gO1) {
    lds_mm(bMak, 72, bVT, 72, 4, DV / 16, 2, [&](int i, int dv, float y) { bYT[dv * 72 + i] = bfr(y); });
    lds_mm(bMrk, 72, bVT, 72, 4, DV / 16, 2, [&](int i, int dv, float o) { gO1[i * DV + dv] = bfr(o); });
    if ((tidx() >> 6) == 0) tri_inverse(Mab, bT, tidx() & 63);
    __syncthreads();
    lds_mm(bT, 72, bYT, 72, 4, DV / 16, 2, [&](int i, int dv, float u) { gUT[dv * 64 + i] = bfr(u); });
    lds_mm(bT, 72, bAST, 72, 4, DK / 16, 2, [&](int i, int dk, float w) { gW[i * DK + permpos(dk)] = bfr(w); });
}

constexpr int PP_F = 0;
constexpr int PP_BK = 35840;
constexpr int PP_BQ = PP_BK + 17408;
constexpr int PP_AST = PP_BQ + 17408;
constexpr int PP_VT = PP_AST + 18432;
constexpr int PP_MAK = PP_VT + 18432;
constexpr int PP_MRK = PP_MAK + 9216;
constexpr int PP_T = PP_MRK + 9216;
constexpr int PP_SC = PP_T + 9216;
constexpr int PP_BYTES = PP_SC + 4096;

DEVI void prepass_dn(KP p, int l, int s, int h, int c, unsigned char* smem) {
    const int tid = tidx(), lane = tid & 63, wid = tid >> 6;
    float* F = (float*)(smem + PP_F);
    float* Mab = (float*)(smem + PP_F);
    bf16_t* bYT = (bf16_t*)(smem + PP_F + 17408);
    bf16_t* bK = (bf16_t*)(smem + PP_BK); bf16_t* bQ = (bf16_t*)(smem + PP_BQ);
    bf16_t* bAST = (bf16_t*)(smem + PP_AST); bf16_t* bVT = (bf16_t*)(smem + PP_VT);
    bf16_t* bMak = (bf16_t*)(smem + PP_MAK); bf16_t* bMrk = (bf16_t*)(smem + PP_MRK); bf16_t* bT = (bf16_t*)(smem + PP_T);
    float* Lam = (float*)(smem + PP_SC); float* Lm1 = Lam + 64; float* bb = Lam + 128; float* aa = Lam + 192;
    const int item = (s * 4 + h) * 32 + c;
    const int rowbase = s * 2048 + c * 64;
    bf16_t* gW = p->dnW + (size_t)item * 8192; bf16_t* gR = p->dnR + (size_t)item * 8192; bf16_t* gKT = p->dnKT + (size_t)item * 8192;
    bf16_t* gM = p->dnM + (size_t)item * 4096; bf16_t* gUT = p->dnUT + (size_t)item * 8192; bf16_t* gO1 = p->dnO1 + (size_t)item * 8192;
    bf16_t* gVT = p->dnVT + (size_t)item * 8192;
    if (wid == 0) {
        const int row = rowbase + lane;
        const float braw = bf2f(p->proj[(size_t)row * LDP + C_DNB + h]), araw = bf2f(p->proj[(size_t)row * LDP + C_DNA + h]);
        const float g = -expf(p->a_log[l * 4 + h]) * softplusf(araw + p->dt_bias[l * 4 + h]);
        float L = g;
#pragma unroll
        for (int o = 1; o < 64; o <<= 1) { const float t = __shfl_up(L, o); if (lane >= o) L += t; }
        Lam[lane] = L; Lm1[lane] = L - g; bb[lane] = sigmf(braw); aa[lane] = expf(g);
        p->dnav[(size_t)item * 64 + lane] = expf(g);
        const float LC = __shfl(L, 63);
        p->dnpc[(size_t)item * 128 + lane] = expf(LC); p->dnpc[(size_t)item * 128 + 64 + lane] = expf(LC);
    }
    const int col = tid & 127, rg = tid >> 7;
    auto conv_seg = [&](int seg, float (&outv)[16]) {
        const int pc = seg * 512 + h * 128 + col;
        const float cw0 = p->conv_w[(l * 4 + 0) * 1536 + pc], cw1 = p->conv_w[(l * 4 + 1) * 1536 + pc], cw2 = p->conv_w[(l * 4 + 2) * 1536 + pc], cw3 = p->conv_w[(l * 4 + 3) * 1536 + pc];
        const int t0 = c * 64 + rg * 16;
        const bf16_t* pp = p->proj + (size_t)(s * 2048) * LDP + pc;
        float w0 = t0 >= 3 ? bf2f(pp[(size_t)(t0 - 3) * LDP]) : 0.f, w1 = t0 >= 2 ? bf2f(pp[(size_t)(t0 - 2) * LDP]) : 0.f, w2 = t0 >= 1 ? bf2f(pp[(size_t)(t0 - 1) * LDP]) : 0.f;
#pragma unroll
        for (int ii = 0; ii < 16; ++ii) {
            const float cur = bf2f(pp[(size_t)(t0 + ii) * LDP]);
            outv[ii] = siluf(w0 * cw0 + w1 * cw1 + w2 * cw2 + cur * cw3);
            w0 = w1; w1 = w2; w2 = cur;
        }
    };
    float cv[16];
    conv_seg(1, cv);
#pragma unroll
    for (int ii = 0; ii < 16; ++ii) F[(rg * 16 + ii) * 129 + col] = cv[ii];
    __syncthreads();
    {
        const float LC = Lam[63];
        for (int i = wid * 8; i < wid * 8 + 8; ++i) {
            const float v0 = F[i * 129 + lane], v1 = F[i * 129 + 64 + lane];
            const float rn = rsqrtf(wsum(v0 * v0 + v1 * v1) + 1e-6f);
            const float k0 = v0 * rn, k1 = v1 * rn;
            const float e1 = expf(Lm1[i]), e2 = bb[i] * expf(LC - Lam[i]);
            bK[i * 136 + lane] = bfr(k0); bK[i * 136 + 64 + lane] = bfr(k1);
            bAST[lane * 72 + i] = bfr(k0 * e1); bAST[(64 + lane) * 72 + i] = bfr(k1 * e1);
            gKT[lane * 64 + permpos(i)] = bfr(k0 * e2); gKT[(64 + lane) * 64 + permpos(i)] = bfr(k1 * e2);
        }
    }
    __syncthreads();
    conv_seg(0, cv);
#pragma unroll
    for (int ii = 0; ii < 16; ++ii) F[(rg * 16 + ii) * 129 + col] = cv[ii];
    __syncthreads();
    for (int i = wid * 8; i < wid * 8 + 8; ++i) {
        const float v0 = F[i * 129 + lane], v1 = F[i * 129 + 64 + lane];
        const float rn = rsqrtf(wsum(v0 * v0 + v1 * v1) + 1e-6f) * 0.08838834764831845f;
        const float q0 = v0 * rn, q1 = v1 * rn, e = expf(Lam[i]);
        bQ[i * 136 + lane] = bfr(q0); bQ[i * 136 + 64 + lane] = bfr(q1);
        gR[i * 128 + permpos(lane)] = bfr(q0 * e); gR[i * 128 + permpos(64 + lane)] = bfr(q1 * e);
    }
    conv_seg(2, cv);
#pragma unroll
    for (int ii = 0; ii < 16; ++ii) {
        const int i = rg * 16 + ii;
        bVT[col * 72 + i] = bfr(cv[ii]);
        gVT[col * 64 + permpos(i)] = bfr(cv[ii]);
    }
    if (c == 31) {
        for (int idx = tid; idx < 3 * 384; idx += NT) {
            const int j = idx / 384, cc = idx % 384, pc = (cc >> 7) * 512 + h * 128 + (cc & 127);
            p->out[O_PCONV + (size_t)((l * 8 + s) * 3 + j) * 1536 + pc] = bf2f(p->proj[(size_t)(s * 2048 + 2045 + j) * LDP + pc]);
        }
    }
    __syncthreads();
    lds_mm(bK, 136, bK, 136, 4, 4, 4, [&](int i, int j, float g) {
        float mak = 0.f;
        if (i > j) mak = bb[j] * g * expf(Lm1[i] - Lam[j]);
        Mab[i * 68 + j] = -aa[j] * mak; bMak[i * 72 + j] = bfr(mak);
    });
    lds_mm(bQ, 136, bK, 136, 4, 4, 4, [&](int i, int j, float g) {
        float mrk = 0.f;
        if (i >= j) mrk = bb[j] * g * expf(Lam[i] - Lam[j]);
        bMrk[i * 72 + j] = bfr(mrk); gM[i * 64 + permpos(j)] = bfr(-aa[j] * mrk);
    });
    __syncthreads();
    prepass_core<128, 128>(Mab, bMak, bMrk, bT, bYT, bAST, bVT, gW, gUT, gO1);
    __syncthreads();
}

DEVI void prepass_rw(KP p, int l, int s, int h, int c, unsigned char* smem) {
    const int tid = tidx(), lane = tid & 63, wid = tid >> 6;
    float* twT = (float*)(smem + PP_F); float* alT = twT + 4096;
    float* Mab = (float*)(smem + PP_F); bf16_t* bYT = (bf16_t*)(smem + PP_F + 17408);
    bf16_t* bAS = (bf16_t*)(smem + PP_BK); bf16_t* bRS = (bf16_t*)(smem + PP_BQ);
    bf16_t* bAST = (bf16_t*)(smem + PP_AST); bf16_t* bBH = (bf16_t*)(smem + PP_AST + 9216);
    bf16_t* bVT = (bf16_t*)(smem + PP_VT); bf16_t* bKH = (bf16_t*)(smem + PP_VT + 9216);
    bf16_t* bMak = (bf16_t*)(smem + PP_MAK); bf16_t* bMrk = (bf16_t*)(smem + PP_MRK); bf16_t* bT = (bf16_t*)(smem + PP_T);
    float* tot = (float*)(smem + PP_SC);
    const int item = (s * 8 + h) * 32 + c;
    const int rowbase = s * 2048 + c * 64;
    bf16_t* gW = p->rwW + (size_t)item * 4096; bf16_t* gR = p->rwR + (size_t)item * 4096; bf16_t* gKT = p->rwKT + (size_t)item * 4096;
    bf16_t* gBT = p->rwBT + (size_t)item * 4096; bf16_t* gM = p->rwM + (size_t)item * 4096; bf16_t* gUT = p->rwUT + (size_t)item * 4096;
    bf16_t* gO1 = p->rwO1 + (size_t)item * 4096; bf16_t* gVT = p->rwVT + (size_t)item * 4096;
    {
        const int col = tid & 127, g4 = tid >> 7;
        const int xc = 1536 + col;
        const float mu = p->rw_mu[l * 1664 + xc];
        const bf16_t* pp = p->proj + (size_t)rowbase * LDP + C_RX + xc;
        const int i0 = g4 * 16;
        float prev = (c * 64 + i0 == 0) ? 0.f : bf2f(pp[(size_t)(i0 - 1) * LDP]);
#pragma unroll
        for (int ii = 0; ii < 16; ++ii) {
            const float cur = bf2f(pp[(size_t)(i0 + ii) * LDP]);
            const float xm = cur + (prev - cur) * mu;
            prev = cur;
            if (col < 64) twT[col * 64 + i0 + ii] = tanhf(xm); else alT[(col - 64) * 64 + i0 + ii] = xm;
        }
    }
    const int ch = lane, hc = h * 64 + ch, i0 = wid * 8;
    float xr[8], xk[8], xv[8];
    {
        const float mur = p->rw_mu[l * 1664 + hc], muk = p->rw_mu[l * 1664 + 512 + hc], muv = p->rw_mu[l * 1664 + 1024 + hc];
        const bf16_t* pp = p->proj + (size_t)rowbase * LDP + C_RX + hc;
        float pr = 0.f, pk = 0.f, pv = 0.f;
        if (c * 64 + i0 != 0) { const bf16_t* q = pp + (size_t)(i0 - 1) * LDP; pr = bf2f(q[0]); pk = bf2f(q[512]); pv = bf2f(q[1024]); }
#pragma unroll
        for (int r = 0; r < 8; ++r) {
            const bf16_t* q = pp + (size_t)(i0 + r) * LDP;
            const float cr = bf2f(q[0]), ck = bf2f(q[512]), cv = bf2f(q[1024]);
            xr[r] = cr + (pr - cr) * mur; xk[r] = ck + (pk - ck) * muk; xv[r] = cv + (pv - cv) * muv;
            pr = cr; pk = ck; pv = cv;
        }
    }
    __syncthreads();
    float aw[8], aa[8];
#pragma unroll
    for (int r = 0; r < 8; ++r) { aw[r] = 0.f; aa[r] = 0.f; }
#pragma unroll 2
    for (int j = 0; j < 64; ++j) {
        const float w2v = p->rw_w2[((size_t)l * 64 + j) * 512 + hc], a2v = p->rw_a2[((size_t)l * 64 + j) * 512 + hc];
#pragma unroll
        for (int q = 0; q < 2; ++q) {
            const float4 t4 = *(const float4*)(twT + j * 64 + i0 + q * 4), a4 = *(const float4*)(alT + j * 64 + i0 + q * 4);
            aw[q * 4 + 0] += t4.x * w2v; aw[q * 4 + 1] += t4.y * w2v; aw[q * 4 + 2] += t4.z * w2v; aw[q * 4 + 3] += t4.w * w2v;
            aa[q * 4 + 0] += a4.x * a2v; aa[q * 4 + 1] += a4.y * a2v; aa[q * 4 + 2] += a4.z * a2v; aa[q * 4 + 3] += a4.w * a2v;
        }
    }
    const float w0 = p->rw_w0[l * 512 + hc], a0 = p->rw_a0[l * 512 + hc], kkc = p->rw_k_k[l * 512 + hc], kac = p->rw_k_a[l * 512 + hc], rkc = p->rw_r_k[l * 512 + hc];
    float lw[8], Ll[8], kkv[8], k2v[8], bv[8];
    float run = 0.f;
#pragma unroll
    for (int r = 0; r < 8; ++r) {
        const float wl = -softplusf(-(w0 + aw[r])) - 0.5f;
        lw[r] = -expf(wl);
        run += lw[r]; Ll[r] = run;
        const float a = sigmf(a0 + aa[r]);
        const float kr = xk[r] * kkc;
        const float kk = kr * rsqrtf(wsum(kr * kr) + 1e-6f);
        const float k2 = xk[r] * (1.f + (a - 1.f) * kac);
        const float bon = wsum(xr[r] * k2 * rkc) * xv[r];
        p->rbonus[(size_t)(rowbase + i0 + r) * 512 + hc] = bon;
        kkv[r] = kk; k2v[r] = k2; bv[r] = -(kk * a);
    }
    tot[wid * 64 + ch] = run;
    __syncthreads();
    {
        float off = 0.f, LC = 0.f;
#pragma unroll
        for (int g = 0; g < 8; ++g) { const float t = tot[g * 64 + ch]; LC += t; if (g < wid) off += t; }
        if (wid == 0) p->rwpc[(size_t)item * 64 + ch] = expc(LC);
#pragma unroll
        for (int r = 0; r < 8; ++r) {
            const int i = i0 + r;
            const float L = off + Ll[r], Lm = L - lw[r];
            const float AS = kkv[r] * expc(Lm), RS = xr[r] * expc(L), em = expc(-L), eC = expc(LC - L);
            bAS[i * 72 + ch] = bfr(AS); bRS[i * 72 + ch] = bfr(RS); bBH[i * 72 + ch] = bfr(bv[r] * em); bKH[i * 72 + ch] = bfr(k2v[r] * em);
            bAST[ch * 72 + i] = bfr(AS); bVT[ch * 72 + i] = bfr(xv[r]);
            gR[i * 64 + permpos(ch)] = bfr(RS);
            gKT[ch * 64 + permpos(i)] = bfr(k2v[r] * eC); gBT[ch * 64 + permpos(i)] = bfr(bv[r] * eC); gVT[ch * 64 + permpos(i)] = bfr(xv[r]);
        }
    }
    if (c == 31 && h == 0) {
        for (int idx = tid; idx < 1664; idx += NT)
            p->out[O_PRS + (size_t)(l * 8 + s) * 1664 + idx] = bf2f(p->proj[(size_t)(s * 2048 + 2047) * LDP + C_RX + idx]);
    }
    __syncthreads();
    lds_mm(bAS, 72, bBH, 72, 4, 4, 2, [&](int i, int j, float g) { Mab[i * 68 + j] = i > j ? g : 0.f; });
    lds_mm(bAS, 72, bKH, 72, 4, 4, 2, [&](int i, int j, float g) { bMak[i * 72 + j] = bfr(i > j ? g : 0.f); });
    lds_mm(bRS, 72, bBH, 72, 4, 4, 2, [&](int i, int j, float g) { gM[i * 64 + permpos(j)] = bfr(i >= j ? g : 0.f); });
    lds_mm(bRS, 72, bKH, 72, 4, 4, 2, [&](int i, int j, float g) { bMrk[i * 72 + j] = bfr(i >= j ? g : 0.f); });
    __syncthreads();
    prepass_core<64, 64>(Mab, bMak, bMrk, bT, bYT, bAST, bVT, gW, gUT, gO1);
    __syncthreads();
}

DEVI void prepass_gla(KP p, int l, int s, int h, int c, unsigned char* smem) {
    const int tid = tidx(), lane = tid & 63, wid = tid >> 6;
    float* glo = (float*)(smem + PP_F);
    bf16_t* bRS = (bf16_t*)(smem + PP_BK); bf16_t* bKH = bRS + 64 * 72;
    bf16_t* bVT = (bf16_t*)(smem + PP_VT); bf16_t* bMrk = (bf16_t*)(smem + PP_MRK);
    float* tot = (float*)(smem + PP_SC);
    const int item = (s * 4 + h) * 32 + c;
    const int rowbase = s * 2048 + c * 64;
    bf16_t* gR = p->glR + (size_t)item * 4096; bf16_t* gKT = p->glKT + (size_t)item * 4096;
    bf16_t* gO1 = p->glO1 + (size_t)item * 8192; bf16_t* gVT = p->glVT + (size_t)item * 8192;
    for (int idx = tid; idx < 1024; idx += NT) glo[idx] = bf2f(p->proj[(size_t)(rowbase + (idx >> 4)) * LDP + C_GLO + (idx & 15)]);
    {
        const int dv = tid & 127, g4 = tid >> 7;
        const bf16_t* pp = p->proj + (size_t)rowbase * LDP + C_GV + h * 128 + dv;
#pragma unroll
        for (int ii = 0; ii < 16; ++ii) {
            const int i = g4 * 16 + ii;
            const bf16_t v = pp[(size_t)i * LDP];
            bVT[dv * 72 + i] = v; gVT[dv * 64 + permpos(i)] = v;
        }
    }
    __syncthreads();
    const int ch = lane, hc = h * 64 + ch, i0 = wid * 8;
    float wf[16];
#pragma unroll
    for (int j = 0; j < 16; ++j) wf[j] = p->gla_wf[(l * 16 + j) * 256 + hc];
    const float bfv = p->gla_bf[l * 256 + hc];
    float Ll[8], qv[8], kv[8];
    float run = 0.f;
#pragma unroll
    for (int r = 0; r < 8; ++r) {
        const int i = i0 + r;
        float z = bfv;
#pragma unroll
        for (int j4 = 0; j4 < 4; ++j4) {
            const float4 g4 = *(const float4*)(glo + i * 16 + j4 * 4);
            z += g4.x * wf[j4 * 4 + 0] + g4.y * wf[j4 * 4 + 1] + g4.z * wf[j4 * 4 + 2] + g4.w * wf[j4 * 4 + 3];
        }
        run += -softplusf(-z) * (1.f / 16.f); Ll[r] = run;
        const bf16_t* pp = p->proj + (size_t)(rowbase + i) * LDP;
        qv[r] = bf2f(pp[C_GQ + hc]) * 0.125f; kv[r] = bf2f(pp[C_GK + hc]);
    }
    tot[wid * 64 + ch] = run;
    __syncthreads();
    {
        float off = 0.f, LC = 0.f;
#pragma unroll
        for (int g = 0; g < 8; ++g) { const float t = tot[g * 64 + ch]; LC += t; if (g < wid) off += t; }
        if (wid == 0) p->glpc[(size_t)item * 64 + ch] = expc(LC);
#pragma unroll
        for (int r = 0; r < 8; ++r) {
            const int i = i0 + r;
            const float L = off + Ll[r];
            const float RS = qv[r] * expc(L);
            bRS[i * 72 + ch] = bfr(RS); bKH[i * 72 + ch] = bfr(kv[r] * expc(-L));
            gR[i * 64 + permpos(ch)] = bfr(RS); gKT[ch * 64 + permpos(i)] = bfr(kv[r] * expc(LC - L));
        }
    }
    __syncthreads();
    lds_mm(bRS, 72, bKH, 72, 4, 4, 2, [&](int i, int j, float g) { bMrk[i * 72 + j] = bfr(i >= j ? g : 0.f); });
    __syncthreads();
    lds_mm(bMrk, 72, bVT, 72, 4, 8, 2, [&](int i, int dv, float o) { gO1[i * 128 + dv] = bfr(o); });
    __syncthreads();
}

DEVI void phase_prepass(KP p_, int l, unsigned char* smem) {
    KP p = launder(p_);
    for (int it = bidx(); it < 4096; it += gdim()) {
#ifdef NO_PRE
        continue;
#endif
        if (it < 2048) prepass_rw(p, l, it >> 8, (it >> 5) & 7, it & 31, smem);
        else if (it < 3072) { const int i = it - 2048; prepass_dn(p, l, i >> 7, (i >> 5) & 3, i & 31, smem); }
        else { const int i = it - 3072; prepass_gla(p, l, i >> 7, (i >> 5) & 3, i & 31, smem); }
    }
}

DEVI f32x4 unpack4(u32x2 u) { return (f32x4){__uint_as_float(u.x << 16), __uint_as_float(u.x & 0xffff0000u), __uint_as_float(u.y << 16), __uint_as_float(u.y & 0xffff0000u)}; }
DEVI bf16x8 pack8(f32x4 a, f32x4 b) { u32x4 r = {pk2(a[0], a[1]), pk2(a[2], a[3]), pk2(b[0], b[1]), pk2(b[2], b[3])}; return __builtin_bit_cast(bf16x8, r); }

template <int TYPE>
DEVI void chunk_seq_wave(KP p, int l, int s, int h, int slice) {
    constexpr int DK = TYPE == 0 ? 128 : 64, DV = TYPE == 2 ? 64 : 128, NDT = DK / 16, NKS = DK / 32, H = TYPE == 2 ? 8 : 4;
    const int lane = tidx() & 63, q = lane >> 4, c = lane & 15;
    const bf16_t* bW = TYPE == 0 ? p->dnW : p->rwW;
    const bf16_t* bR = TYPE == 0 ? p->dnR : (TYPE == 1 ? p->glR : p->rwR);
    const bf16_t* bKT = TYPE == 0 ? p->dnKT : (TYPE == 1 ? p->glKT : p->rwKT);
    const bf16_t* bBT = p->rwBT;
    const bf16_t* bM = TYPE == 0 ? p->dnM : p->rwM;
    const bf16_t* bUT = TYPE == 0 ? p->dnUT : p->rwUT;
    const bf16_t* bO1 = TYPE == 0 ? p->dnO1 : (TYPE == 1 ? p->glO1 : p->rwO1);
    const bf16_t* bVT = TYPE == 0 ? p->dnVT : (TYPE == 1 ? p->glVT : p->rwVT);
    const float* bpc = TYPE == 0 ? p->dnpc : (TYPE == 1 ? p->glpc : p->rwpc);
    const float* bav = p->dnav;
    float* oraw = p->oraw;
    const int ocol = (TYPE == 0 ? 0 : (TYPE == 1 ? 512 : 1024)) + h * DV + slice * 16 + 4 * q;
    f32x4 S[NDT];
#pragma unroll
    for (int dt = 0; dt < NDT; ++dt) S[dt] = (f32x4){0.f, 0.f, 0.f, 0.f};
    for (int ch = 0; ch < 32; ++ch) {
        const size_t item = (size_t)(s * H + h) * 32 + ch;
        const bf16_t* gW = bW + item * (64 * DK); const bf16_t* gR = bR + item * (64 * DK); const bf16_t* gKT = bKT + item * (64 * DK);
        const bf16_t* gBT = bBT + item * (64 * DK); const bf16_t* gM = bM + item * 4096;
        const bf16_t* gUT = bUT + item * (64 * DV); const bf16_t* gO1 = bO1 + item * (64 * DV); const bf16_t* gVT = bVT + item * (64 * DV);
        const float* gpc = bpc + item * DK; const float* gav = bav + item * 64;
        bf16x8 Sb[NKS];
#pragma unroll
        for (int ks = 0; ks < NKS; ++ks) Sb[ks] = pack8(S[2 * ks], S[2 * ks + 1]);
        f32x4 X[4]; bf16x8 Xb[2];
        if (TYPE != 1) {
#pragma unroll
            for (int mt = 0; mt < 4; ++mt) X[mt] = unpack4(*(const u32x2*)(gUT + (slice * 16 + c) * 64 + mt * 16 + 4 * q));
#pragma unroll
            for (int mt = 0; mt < 4; ++mt)
#pragma unroll
                for (int ks = 0; ks < NKS; ++ks) X[mt] = MFMA16(*(const bf16x8*)(gW + (mt * 16 + c) * DK + ks * 32 + 8 * q), Sb[ks], X[mt]);
            Xb[0] = pack8(X[0], X[1]); Xb[1] = pack8(X[2], X[3]);
        }
        f32x4 O[4];
#pragma unroll
        for (int mt = 0; mt < 4; ++mt) O[mt] = unpack4(*(const u32x2*)(gO1 + (mt * 16 + c) * DV + slice * 16 + 4 * q));
#pragma unroll
        for (int mt = 0; mt < 4; ++mt) {
#pragma unroll
            for (int ks = 0; ks < NKS; ++ks) O[mt] = MFMA16(Sb[ks], *(const bf16x8*)(gR + (mt * 16 + c) * DK + ks * 32 + 8 * q), O[mt]);
            if (TYPE != 1) {
#pragma unroll
                for (int k2 = 0; k2 < 2; ++k2) O[mt] = MFMA16(Xb[k2], *(const bf16x8*)(gM + (mt * 16 + c) * 64 + k2 * 32 + 8 * q), O[mt]);
            }
            *(f32x4*)(oraw + (size_t)(s * 2048 + ch * 64 + mt * 16 + c) * 1536 + ocol) = O[mt];
        }
        bf16x8 Vb[2];
        if (TYPE == 0) {
            f32x4 Vn[4];
#pragma unroll
            for (int mt = 0; mt < 4; ++mt) {
                const f32x4 v = unpack4(*(const u32x2*)(gVT + (slice * 16 + c) * 64 + (mt >> 1) * 32 + 8 * q + (mt & 1) * 4));
                const f32x4 a4 = *(const f32x4*)(gav + mt * 16 + 4 * q);
                Vn[mt] = v - a4 * X[mt];
            }
            Vb[0] = pack8(Vn[0], Vn[1]); Vb[1] = pack8(Vn[2], Vn[3]);
        } else {
            Vb[0] = *(const bf16x8*)(gVT + (slice * 16 + c) * 64 + 8 * q); Vb[1] = *(const bf16x8*)(gVT + (slice * 16 + c) * 64 + 32 + 8 * q);
        }
#pragma unroll
        for (int dt = 0; dt < NDT; ++dt) {
            const f32x4 pc4 = *(const f32x4*)(gpc + dt * 16 + 4 * q);
            S[dt] = S[dt] * pc4;
#pragma unroll
            for (int k2 = 0; k2 < 2; ++k2) S[dt] = MFMA16(*(const bf16x8*)(gKT + (dt * 16 + c) * 64 + k2 * 32 + 8 * q), Vb[k2], S[dt]);
            if (TYPE == 2) {
#pragma unroll
                for (int k2 = 0; k2 < 2; ++k2) S[dt] = MFMA16(*(const bf16x8*)(gBT + (dt * 16 + c) * 64 + k2 * 32 + 8 * q), Xb[k2], S[dt]);
            }
        }
    }
    if (TYPE == 2) {
        float* So = p->out + O_PRW + (size_t)((l * 8 + s) * 8 + h) * 4096;
#pragma unroll
        for (int dt = 0; dt < NDT; ++dt) *(f32x4*)(So + (slice * 16 + c) * 64 + dt * 16 + 4 * q) = S[dt];
    } else {
        float* So = p->out + (TYPE == 0 ? O_PDN + (size_t)((l * 8 + s) * 4 + h) * 16384 : O_PGLA + (size_t)((l * 8 + s) * 4 + h) * 8192);
#pragma unroll
        for (int dt = 0; dt < NDT; ++dt)
#pragma unroll
            for (int jj = 0; jj < 4; ++jj) So[(dt * 16 + 4 * q + jj) * 128 + slice * 16 + c] = S[dt][jj];
    }
}

DEVI void phase_scan(KP p_, int l, unsigned char* smem) {
    KP p = launder(p_);
    const int wid = tidx() >> 6, bid = bidx();
    float* wl = (float*)smem + wid * 512;
#ifndef NO_SEQ
    if (wid < 4) {
        for (int it = bid * 4 + wid; it < 768; it += gdim() * 4) {
            if (it < 256) chunk_seq_wave<0>(p, l, it >> 5, (it >> 3) & 3, it & 7);
            else if (it < 512) { const int i = it - 256; chunk_seq_wave<1>(p, l, i >> 5, (i >> 3) & 3, i & 7); }
            else { const int i = it - 512; chunk_seq_wave<2>(p, l, i >> 5, (i >> 2) & 7, i & 3); }
        }
    } else
#endif
    {
#ifndef NO_TOK
        for (int it = bid * 4 + (wid - 4); it < 4096; it += gdim() * 4) {
            if (it < 2048) dn_scan_item(p, l, 8 + (it >> 4), (it >> 2) & 3, it & 3, wl);
            else if (it < 3072) { const int i = it - 2048; gla_scan_item(p, l, 8 + (i >> 3), (i >> 1) & 3, i & 1, wl); }
            else { const int i = it - 3072; rw_scan_item(p, l, 8 + (i >> 3), i & 7, wl); }
        }
#endif
    }
}

DEVI void phase_post(KP p_, int l) {
    KP p = launder(p_);
    const int lane = tidx() & 63, wid = tidx() >> 6;
    for (int row = bidx() * 8 + wid; row < NR; row += gdim() * 8) {
        const float* orow = p->oraw + (size_t)row * 1536;
        const bf16_t* pr = p->proj + (size_t)row * LDP;
        bf16_t* ob = p->obf + (size_t)row * 1536;
#pragma unroll
        for (int h = 0; h < 4; ++h) {
            {
                const float2 o = *(const float2*)(orow + h * 128 + lane * 2);
                const float ss = wsum(o.x * o.x + o.y * o.y);
                const float rs = rsqrtf(ss * (1.f / 128.f) + 1e-6f);
                const float2 g = *(const float2*)(p->dn_norm_g + l * 128 + lane * 2);
                const float z0 = bf2f(pr[C_DNZ + h * 128 + lane * 2]), z1 = bf2f(pr[C_DNZ + h * 128 + lane * 2 + 1]);
                ushort2 w; w.x = f2bf(o.x * rs * g.x * siluf(z0)); w.y = f2bf(o.y * rs * g.y * siluf(z1));
                *(ushort2*)(ob + h * 128 + lane * 2) = w;
            }
            {
                const float2 o = *(const float2*)(orow + 512 + h * 128 + lane * 2);
                const float ss = wsum(o.x * o.x + o.y * o.y);
                const float rs = rsqrtf(ss * (1.f / 128.f) + 1e-6f);
                const float2 g = *(const float2*)(p->gla_norm_g + l * 128 + lane * 2);
                const float z0 = bf2f(pr[C_GZ + h * 128 + lane * 2]), z1 = bf2f(pr[C_GZ + h * 128 + lane * 2 + 1]);
                ushort2 w; w.x = f2bf(o.x * rs * g.x * siluf(z0)); w.y = f2bf(o.y * rs * g.y * siluf(z1));
                *(ushort2*)(ob + 512 + h * 128 + lane * 2) = w;
            }
        }
#pragma unroll
        for (int h = 0; h < 8; ++h) {
            const int c = h * 64 + lane;
            const float o = orow[1024 + c];
            const float mu = wsum(o) * (1.f / 64.f);
            const float d = o - mu;
            const float var = wsum(d * d) * (1.f / 64.f);
            float y = d * rsqrtf(var + 64e-5f) * p->rw_ln_w[l * 512 + c] + p->rw_ln_b[l * 512 + c];
            y += p->rbonus[(size_t)row * 512 + c];
            y *= siluf(bf2f(pr[C_RZ + c]));
            ob[1024 + c] = f2bf(y);
        }
    }
}

DEVI void phase_final(KP p_) {
    KP p = launder(p_);
    const int lane = tidx() & 63, wid = tidx() >> 6;
    for (int row = bidx() * 8 + wid; row < NR; row += gdim() * 8) {
        const float4* xr = (const float4*)(p->x + (size_t)row * 1024);
        float4 v[4]; float ss = 0.f;
#pragma unroll
        for (int i = 0; i < 4; ++i) { v[i] = xr[lane + i * 64]; ss += v[i].x * v[i].x + v[i].y * v[i].y + v[i].z * v[i].z + v[i].w * v[i].w; }
        ss = wsum(ss);
        const float rstd = rsqrtf(ss * (1.f / 1024.f) + 1e-6f);
        float4* yo = (float4*)(p->out + (size_t)row * 1024);
#pragma unroll
        for (int i = 0; i < 4; ++i) {
            const float4 g = ((const float4*)p->final_g)[lane + i * 64];
            yo[lane + i * 64] = make_float4(v[i].x * rstd * g.x, v[i].y * rstd * g.y, v[i].z * rstd * g.z, v[i].w * rstd * g.w);
        }
    }
}

constexpr int SMEM_BYTES = PP_BYTES;
DEVI void run_sub(KP p, int l, int sub, unsigned char* smem) {
    if (sub == 0) phase_norm(p, l);
    else if (sub == 1) { KP q = launder(p); EpiProj e{q->proj}; gemm_phase(smem, q->h, 1024, q->WinT + (size_t)l * LDP * 1024, 1024, NRP / G_BM, LDP / G_BN, 1024, e); }
    else if (sub == 2) { phase_prepass(p, l, smem); phase_prep(p, l, smem); }
    else if (sub == 3) phase_scan(p, l, smem);
    else if (sub == 4) phase_post(p, l);
    else { KP q = launder(p); EpiOut e{q->x, q->mod + (size_t)l * NSEQ * 3072}; gemm_phase(smem, q->obf, 1536, q->WoutT + (size_t)l * 1024 * 1536, 1536, NRP / G_BM, 1024 / G_BN, 1536, e); }
}
template <bool kCoop>
__global__ void __launch_bounds__(NT) fwd_kernel(Params p_arg) {
    KP p = (KP)__builtin_amdgcn_kernarg_segment_ptr();
    __shared__ __attribute__((aligned(16))) unsigned char smem[SMEM_BYTES];
    if (kCoop) {
        cg::grid_group grid = cg::this_grid();
        phase_setup(p, smem);
        grid.sync();
#pragma unroll 1
        for (int l = 0; l < 2; ++l) {
            phase_norm(p, l); grid.sync();
            run_sub(p, l, 1, smem); grid.sync();
            phase_prepass(p, l, smem); phase_prep(p, l, smem); grid.sync();
            phase_scan(p, l, smem); grid.sync();
            phase_post(p, l); grid.sync();
            run_sub(p, l, 5, smem); grid.sync();
        }
        phase_final(p);
    } else {
        const int ph = launder(p)->p0;
        if (ph == 0) phase_setup(p, smem);
        else if (ph == 13) phase_final(p);
        else run_sub(p, (ph - 1) / 6, (ph - 1) % 6, smem);
    }
}

extern "C" void kernel_launch(void* const* d_in, const int* in_sizes, int n_in, void* d_out, int out_size, void* d_ws, size_t ws_size, hipStream_t stream) {
    Params hp{};
    const float** pf = (const float**)&hp;
    for (int i = 0; i < 32; ++i) pf[i] = (const float*)d_in[i];
    hp.out = (float*)d_out;
    char* w = (char*)d_ws;
    auto take = [&](size_t bytes) { char* r = w; w += (bytes + 255) & ~(size_t)255; return r; };
    hp.WinT = (bf16_t*)take((size_t)2 * LDP * 1024 * 2);
    hp.WoutT = (bf16_t*)take((size_t)2 * 1024 * 1536 * 2);
    hp.h = (bf16_t*)take((size_t)NRP * 1024 * 2);
    hp.proj = (bf16_t*)take((size_t)NRP * LDP * 2);
    hp.obf = (bf16_t*)take((size_t)NRP * 1536 * 2);
    hp.mod = (float*)take((size_t)2 * NSEQ * 3072 * 4);
    hp.x = (float*)d_out;
    const size_t soff = (size_t)NPR;
    hp.dnq = (float*)take((size_t)128 * 512 * 4) - soff * 512;
    hp.dnk = (float*)take((size_t)128 * 512 * 4) - soff * 512;
    hp.dnv = (float*)take((size_t)128 * 512 * 4) - soff * 512;
    hp.dnbeta = (float*)take((size_t)128 * 4 * 4) - soff * 4;
    hp.dna = (float*)take((size_t)128 * 4 * 4) - soff * 4;
    hp.glf = (float*)take((size_t)128 * 256 * 4) - soff * 256;
    hp.rr = (float*)take((size_t)128 * 512 * 4) - soff * 512;
    hp.rk = (float*)take((size_t)128 * 512 * 4) - soff * 512;
    hp.rv = (float*)take((size_t)128 * 512 * 4) - soff * 512;
    hp.rw = (float*)take((size_t)128 * 512 * 4) - soff * 512;
    hp.rkk = (float*)take((size_t)128 * 512 * 4) - soff * 512;
    hp.rb = (float*)take((size_t)128 * 512 * 4) - soff * 512;
    hp.rbonus = (float*)take((size_t)NR * 512 * 4);
    hp.oraw = (float*)take((size_t)NR * 1536 * 4);
    hp.dnW = (bf16_t*)take((size_t)1024 * 8192 * 2); hp.dnR = (bf16_t*)take((size_t)1024 * 8192 * 2); hp.dnKT = (bf16_t*)take((size_t)1024 * 8192 * 2);
    hp.dnM = (bf16_t*)take((size_t)1024 * 4096 * 2); hp.dnUT = (bf16_t*)take((size_t)1024 * 8192 * 2); hp.dnO1 = (bf16_t*)take((size_t)1024 * 8192 * 2);
    hp.dnVT = (bf16_t*)take((size_t)1024 * 8192 * 2);
    hp.rwW = (bf16_t*)take((size_t)2048 * 4096 * 2); hp.rwR = (bf16_t*)take((size_t)2048 * 4096 * 2); hp.rwKT = (bf16_t*)take((size_t)2048 * 4096 * 2);
    hp.rwBT = (bf16_t*)take((size_t)2048 * 4096 * 2); hp.rwM = (bf16_t*)take((size_t)2048 * 4096 * 2); hp.rwUT = (bf16_t*)take((size_t)2048 * 4096 * 2);
    hp.rwO1 = (bf16_t*)take((size_t)2048 * 4096 * 2); hp.rwVT = (bf16_t*)take((size_t)2048 * 4096 * 2);
    hp.glR = (bf16_t*)take((size_t)1024 * 4096 * 2); hp.glKT = (bf16_t*)take((size_t)1024 * 4096 * 2);
    hp.glO1 = (bf16_t*)take((size_t)1024 * 8192 * 2); hp.glVT = (bf16_t*)take((size_t)1024 * 8192 * 2);
    hp.dnpc = (float*)take((size_t)1024 * 128 * 4); hp.dnav = (float*)take((size_t)1024 * 64 * 4);
    hp.rwpc = (float*)take((size_t)2048 * 64 * 4); hp.glpc = (float*)take((size_t)1024 * 64 * 4);
    if ((size_t)(w - (char*)d_ws) > ws_size) fprintf(stderr, "workspace too small: need %zu have %zu\n", (size_t)(w - (char*)d_ws), ws_size);
    static int grid_blocks = 0;
    if (!grid_blocks) {
        int dev = 0, cus = 0, per_cu = 0;
        hipGetDevice(&dev);
        hipDeviceGetAttribute(&cus, hipDeviceAttributeMultiprocessorCount, dev);
        hipOccupancyMaxActiveBlocksPerMultiprocessor(&per_cu, fwd_kernel<COOP != 0>, NT, 0);
        if (per_cu < 1) fprintf(stderr, "occupancy query returned %d\n", per_cu);
        grid_blocks = cus;
    }
#if COOP
    hp.p0 = 0; hp.p1 = 14;
    void* args[] = {&hp};
    hipError_t e = hipLaunchCooperativeKernel((void*)fwd_kernel<true>, dim3(grid_blocks), dim3(NT), args, 0, stream);
    if (e != hipSuccess) fprintf(stderr, "cooperative launch failed: %s (grid %d)\n", hipGetErrorString(e), grid_blocks);
#else
    for (int ph = 0; ph < 14; ++ph) {
        hp.p0 = ph; hp.p1 = ph + 1;
        fwd_kernel<false><<<grid_blocks, NT, 0, stream>>>(hp);
    }
#endif
}
```

```cpp
#include <hip/hip_runtime.h>
#include <hip/hip_cooperative_groups.h>
#include <cstdio>
namespace cg = cooperative_groups;

#ifndef REP_PRE
#define REP_PRE 1
#endif
#ifndef REP_SCAN
#define REP_SCAN 1
#endif
#ifndef REP_GEMM
#define REP_GEMM 1
#endif
#ifndef COOP
#define COOP 1
#endif

#define DEVI __device__ __forceinline__
typedef unsigned short bf16_t;
typedef short bf16x8 __attribute__((ext_vector_type(8)));
typedef float f32x4 __attribute__((ext_vector_type(4)));

constexpr int NT = 512;
constexpr int DM = 1024;
constexpr int NPR = 16384;
constexpr int NR = 16512;
constexpr int NRP = 16640;
constexpr int LDP = 5888;
constexpr int DPROJ = 5784;
constexpr int NSEQ = 136;
constexpr int C_DNQ = 0, C_DNK = 512, C_DNV = 1024, C_DNZ = 1536, C_DNB = 2048, C_DNA = 2052;
constexpr int C_GQ = 2056, C_GK = 2312, C_GV = 2568, C_GZ = 3080, C_GLO = 3592;
constexpr int C_RX = 3608, C_RZ = 5272;
constexpr size_t O_YP = 0;
constexpr size_t O_YS = O_YP + (size_t)16384 * 1024;
constexpr size_t O_PCONV = O_YS + (size_t)128 * 1024;
constexpr size_t O_PDN = O_PCONV + (size_t)2 * 8 * 3 * 1536;
constexpr size_t O_PGLA = O_PDN + (size_t)2 * 8 * 4 * 128 * 128;
constexpr size_t O_PRS = O_PGLA + (size_t)2 * 8 * 4 * 64 * 128;
constexpr size_t O_PRW = O_PRS + (size_t)2 * 8 * 1664;
constexpr size_t O_SCONV = O_PRW + (size_t)2 * 8 * 8 * 64 * 64;
constexpr size_t O_SDN = O_SCONV + (size_t)2 * 128 * 3 * 1536;
constexpr size_t O_SGLA = O_SDN + (size_t)2 * 128 * 4 * 128 * 128;
constexpr size_t O_SRS = O_SGLA + (size_t)2 * 128 * 4 * 64 * 128;
constexpr size_t O_SRW = O_SRS + (size_t)2 * 128 * 1664;

struct Params {
    const float *x_prompt, *x_sample, *c_prompt, *c_sample, *st_conv, *st_dn, *st_gla, *st_rs, *st_rw;
    const float *norm_g, *ada_w, *ada_b, *w_in, *conv_w, *a_log, *dt_bias, *dn_norm_g, *gla_wf, *gla_bf, *gla_norm_g;
    const float *rw_mu, *rw_w0, *rw_w2, *rw_a0, *rw_a2, *rw_k_k, *rw_k_a, *rw_r_k, *rw_ln_w, *rw_ln_b, *w_out, *final_g;
    float* out;
    bf16_t *WinT, *WoutT, *h, *proj, *obf;
    float *mod, *x, *dnq, *dnk, *dnv, *dnbeta, *dna, *glf, *rr, *rk, *rv, *rw, *rkk, *rb, *rbonus, *oraw;
    bf16_t *dnW, *dnR, *dnKT, *dnM, *dnUT, *dnO1, *dnVT, *rwW, *rwR, *rwKT, *rwBT, *rwM, *rwUT, *rwO1, *rwVT, *glR, *glKT, *glO1, *glVT;
    float *dnpc, *dnav, *rwpc, *glpc;
    unsigned* bar;
    int p0, p1;
};

typedef const __attribute__((address_space(4))) Params* KP;
DEVI KP launder(KP q) { asm volatile("" : "+s"(q)); return q; }
DEVI int tidx() { int v = threadIdx.x; asm volatile("" : "+v"(v)); return v; }
DEVI int bidx() { int v = blockIdx.x; asm volatile("" : "+s"(v)); return v; }
DEVI int gdim() { int v = gridDim.x; asm volatile("" : "+s"(v)); return v; }
DEVI bf16_t f2bf(float f) { unsigned u = __float_as_uint(f); u += 0x7fffu + ((u >> 16) & 1u); return (bf16_t)(u >> 16); }
DEVI float bf2f(bf16_t b) { return __uint_as_float(((unsigned)b) << 16); }
template <int CTRL> DEVI float dppf(float v) { return __int_as_float(__builtin_amdgcn_update_dpp(0, __float_as_int(v), CTRL, 0xF, 0xF, true)); }
DEVI float rdlane(float v, int l) { return __int_as_float(__builtin_amdgcn_readlane(__float_as_int(v), l)); }
DEVI float wsum(float v) {
    v += dppf<0xB1>(v);
    v += dppf<0x4E>(v);
    v += dppf<0x141>(v);
    v += dppf<0x140>(v);
    return (rdlane(v, 0) + rdlane(v, 16)) + (rdlane(v, 32) + rdlane(v, 48));
}
DEVI float fexp(float x) { return __expf(x); }
DEVI float frcp(float x) { return __builtin_amdgcn_rcpf(x); }
DEVI float siluf(float x) { return x * frcp(1.f + fexp(-x)); }
DEVI float sigmf(float x) { return frcp(1.f + fexp(-x)); }
DEVI float softplusf(float x) { return x > 20.f ? x : __logf(1.f + fexp(x)); }
DEVI float ftanh(float x) { return 1.f - 2.f * frcp(1.f + fexp(2.f * x)); }
DEVI void wave_sync() {
    __builtin_amdgcn_fence(__ATOMIC_RELEASE, "wavefront");
    __builtin_amdgcn_wave_barrier();
    __builtin_amdgcn_fence(__ATOMIC_ACQUIRE, "wavefront");
}
DEVI int mod_row(int row) { return row < NPR ? (row >> 11) : (8 + row - NPR); }

typedef float f32x2 __attribute__((ext_vector_type(2)));
typedef __bf16 bf16x2_t __attribute__((ext_vector_type(2)));
typedef unsigned u32x2 __attribute__((ext_vector_type(2)));
typedef unsigned u32x4 __attribute__((ext_vector_type(4)));
DEVI unsigned pk2(float a, float b) { f32x2 v = {a, b}; bf16x2_t r = __builtin_convertvector(v, bf16x2_t); return __builtin_bit_cast(unsigned, r); }
#define MFMA16(a, b, c) __builtin_amdgcn_mfma_f32_16x16x32_bf16((a), (b), (c), 0, 0, 0)
DEVI void transpose_tile4(const float* src, bf16_t* dst, int K, int N, int k0, int n0, float* tl) {
    const int tid = tidx();
    float v[4][8];
#pragma unroll
    for (int t = 0; t < 4; ++t)
#pragma unroll
        for (int i = 0; i < 8; ++i) {
            const int kk = (tid >> 6) + i * 8, nn = n0 + t * 64 + (tid & 63);
            v[t][i] = nn < N ? src[(size_t)(k0 + kk) * N + nn] : 0.f;
        }
#pragma unroll
    for (int t = 0; t < 4; ++t)
#pragma unroll
        for (int i = 0; i < 8; ++i) tl[t * 4160 + ((tid >> 6) + i * 8) * 65 + (tid & 63)] = v[t][i];
    __syncthreads();
#pragma unroll
    for (int t = 0; t < 4; ++t)
#pragma unroll
        for (int i = 0; i < 4; ++i) {
            const int nn = (tid >> 5) + i * 16, kk = (tid & 31) * 2;
            *(unsigned*)(dst + (size_t)(n0 + t * 64 + nn) * K + k0 + kk) = pk2(tl[t * 4160 + kk * 65 + nn], tl[t * 4160 + (kk + 1) * 65 + nn]);
        }
    __syncthreads();
}

DEVI void phase_setup(KP p_, unsigned char* smem) {
    KP p = launder(p_);
    const int tid = tidx();
    float* tl = (float*)smem;
    for (int it = bidx(); it < 2 * 16 * 23; it += gdim()) {
        int l = it / (16 * 23), r = it % (16 * 23), kt = r / 23, ng = r % 23;
        transpose_tile4(p->w_in + (size_t)l * 1024 * DPROJ, p->WinT + (size_t)l * LDP * 1024, 1024, DPROJ, kt * 64, ng * 256, tl);
    }
    for (int it = bidx(); it < 2 * 24 * 4; it += gdim()) {
        int l = it / (24 * 4), r = it % (24 * 4), kt = r / 4, ng = r % 4;
        transpose_tile4(p->w_out + (size_t)l * 1536 * 1024, p->WoutT + (size_t)l * 1024 * 1536, 1536, 1024, kt * 64, ng * 256, tl);
    }
    {
        for (size_t i = (size_t)bidx() * NT + tid; i < (size_t)(NRP - NR) * 1024; i += (size_t)gdim() * NT) p->h[(size_t)NR * 1024 + i] = 0;
        for (size_t i = (size_t)bidx() * NT + tid; i < (size_t)(NRP - NR) * 1536; i += (size_t)gdim() * NT) p->obf[(size_t)NR * 1536 + i] = 0;
    }
    float* sc = (float*)smem;
    for (int it = bidx(); it < 2 * 6 * 17; it += gdim()) {
        int l = it / 102, r = it % 102, jt = r / 17, rg = r % 17;
        for (int idx = tid; idx < 8192; idx += NT) {
            int rr = idx >> 10, k = idx & 1023, mb = rg * 8 + rr;
            float c = mb < 8 ? p->c_prompt[mb * 1024 + k] : p->c_sample[(mb - 8) * 1024 + k];
            sc[k * 8 + rr] = siluf(c);
        }
        __syncthreads();
        const int col = jt * 512 + tid;
        f32x2 acc2[4];
#pragma unroll
        for (int i = 0; i < 4; ++i) acc2[i] = (f32x2){0.f, 0.f};
        const float* aw = p->ada_w + (size_t)l * 1024 * 3072 + col;
#pragma unroll 16
        for (int k = 0; k < 1024; ++k) {
            const float a = aw[(size_t)k * 3072];
            const f32x2 av = {a, a};
            const f32x4 s0 = ((const f32x4*)sc)[k * 2], s1 = ((const f32x4*)sc)[k * 2 + 1];
            acc2[0] = __builtin_elementwise_fma((f32x2){s0[0], s0[1]}, av, acc2[0]); acc2[1] = __builtin_elementwise_fma((f32x2){s0[2], s0[3]}, av, acc2[1]);
            acc2[2] = __builtin_elementwise_fma((f32x2){s1[0], s1[1]}, av, acc2[2]); acc2[3] = __builtin_elementwise_fma((f32x2){s1[2], s1[3]}, av, acc2[3]);
        }
        float bb = p->ada_b[l * 3072 + col];
#pragma unroll
        for (int i = 0; i < 8; ++i) p->mod[((size_t)l * NSEQ + rg * 8 + i) * 3072 + col] = acc2[i >> 1][i & 1] + bb;
        __syncthreads();
    }
}

DEVI void phase_norm(KP p_, int l) {
    KP p = launder(p_);
    const int lane = tidx() & 63, wid = tidx() >> 6;
    for (int row = bidx() * 8 + wid; row < NR; row += gdim() * 8) {
        const float4* xr = l == 0 ? (row < NPR ? (const float4*)(p->x_prompt + (size_t)row * 1024) : (const float4*)(p->x_sample + (size_t)(row - NPR) * 1024))
                                  : (const float4*)(p->x + (size_t)row * 1024);
        const float* md = p->mod + ((size_t)l * NSEQ + mod_row(row)) * 3072;
        float4 v[4], g[4], sh[4], sc[4];
#pragma unroll
        for (int i = 0; i < 4; ++i) {
            const int c = (lane + i * 64) * 4;
            v[i] = xr[lane + i * 64]; g[i] = *(const float4*)(p->norm_g + l * 1024 + c); sh[i] = *(const float4*)(md + c); sc[i] = *(const float4*)(md + 1024 + c);
        }
        float ss = 0.f;
#pragma unroll
        for (int i = 0; i < 4; ++i) ss += v[i].x * v[i].x + v[i].y * v[i].y + v[i].z * v[i].z + v[i].w * v[i].w;
        ss = wsum(ss);
        const float rstd = rsqrtf(ss * (1.f / 1024.f) + 1e-6f);
#pragma unroll
        for (int i = 0; i < 4; ++i) {
            const int c = (lane + i * 64) * 4;
            ushort4 o;
            o.x = f2bf(v[i].x * rstd * g[i].x * (1.f + sc[i].x) + sh[i].x);
            o.y = f2bf(v[i].y * rstd * g[i].y * (1.f + sc[i].y) + sh[i].y);
            o.z = f2bf(v[i].z * rstd * g[i].z * (1.f + sc[i].z) + sh[i].z);
            o.w = f2bf(v[i].w * rstd * g[i].w * (1.f + sc[i].w) + sh[i].w);
            *(ushort4*)(p->h + (size_t)row * 1024 + c) = o;
        }
    }
}

constexpr int G_BM = 256, G_BN = 128, G_BK = 64, G_LDS = 72;
template <class Epi>
DEVI void gemm_phase(unsigned char* smem, const bf16_t* A, int lda, const bf16_t* Bt, int ldb, int Mtiles, int Ntiles, int K, const Epi& epi, int first_block, int mt0) {
    bf16_t* As = (bf16_t*)smem;
    bf16_t* Bs = As + G_BM * G_LDS;
    const int tid = tidx(), lane = tid & 63, wid = tid >> 6, wm = wid >> 1, wn = wid & 1;
    const int fr = lane & 15, fq = lane >> 4;
    const int nk = K / G_BK;
    for (int t = bidx() - first_block; t < Mtiles * Ntiles; t += gdim()) {
        if (t < 0) continue;
        const int mt = mt0 + t / Ntiles, nt = t % Ntiles;
        const bf16_t* Ag = A + (size_t)mt * G_BM * lda;
        const bf16_t* Bg = Bt + (size_t)nt * G_BN * ldb;
        f32x4 acc[4][4];
#pragma unroll
        for (int i = 0; i < 4; ++i)
#pragma unroll
            for (int j = 0; j < 4; ++j) acc[i][j] = (f32x4){0.f, 0.f, 0.f, 0.f};
        const int sr = tid >> 3, scol = (tid & 7) * 8;
        const bf16_t* Ap = Ag + (size_t)sr * lda + scol;
        const bf16_t* Bp = Bg + (size_t)sr * ldb + scol;
        uint4 ra0 = *(const uint4*)(Ap), ra1 = *(const uint4*)(Ap + (size_t)64 * lda), ra2 = *(const uint4*)(Ap + (size_t)128 * lda), ra3 = *(const uint4*)(Ap + (size_t)192 * lda);
        uint4 rb0 = *(const uint4*)(Bp), rb1 = *(const uint4*)(Bp + (size_t)64 * ldb);
        for (int kt = 0; kt < nk; ++kt) {
            *(uint4*)(As + sr * G_LDS + scol) = ra0; *(uint4*)(As + (sr + 64) * G_LDS + scol) = ra1;
            *(uint4*)(As + (sr + 128) * G_LDS + scol) = ra2; *(uint4*)(As + (sr + 192) * G_LDS + scol) = ra3;
            *(uint4*)(Bs + sr * G_LDS + scol) = rb0; *(uint4*)(Bs + (sr + 64) * G_LDS + scol) = rb1;
            __syncthreads();
            if (kt + 1 < nk) {
                const int k0 = (kt + 1) * G_BK;
                ra0 = *(const uint4*)(Ap + k0); ra1 = *(const uint4*)(Ap + (size_t)64 * lda + k0); ra2 = *(const uint4*)(Ap + (size_t)128 * lda + k0); ra3 = *(const uint4*)(Ap + (size_t)192 * lda + k0);
                rb0 = *(const uint4*)(Bp + k0); rb1 = *(const uint4*)(Bp + (size_t)64 * ldb + k0);
            }
#pragma unroll
            for (int ks = 0; ks < 2; ++ks) {
                bf16x8 af[4], bfr[4];
#pragma unroll
                for (int i = 0; i < 4; ++i) af[i] = *(const bf16x8*)(As + (wm * 64 + i * 16 + fr) * G_LDS + ks * 32 + fq * 8);
#pragma unroll
                for (int j = 0; j < 4; ++j) bfr[j] = *(const bf16x8*)(Bs + (wn * 64 + j * 16 + fr) * G_LDS + ks * 32 + fq * 8);
#pragma unroll
                for (int i = 0; i < 4; ++i)
#pragma unroll
                    for (int j = 0; j < 4; ++j) acc[i][j] = __builtin_amdgcn_mfma_f32_16x16x32_bf16(bfr[j], af[i], acc[i][j], 0, 0, 0);
            }
            __syncthreads();
        }
#pragma unroll
        for (int i = 0; i < 4; ++i)
#pragma unroll
            for (int j = 0; j < 4; ++j) epi(mt * G_BM + wm * 64 + i * 16 + fr, nt * G_BN + wn * 64 + j * 16 + fq * 4, acc[i][j]);
    }
}
struct EpiProj {
    bf16_t* proj;
    DEVI void operator()(int m, int n, f32x4 v) const {
        ushort4 o; o.x = f2bf(v[0]); o.y = f2bf(v[1]); o.z = f2bf(v[2]); o.w = f2bf(v[3]);
        *(ushort4*)(proj + (size_t)m * LDP + n) = o;
    }
};
struct EpiOut {
    float* x; const float* mod;
    DEVI void operator()(int m, int n, f32x4 v) const {
        if (m >= NR) return;
        const float4 g = *(const float4*)(mod + (size_t)mod_row(m) * 3072 + 2048 + n);
        float4* xp = (float4*)(x + (size_t)m * 1024 + n);
        float4 xv = *xp;
        xv.x += g.x * v[0]; xv.y += g.y * v[1]; xv.z += g.z * v[2]; xv.w += g.w * v[3];
        *xp = xv;
    }
};

namespace pg8 {
#define PG8_LAS __attribute__((address_space(3)))
typedef unsigned short bf16_t;
typedef short bf16x8 __attribute__((ext_vector_type(8)));
typedef float f32x4 __attribute__((ext_vector_type(4)));
typedef unsigned u32x4 __attribute__((ext_vector_type(4)));
constexpr int BM = 256, BK = 64, HALF = 128, HTB = HALF * BK * 2  , STAGE_BYTES = 8 * HTB, NXCD = 8, WGM = 8;

__host__ __device__ __forceinline__ int lds_byte(int r, int c) { const int st = (r >> 4) * 2 + (c >> 5), rr = r & 15, cc = c & 31, ob = rr * 64 + cc * 2; return st * 1024 + (ob ^ (((ob >> 9) & 1) << 5)); }
__host__ __device__ __forceinline__ void stage_rc(int b, int& R, int& C) { const int st = b / 1024, sb = b % 1024, swz = sb ^ (((sb >> 9) & 1) << 5); R = (st >> 1) * 16 + swz / 64; C = (st & 1) * 32 + (swz % 64) / 2; }
__host__ __device__ __forceinline__ int perm32(int rho) { const int n = rho >> 4, i = rho & 15; return 8 * (i >> 2) + 4 * n + (i & 3); }

struct Unit { int pm, pn; };
struct Gemm { const bf16_t* A; const bf16_t* Bt; int M, N, K; };

struct StaticOrder {
    int nM, nN, nwg, G, c;
    __host__ __device__ void init(int M, int N, int G_, int c_) { nM = M / BM; nN = N / BM; nwg = nM * nN; G = G_; c = c_; }
    __host__ __device__ bool next(int i, Unit& u) const {
        const long L = (long)i * G + c; if (L >= nwg) return false;
        int wgid = (int)L; { const int q = nwg / NXCD, r = nwg % NXCD, xcd = wgid % NXCD, off = wgid / NXCD; wgid = (xcd < r ? xcd * (q + 1) : r * (q + 1) + (xcd - r) * q) + off; }
        const int nig = WGM * nN, gid = wgid / nig, fm = gid * WGM, gsz = (nM - fm) < WGM ? (nM - fm) : WGM;
        u.pm = fm + ((wgid % nig) % gsz); u.pn = (wgid % nig) / gsz; return true;
    }
    __device__ __forceinline__ void a_ready(const Unit&) const {}
    __device__ __forceinline__ void done(const Unit&) const {}
};
template <class Epi, class Sched, bool STAMP = false>
__device__ __forceinline__ void gemm_phase(PG8_LAS unsigned char* lds, const Gemm g, const Sched& S, const Epi& E, unsigned long long* stamps) {
    const int tid = tidx(), wid = __builtin_amdgcn_readfirstlane(tid >> 6), lane = tid & 63, wr = wid >> 2, wc = wid & 3, fr = lane & 15, fq = lane >> 4;
    const int K = g.K, nt = K / BK;
    int ts_lo = 0, ts_hi = 0, nts = 0; const unsigned long long rt_entry = STAMP ? (unsigned long long)wall_clock64() : 0ull;
#define PG8_STAMP() do { if (STAMP && wid == 0 && nts < 64) { const unsigned long long _c = (unsigned long long)clock64(); \
        ts_lo = (lane == nts) ? (int)(unsigned)_c : ts_lo; ts_hi = (lane == nts) ? (int)(unsigned)(_c >> 32) : ts_hi; ++nts; } } while (0)
    PG8_STAMP();
    unsigned voffA[2], voffB[2];
#pragma unroll
    for (int i = 0; i < 2; ++i) { int R, C; stage_rc(tid * 16 + i * 8192, R, C); const int Rb = Epi::PERM ? ((R & ~31) + perm32(R & 31)) : R;
        voffA[i] = (unsigned)(R * K + C) * 2u; voffB[i] = (unsigned)(Rb * K + C) * 2u; }
    const size_t kstep = (size_t)(BK * 2);
    const size_t hstep = (size_t)HALF * K * 2;
    const size_t tstep = 2 * hstep;
    const unsigned ldsw = (unsigned)wid * 1024u;
    const int aoff = lds_byte(wr * 64 + fr, fq * 8), boff = lds_byte(wc * 32 + fr, fq * 8);
#define PG8_SA(b, h) (((b) * 2 + (h)) * HTB)
#define PG8_SB(b, h) ((4 + (b) * 2 + (h)) * HTB)
#define PG8_STAGE(bufoff, gbase, voff) do { _Pragma("unroll") for (int _i = 0; _i < 2; ++_i) \
        __builtin_amdgcn_global_load_lds((const unsigned*)((const char*)(gbase) + (voff)[_i]), (PG8_LAS unsigned*)(lds + (bufoff) + ldsw + _i * 8192), 16, 0, 0); } while (0)
#define PG8_LDA(dst, b, h) do { _Pragma("unroll") for (int m = 0; m < 4; ++m) _Pragma("unroll") for (int k = 0; k < 2; ++k) dst[m][k] = *(const PG8_LAS bf16x8*)(lds + PG8_SA(b, h) + aoff + m * 2048 + k * 1024); } while (0)
#define PG8_LDB(dst, b, h) do { _Pragma("unroll") for (int n = 0; n < 2; ++n) _Pragma("unroll") for (int k = 0; k < 2; ++k) dst[n][k] = *(const PG8_LAS bf16x8*)(lds + PG8_SB(b, h) + boff + n * 2048 + k * 1024); } while (0)
#define PG8_MMA(ai, bj, At, Bt) do { __builtin_amdgcn_s_setprio(1); _Pragma("unroll") for (int m = 0; m < 4; ++m) _Pragma("unroll") for (int n = 0; n < 2; ++n) _Pragma("unroll") for (int k = 0; k < 2; ++k) \
        acc[ai][bj][m][n] = __builtin_amdgcn_mfma_f32_16x16x32_bf16(Bt[n][k], At[m][k], acc[ai][bj][m][n], 0, 0, 0); __builtin_amdgcn_s_setprio(0); } while (0)
#define PG8_WAIT_V(n) asm volatile("s_waitcnt vmcnt(" #n ")" ::: "memory")
#define PG8_WAIT_L(n) asm volatile("s_waitcnt lgkmcnt(" #n ")" ::: "memory")
#define PG8_BAR __builtin_amdgcn_s_barrier()
#define PG8_SCHED __builtin_amdgcn_sched_barrier(0)
    Unit cur, nxt; int ui = 0;
    if (!S.next(0, cur)) return;
    f32x4 acc[2][2][4][2];
#pragma unroll
    for (int a = 0; a < 2; ++a)
#pragma unroll
        for (int b = 0; b < 2; ++b)
#pragma unroll
            for (int m = 0; m < 4; ++m)
#pragma unroll
                for (int n = 0; n < 2; ++n) acc[a][b][m][n] = (f32x4){0.f, 0.f, 0.f, 0.f};
    bf16x8 At[4][2], B0[2][2], B1[2][2];
    const char* cA = (const char*)g.A + (size_t)cur.pm * tstep; const char* cB = (const char*)g.Bt + (size_t)cur.pn * tstep;
    S.a_ready(cur);
    PG8_STAGE(PG8_SB(0, 0), cB, voffB); PG8_STAGE(PG8_SA(0, 0), cA, voffA); PG8_STAGE(PG8_SB(0, 1), cB + hstep, voffB); PG8_STAGE(PG8_SA(0, 1), cA + hstep, voffA);
    if (wr == 1) PG8_BAR;
    PG8_WAIT_V(4); PG8_BAR;
    PG8_STAGE(PG8_SB(1, 0), cB + kstep, voffB); PG8_STAGE(PG8_SA(1, 0), cA + kstep, voffA); PG8_STAGE(PG8_SB(1, 1), cB + hstep + kstep, voffB);
    PG8_WAIT_V(6); PG8_BAR;
    PG8_STAMP();
    for (;;) {
        const bool has_next = S.next(ui + 1, nxt);
        const char* nA = has_next ? (const char*)g.A + (size_t)nxt.pm * tstep : cA; const char* nB = has_next ? (const char*)g.Bt + (size_t)nxt.pn * tstep : cB;
        for (int t = 0; t < nt; t += 2) {
            const bool last = (t == nt - 2);
            const char* a1 = cA + (size_t)(t + 1) * kstep;
            const char* a2 = last ? nA : cA + (size_t)(t + 2) * kstep; const char* b2 = last ? nB : cB + (size_t)(t + 2) * kstep;
            const char* a3 = a2 + kstep; const char* b3 = b2 + kstep;
            if (last && has_next) S.a_ready(nxt);
            PG8_LDB(B0, 0, 0); PG8_SCHED; PG8_LDA(At, 0, 0); PG8_STAGE(PG8_SA(1, 1), a1 + hstep, voffA);
            PG8_WAIT_L(8); PG8_BAR; PG8_WAIT_L(0); PG8_MMA(0, 0, At, B0); PG8_BAR; PG8_SCHED;
            PG8_LDB(B1, 0, 1); PG8_STAGE(PG8_SB(0, 0), b2, voffB);
            PG8_BAR; PG8_WAIT_L(0); PG8_MMA(0, 1, At, B1); PG8_BAR;
            PG8_LDA(At, 0, 1); PG8_STAGE(PG8_SA(0, 0), a2, voffA);
            PG8_BAR; PG8_WAIT_L(0); PG8_MMA(1, 0, At, B0); PG8_BAR; PG8_SCHED;
            PG8_STAGE(PG8_SB(0, 1), b2 + hstep, voffB);
            PG8_WAIT_V(6); PG8_BAR; PG8_MMA(1, 1, At, B1); PG8_BAR;
            PG8_LDB(B0, 1, 0); PG8_SCHED; PG8_LDA(At, 1, 0); PG8_STAGE(PG8_SA(0, 1), a2 + hstep, voffA);
            PG8_WAIT_L(8); PG8_BAR; PG8_WAIT_L(0); PG8_MMA(0, 0, At, B0); PG8_BAR; PG8_SCHED;
            PG8_LDB(B1, 1, 1); PG8_STAGE(PG8_SB(1, 0), b3, voffB);
            PG8_BAR; PG8_WAIT_L(0); PG8_MMA(0, 1, At, B1); PG8_BAR;
            PG8_LDA(At, 1, 1); PG8_STAGE(PG8_SA(1, 0), a3, voffA);
            PG8_BAR; PG8_WAIT_L(0); PG8_MMA(1, 0, At, B0); PG8_BAR; PG8_SCHED;
            PG8_STAGE(PG8_SB(1, 1), b3 + hstep, voffB);
            PG8_WAIT_V(6); PG8_BAR; PG8_MMA(1, 1, At, B1); PG8_BAR;
        }
        PG8_STAMP();
        if constexpr (!Epi::AFTER_DRAIN) { E(acc, cur, wr, wc, fr, fq); S.done(cur); }
        PG8_STAMP();
        if (!has_next) break;
#pragma unroll
        for (int a = 0; a < 2; ++a)
#pragma unroll
            for (int b = 0; b < 2; ++b)
#pragma unroll
                for (int m = 0; m < 4; ++m)
#pragma unroll
                    for (int n = 0; n < 2; ++n) acc[a][b][m][n] = (f32x4){0.f, 0.f, 0.f, 0.f};
        cur = nxt; cA = nA; cB = nB; ++ui;
    }
    PG8_WAIT_V(0);
    if (wr == 0) PG8_BAR;
    PG8_BAR;
    if constexpr (Epi::AFTER_DRAIN) { E.fused(acc, cur, wr, wc, fr, fq, lds, wid, lane); S.done(cur); }
    PG8_STAMP();
    if (STAMP && wid == 0) { stamps[lane] = lane < nts ? (((unsigned long long)(unsigned)ts_hi << 32) | (unsigned)ts_lo) : 0ull;
        if (lane == 62) stamps[62] = rt_entry; if (lane == 63) stamps[63] = (unsigned long long)wall_clock64(); }
#undef PG8_STAMP
#undef PG8_SA
#undef PG8_SB
#undef PG8_STAGE
#undef PG8_LDA
#undef PG8_LDB
#undef PG8_MMA
#undef PG8_WAIT_V
#undef PG8_WAIT_L
#undef PG8_BAR
#undef PG8_SCHED
}
}

struct EpiProjPG {
    static constexpr bool PERM = true, AFTER_DRAIN = false;
    bf16_t* O;
    DEVI void operator()(const pg8::f32x4 (&acc)[2][2][4][2], const pg8::Unit& u, int wr, int wc, int fr, int fq) const {
        const int row0 = u.pm * 256 + wr * 64 + fr, col0 = u.pn * 256 + wc * 32 + 8 * fq;
#pragma unroll
        for (int ai = 0; ai < 2; ++ai)
#pragma unroll
            for (int m = 0; m < 4; ++m) {
                bf16_t* rowp = O + (size_t)(row0 + ai * 128 + m * 16) * LDP + col0;
#pragma unroll
                for (int bj = 0; bj < 2; ++bj) {
                    const pg8::f32x4 v0 = acc[ai][bj][m][0], v1 = acc[ai][bj][m][1];
                    u32x4 w = {pk2(v0[0], v0[1]), pk2(v0[2], v0[3]), pk2(v1[0], v1[1]), pk2(v1[2], v1[3])};
                    *(u32x4*)(rowp + bj * 128) = w;
                }
            }
    }
};
struct EpiOutPG {
    static constexpr bool PERM = false, AFTER_DRAIN = false;
    float* x; const float* xin; const float* mod;
    DEVI void operator()(const pg8::f32x4 (&acc)[2][2][4][2], const pg8::Unit& u, int wr, int wc, int fr, int fq) const {
        const int row0 = u.pm * 256 + wr * 64 + fr, col0 = u.pn * 256 + wc * 32 + 4 * fq;
        const float* gp = mod + (size_t)(u.pm >> 3) * 3072 + 2048 + col0;
        pg8::f32x4 gv[2][2];
#pragma unroll
        for (int bj = 0; bj < 2; ++bj)
#pragma unroll
            for (int n = 0; n < 2; ++n) gv[bj][n] = *(const pg8::f32x4*)(gp + bj * 128 + n * 16);
#pragma unroll
        for (int ai = 0; ai < 2; ++ai)
#pragma unroll
            for (int m = 0; m < 4; ++m) {
                const size_t ro = (size_t)(row0 + ai * 128 + m * 16) * 1024 + col0;
#pragma unroll
                for (int bj = 0; bj < 2; ++bj)
#pragma unroll
                    for (int n = 0; n < 2; ++n)
                        *(pg8::f32x4*)(x + ro + bj * 128 + n * 16) = *(const pg8::f32x4*)(xin + ro + bj * 128 + n * 16) + gv[bj][n] * acc[ai][bj][m][n];
            }
    }
};
DEVI void out_gemm_sample(KP p_, int l) {
    KP p = launder(p_);
    const int nt = bidx();
    if (nt >= 64) return;
    const int lane = tidx() & 63, wid = tidx() >> 6, q = lane >> 4, c = lane & 15;
    const bf16_t* a = p->obf + (size_t)(NPR + wid * 16 + c) * 1536 + 8 * q;
    const bf16_t* b = p->WoutT + (size_t)l * 1024 * 1536 + (size_t)(nt * 16 + c) * 1536 + 8 * q;
    f32x4 acc0 = {0.f, 0.f, 0.f, 0.f}, acc1 = {0.f, 0.f, 0.f, 0.f};
#pragma unroll 8
    for (int ks = 0; ks < 48; ks += 2) {
        acc0 = MFMA16(*(const bf16x8*)(b + ks * 32), *(const bf16x8*)(a + ks * 32), acc0);
        acc1 = MFMA16(*(const bf16x8*)(b + ks * 32 + 32), *(const bf16x8*)(a + ks * 32 + 32), acc1);
    }
    const int m = NPR + wid * 16 + c, n = nt * 16 + 4 * q;
    const f32x4 g = *(const f32x4*)(p->mod + ((size_t)l * NSEQ + mod_row(m)) * 3072 + 2048 + n);
    const float* xi = l == 0 ? p->x_sample + (size_t)(m - NPR) * 1024 + n : p->x + (size_t)m * 1024 + n;
    *(f32x4*)(p->x + (size_t)m * 1024 + n) = *(const f32x4*)xi + g * (acc0 + acc1);
}
DEVI float dn_full(KP p, int l, int s, int row0, int f, int col) {
    if (f < 3) { if (s < 8) return 0.f; return p->st_conv[((size_t)(l * 128 + (s - 8)) * 3 + f) * 1536 + col]; }
    return bf2f(p->proj[(size_t)(row0 + f - 3) * LDP + col]);
}
DEVI void seq_of_row(int row, int& s, int& t, int& T, int& row0) {
    if (row < NPR) { s = row >> 11; t = row & 2047; T = 2048; row0 = s * 2048; }
    else { s = 8 + row - NPR; t = 0; T = 1; row0 = row; }
}

DEVI void phase_prep(KP p_, int l, unsigned char* smem) {
    KP p = launder(p_);
    const int tid = tidx(), lane = tid & 63, wid = tid >> 6;
    for (int it = NPR * 4 + bidx() * 8 + wid; it < NR * 4; it += gdim() * 8) {
        const int row = it >> 2, h = it & 3, b = row - NPR;
        const float* st = p->st_conv + (size_t)(l * 128 + b) * 3 * 1536;
        float* cdst = p->out + O_SCONV + (size_t)(l * 128 + b) * 3 * 1536;
        float val[3][2];
#pragma unroll
        for (int seg = 0; seg < 3; ++seg) {
            const int col = seg * 512 + h * 128 + lane * 2;
            const float2 s0 = *(const float2*)(st + col), s1 = *(const float2*)(st + 1536 + col), s2 = *(const float2*)(st + 3072 + col);
            const unsigned cu = *(const unsigned*)(p->proj + (size_t)row * LDP + col);
            const float2 cur = make_float2(__uint_as_float(cu << 16), __uint_as_float(cu & 0xffff0000u));
            const float2 w0 = *(const float2*)(p->conv_w + (l * 4 + 0) * 1536 + col), w1 = *(const float2*)(p->conv_w + (l * 4 + 1) * 1536 + col);
            const float2 w2 = *(const float2*)(p->conv_w + (l * 4 + 2) * 1536 + col), w3 = *(const float2*)(p->conv_w + (l * 4 + 3) * 1536 + col);
            val[seg][0] = siluf(s0.x * w0.x + s1.x * w1.x + s2.x * w2.x + cur.x * w3.x);
            val[seg][1] = siluf(s0.y * w0.y + s1.y * w1.y + s2.y * w2.y + cur.y * w3.y);
            *(float2*)(cdst + col) = s1; *(float2*)(cdst + 1536 + col) = s2; *(float2*)(cdst + 3072 + col) = cur;
        }
        float sq = wsum(val[0][0] * val[0][0] + val[0][1] * val[0][1]);
        float sk = wsum(val[1][0] * val[1][0] + val[1][1] * val[1][1]);
        const float rq = rsqrtf(sq + 1e-6f) * 0.08838834764831845f, rk = rsqrtf(sk + 1e-6f);
        const size_t o = (size_t)row * 512 + h * 128 + lane * 2;
        *(float2*)(p->dnq + o) = make_float2(val[0][0] * rq, val[0][1] * rq);
        *(float2*)(p->dnk + o) = make_float2(val[1][0] * rk, val[1][1] * rk);
        *(float2*)(p->dnv + o) = make_float2(val[2][0], val[2][1]);
        if (lane == 0) {
            float braw = bf2f(p->proj[(size_t)row * LDP + C_DNB + h]), araw = bf2f(p->proj[(size_t)row * LDP + C_DNA + h]);
            p->dnbeta[row * 4 + h] = sigmf(braw);
            float g = -fexp(p->a_log[l * 4 + h]) * softplusf(araw + p->dt_bias[l * 4 + h]);
            p->dna[row * 4 + h] = fexp(g);
        }
    }
    for (int row = NPR + ((bidx() + gdim() - 64) % gdim()) * 8 + wid; row < NR; row += gdim() * 8) {
        float glo[16];
#pragma unroll
        for (int j = 0; j < 16; ++j) glo[j] = bf2f(p->proj[(size_t)row * LDP + C_GLO + j]);
#pragma unroll
        for (int i = 0; i < 4; ++i) {
            const int c = lane + i * 64;
            float z = p->gla_bf[l * 256 + c];
#pragma unroll
            for (int j = 0; j < 16; ++j) z += glo[j] * p->gla_wf[(l * 16 + j) * 256 + c];
            p->glf[(size_t)row * 256 + c] = -softplusf(-z) * (1.f / 16.f);
        }
    }
    constexpr int RT = 2;
    float* twT = (float*)smem;
    float* alT = twT + 64 * RT;
    for (int tile = NPR / RT + (bidx() + gdim() - 128) % gdim(); tile < NR / RT; tile += gdim()) {
        const int c = tid;
        const int rbase = tile * RT;
        const float mur = p->rw_mu[l * 1664 + c], muk = p->rw_mu[l * 1664 + 512 + c], muv = p->rw_mu[l * 1664 + 1024 + c];
        float xr[RT], xk[RT], xv[RT];
#pragma unroll
        for (int r = 0; r < RT; ++r) {
            const int row = rbase + r;
            const bf16_t* pp = p->proj + (size_t)row * LDP + C_RX;
            const float cr = bf2f(pp[c]), ck = bf2f(pp[512 + c]), cv = bf2f(pp[1024 + c]);
            const float* st = p->st_rs + (size_t)(l * 128 + row - NPR) * 1664;
            const float pr = st[c], pk = st[512 + c], pv = st[1024 + c];
            xr[r] = cr + (pr - cr) * mur; xk[r] = ck + (pk - ck) * muk; xv[r] = cv + (pv - cv) * muv;
            float* dst = p->out + O_SRS + (size_t)(l * 128 + row - NPR) * 1664;
            dst[c] = cr; dst[512 + c] = ck; dst[1024 + c] = cv;
            if (c < 128) dst[1536 + c] = bf2f(pp[1536 + c]);
        }
        if (c < 128) {
            const int col = 1536 + c, j = c & 63;
            const float mu = p->rw_mu[l * 1664 + col];
#pragma unroll
            for (int r = 0; r < RT; ++r) {
                const int row = rbase + r;
                const float cw = bf2f(p->proj[(size_t)row * LDP + C_RX + col]);
                const float pw = p->st_rs[(size_t)(l * 128 + row - NPR) * 1664 + col];
                const float xm = cw + (pw - cw) * mu;
                if (c < 64) twT[j * RT + r] = ftanh(xm); else alT[j * RT + r] = xm;
            }
        }
        __syncthreads();
        float aw[RT], aa[RT];
#pragma unroll
        for (int r = 0; r < RT; ++r) { aw[r] = 0.f; aa[r] = 0.f; }
#pragma unroll 32
        for (int j = 0; j < 64; ++j) {
            const float w2v = p->rw_w2[((size_t)l * 64 + j) * 512 + c], a2v = p->rw_a2[((size_t)l * 64 + j) * 512 + c];
            const float2 t2 = ((const float2*)twT)[j], a2 = ((const float2*)alT)[j];
            aw[0] += t2.x * w2v; aw[1] += t2.y * w2v;
            aa[0] += a2.x * a2v; aa[1] += a2.y * a2v;
        }
        const float w0 = p->rw_w0[l * 512 + c], a0 = p->rw_a0[l * 512 + c], kkc = p->rw_k_k[l * 512 + c], kac = p->rw_k_a[l * 512 + c], rkc = p->rw_r_k[l * 512 + c];
#pragma unroll
        for (int r = 0; r < RT; ++r) {
            const size_t o = (size_t)(rbase + r) * 512 + c;
            const float wl = -softplusf(-(w0 + aw[r])) - 0.5f;
            const float decay = fexp(-fexp(wl));
            const float a = sigmf(a0 + aa[r]);
            const float kr = xk[r] * kkc;
            const float ss = wsum(kr * kr);
            const float kk = kr * rsqrtf(ss + 1e-6f);
            const float k2 = xk[r] * (1.f + (a - 1.f) * kac);
            const float bon = wsum(xr[r] * k2 * rkc) * xv[r];
            p->rr[o] = xr[r]; p->rk[o] = k2; p->rv[o] = xv[r]; p->rw[o] = decay; p->rkk[o] = kk; p->rb[o] = kk * a; p->rbonus[o] = bon;
        }
        __syncthreads();
    }
}

DEVI void dn_scan_item(KP p, int l, int s, int h, int quarter, float* wl) {
    const int lane = tidx() & 63, kh = lane & 1;
    const int row = NPR + s - 8;
    const float* Sin = p->st_dn + (size_t)((l * 128 + s - 8) * 4 + h) * 16384;
    float* Sout = p->out + O_SDN + (size_t)((l * 128 + s - 8) * 4 + h) * 16384;
    const int col = quarter * 32 + (lane >> 1);
    float S[64];
#pragma unroll
    for (int k = 0; k < 64; ++k) S[k] = Sin[(kh * 64 + k) * 128 + col];
    const size_t o = (size_t)row * 512 + h * 128;
    wave_sync();
    wl[lane] = p->dnq[o + lane]; wl[64 + lane] = p->dnq[o + 64 + lane]; wl[128 + lane] = p->dnk[o + lane]; wl[192 + lane] = p->dnk[o + 64 + lane];
    const float v = p->dnv[o + col], beta = p->dnbeta[row * 4 + h], a = p->dna[row * 4 + h];
    wave_sync();
    const float4* kp = (const float4*)(wl + 128 + kh * 64);
    const float4* qp = (const float4*)(wl + kh * 64);
    float x0 = 0.f, x1 = 0.f, x2 = 0.f, x3 = 0.f;
#pragma unroll
    for (int k4 = 0; k4 < 16; ++k4) {
        const float4 kv = kp[k4];
        x0 += S[k4 * 4 + 0] * kv.x; x1 += S[k4 * 4 + 1] * kv.y; x2 += S[k4 * 4 + 2] * kv.z; x3 += S[k4 * 4 + 3] * kv.w;
    }
    float x = (x0 + x1) + (x2 + x3);
    x += __shfl_xor(x, 1);
    const float coef = beta * (v - a * x);
    float o0 = 0.f, o1 = 0.f, o2 = 0.f, o3 = 0.f;
#pragma unroll
    for (int k4 = 0; k4 < 16; ++k4) {
        const float4 kv = kp[k4];
        const float4 qv = qp[k4];
        S[k4 * 4 + 0] = a * S[k4 * 4 + 0] + coef * kv.x; o0 += S[k4 * 4 + 0] * qv.x;
        S[k4 * 4 + 1] = a * S[k4 * 4 + 1] + coef * kv.y; o1 += S[k4 * 4 + 1] * qv.y;
        S[k4 * 4 + 2] = a * S[k4 * 4 + 2] + coef * kv.z; o2 += S[k4 * 4 + 2] * qv.z;
        S[k4 * 4 + 3] = a * S[k4 * 4 + 3] + coef * kv.w; o3 += S[k4 * 4 + 3] * qv.w;
    }
    float ov = (o0 + o1) + (o2 + o3);
    ov += __shfl_xor(ov, 1);
    if (kh == 0) p->oraw[(size_t)row * 1536 + h * 128 + col] = ov;
#pragma unroll
    for (int k = 0; k < 64; ++k) Sout[(kh * 64 + k) * 128 + col] = S[k];
}

DEVI void gla_scan_item(KP p, int l, int s, int h, int quarter, float* wl) {
    const int lane = tidx() & 63, kh = lane & 1;
    const int row = NPR + s - 8;
    const float* Sin = p->st_gla + (size_t)((l * 128 + s - 8) * 4 + h) * 8192;
    float* Sout = p->out + O_SGLA + (size_t)((l * 128 + s - 8) * 4 + h) * 8192;
    const int col = quarter * 32 + (lane >> 1);
    float S[32];
#pragma unroll
    for (int k = 0; k < 32; ++k) S[k] = Sin[(kh * 32 + k) * 128 + col];
    const bf16_t* pp = p->proj + (size_t)row * LDP;
    wave_sync();
    wl[lane] = bf2f(pp[C_GQ + h * 64 + lane]) * 0.125f; wl[64 + lane] = bf2f(pp[C_GK + h * 64 + lane]);
    wl[128 + lane] = fexp(p->glf[(size_t)row * 256 + h * 64 + lane]);
    const float v = bf2f(pp[C_GV + h * 128 + col]);
    wave_sync();
    float o0 = 0.f, o1 = 0.f, o2 = 0.f, o3 = 0.f;
#pragma unroll
    for (int k4 = 0; k4 < 8; ++k4) {
        const float4 qv = ((const float4*)(wl + kh * 32))[k4], kv = ((const float4*)(wl + 64 + kh * 32))[k4], fv = ((const float4*)(wl + 128 + kh * 32))[k4];
        S[k4 * 4 + 0] = fv.x * S[k4 * 4 + 0] + kv.x * v; o0 += S[k4 * 4 + 0] * qv.x;
        S[k4 * 4 + 1] = fv.y * S[k4 * 4 + 1] + kv.y * v; o1 += S[k4 * 4 + 1] * qv.y;
        S[k4 * 4 + 2] = fv.z * S[k4 * 4 + 2] + kv.z * v; o2 += S[k4 * 4 + 2] * qv.z;
        S[k4 * 4 + 3] = fv.w * S[k4 * 4 + 3] + kv.w * v; o3 += S[k4 * 4 + 3] * qv.w;
    }
    float ov = (o0 + o1) + (o2 + o3);
    ov += __shfl_xor(ov, 1);
    if (kh == 0) p->oraw[(size_t)row * 1536 + 512 + h * 128 + col] = ov;
#pragma unroll
    for (int k = 0; k < 32; ++k) Sout[(kh * 32 + k) * 128 + col] = S[k];
}

DEVI void rw_scan_item(KP p, int l, int s, int h, int half, float* wl) {
    const int lane = tidx() & 63, kh = lane & 1;
    const int row = NPR + s - 8;
    const float* Sin = p->st_rw + (size_t)((l * 128 + s - 8) * 8 + h) * 4096;
    float* Sout = p->out + O_SRW + (size_t)((l * 128 + s - 8) * 8 + h) * 4096;
    const int vr = half * 32 + (lane >> 1);
    float S[32];
#pragma unroll
    for (int k4 = 0; k4 < 8; ++k4) {
        const float4 v4 = ((const float4*)(Sin + vr * 64 + kh * 32))[k4];
        S[k4 * 4 + 0] = v4.x; S[k4 * 4 + 1] = v4.y; S[k4 * 4 + 2] = v4.z; S[k4 * 4 + 3] = v4.w;
    }
    const size_t o = (size_t)row * 512 + h * 64;
    wave_sync();
    wl[lane] = p->rr[o + lane]; wl[64 + lane] = p->rw[o + lane]; wl[128 + lane] = p->rk[o + lane]; wl[192 + lane] = p->rkk[o + lane]; wl[256 + lane] = p->rb[o + lane];
    const float v = p->rv[o + vr];
    wave_sync();
    float x0 = 0.f, x1 = 0.f, x2 = 0.f, x3 = 0.f;
#pragma unroll
    for (int k4 = 0; k4 < 8; ++k4) {
        const float4 kv = ((const float4*)(wl + 192 + kh * 32))[k4];
        x0 += S[k4 * 4 + 0] * kv.x; x1 += S[k4 * 4 + 1] * kv.y; x2 += S[k4 * 4 + 2] * kv.z; x3 += S[k4 * 4 + 3] * kv.w;
    }
    float x = (x0 + x1) + (x2 + x3);
    x += __shfl_xor(x, 1);
    float o0 = 0.f, o1 = 0.f, o2 = 0.f, o3 = 0.f;
#pragma unroll
    for (int k4 = 0; k4 < 8; ++k4) {
        const float4 rv = ((const float4*)(wl + kh * 32))[k4], wv = ((const float4*)(wl + 64 + kh * 32))[k4], kv = ((const float4*)(wl + 128 + kh * 32))[k4], bv = ((const float4*)(wl + 256 + kh * 32))[k4];
        S[k4 * 4 + 0] = S[k4 * 4 + 0] * wv.x - x * bv.x + v * kv.x; o0 += S[k4 * 4 + 0] * rv.x;
        S[k4 * 4 + 1] = S[k4 * 4 + 1] * wv.y - x * bv.y + v * kv.y; o1 += S[k4 * 4 + 1] * rv.y;
        S[k4 * 4 + 2] = S[k4 * 4 + 2] * wv.z - x * bv.z + v * kv.z; o2 += S[k4 * 4 + 2] * rv.z;
        S[k4 * 4 + 3] = S[k4 * 4 + 3] * wv.w - x * bv.w + v * kv.w; o3 += S[k4 * 4 + 3] * rv.w;
    }
    float ov = (o0 + o1) + (o2 + o3);
    ov += __shfl_xor(ov, 1);
    if (kh == 0) p->oraw[(size_t)row * 1536 + 1024 + h * 64 + vr] = ov;
#pragma unroll
    for (int k4 = 0; k4 < 8; ++k4)
        ((float4*)(Sout + vr * 64 + kh * 32))[k4] = make_float4(S[k4 * 4 + 0], S[k4 * 4 + 1], S[k4 * 4 + 2], S[k4 * 4 + 3]);
}

DEVI bf16_t bfr(float a) { return (bf16_t)(pk2(a, 0.f) & 0xffffu); }
DEVI int permpos(int i) { return (i & ~31) | ((i & 12) << 1) | ((i & 16) >> 2) | (i & 3); }
DEVI float expc(float x) { return fexp(fminf(x, 80.f)); }

template <class F>
DEVI void lds_mm(const bf16_t* A, int lda, const bf16_t* Bt, int ldb, int MT, int NTl, int KS, F epi) {
    const int tid = tidx(), lane = tid & 63, wid = tid >> 6, r = lane & 15, q = lane >> 4;
    const int ntile = MT * NTl;
    for (int t = wid; t < ntile; t += 16) {
        const int t2 = t + 8;
        const bool two = t2 < ntile;
        const int mt = t / NTl, nt = t % NTl, mt2 = two ? t2 / NTl : mt, nt2 = two ? t2 % NTl : nt;
        f32x4 acc = {0.f, 0.f, 0.f, 0.f}, acc2 = {0.f, 0.f, 0.f, 0.f};
        for (int ks = 0; ks < KS; ++ks) {
            const bf16x8 a = *(const bf16x8*)(A + (mt * 16 + r) * lda + ks * 32 + q * 8);
            const bf16x8 b = *(const bf16x8*)(Bt + (nt * 16 + r) * ldb + ks * 32 + q * 8);
            const bf16x8 a2 = *(const bf16x8*)(A + (mt2 * 16 + r) * lda + ks * 32 + q * 8);
            const bf16x8 b2 = *(const bf16x8*)(Bt + (nt2 * 16 + r) * ldb + ks * 32 + q * 8);
            acc = MFMA16(a, b, acc);
            acc2 = MFMA16(a2, b2, acc2);
        }
#pragma unroll
        for (int jj = 0; jj < 4; ++jj) epi(mt * 16 + q * 4 + jj, nt * 16 + r, acc[jj]);
        if (two) {
#pragma unroll
            for (int jj = 0; jj < 4; ++jj) epi(mt2 * 16 + q * 4 + jj, nt2 * 16 + r, acc2[jj]);
        }
    }
}

template <int NPAR, class F>
DEVI void lds_mm4(const bf16_t* A, int lda, const bf16_t* Bt, int ldb, int MT, int NTl, int KS, F epi4) {
    const int tid = tidx(), lane = tid & 63, wid = tid >> 6, r = lane & 15, q = lane >> 4;
    f32x4 acc[NPAR];
    const bf16_t* ap[NPAR]; const bf16_t* bp[NPAR];
#pragma unroll
    for (int u = 0; u < NPAR; ++u) {
        const int t = wid + 8 * u, mt = t / NTl, nt = t % NTl;
        acc[u] = (f32x4){0.f, 0.f, 0.f, 0.f};
        ap[u] = A + (mt * 16 + r) * lda + q * 8; bp[u] = Bt + (nt * 16 + r) * ldb + q * 8;
    }
    for (int ks = 0; ks < KS; ++ks) {
        bf16x8 a[NPAR], b[NPAR];
#pragma unroll
        for (int u = 0; u < NPAR; ++u) { a[u] = *(const bf16x8*)(ap[u] + ks * 32); b[u] = *(const bf16x8*)(bp[u] + ks * 32); }
#pragma unroll
        for (int u = 0; u < NPAR; ++u) acc[u] = MFMA16(a[u], b[u], acc[u]);
    }
#pragma unroll
    for (int u = 0; u < NPAR; ++u) { const int t = wid + 8 * u, mt = t / NTl, nt = t % NTl; epi4(mt * 16 + q * 4, nt * 16 + r, acc[u]); }
}

DEVI void tri_inverse(const float* Mab, bf16_t* bT, int lane) {
    float Tc[64];
#pragma unroll
    for (int i = 0; i < 64; ++i) {
        float a0 = (lane == i) ? 1.f : 0.f, a1 = 0.f, a2 = 0.f, a3 = 0.f;
#pragma unroll
        for (int j4 = 0; j4 < (i + 3) / 4; ++j4) {
            const float4 m = *(const float4*)(Mab + i * 68 + j4 * 4);
            if (j4 * 4 + 0 < i) a0 += m.x * Tc[j4 * 4 + 0];
            if (j4 * 4 + 1 < i) a1 += m.y * Tc[j4 * 4 + 1];
            if (j4 * 4 + 2 < i) a2 += m.z * Tc[j4 * 4 + 2];
            if (j4 * 4 + 3 < i) a3 += m.w * Tc[j4 * 4 + 3];
        }
        Tc[i] = (a0 + a1) + (a2 + a3);
        bT[i * 72 + lane] = bfr(Tc[i]);
    }
}

DEVI void tri_inverse8(const float* Mab, bf16_t* bT) {
    const int tid = tidx(), lane = tid & 63, wid = tid >> 6, jl = lane & 7, col = wid * 8 + (lane >> 3);
    float s[8];
#pragma unroll
    for (int k = 0; k < 8; ++k) s[k] = 0.f;
    float mc[2][8][8];
#pragma unroll
    for (int r = 0; r < 8; ++r)
#pragma unroll
        for (int kk = 0; kk < 8; ++kk) mc[0][r][kk] = Mab[(kk * 8 + jl) * 68 + r];
#pragma unroll
    for (int b = 0; b < 8; ++b) {
        if (b + 1 < 8) {
#pragma unroll
            for (int r = 0; r < 8; ++r)
#pragma unroll
                for (int kk = b + 1; kk < 8; ++kk) mc[(b + 1) & 1][r][kk] = Mab[(kk * 8 + jl) * 68 + (b + 1) * 8 + r];
        }
#pragma unroll
        for (int r = 0; r < 8; ++r) {
            const int i = b * 8 + r;
            const float own = s[b] + (col == i ? 1.f : 0.f);
            const float q1 = (r & 3) == 0 ? dppf<0x00>(own) : ((r & 3) == 1 ? dppf<0x55>(own) : ((r & 3) == 2 ? dppf<0xAA>(own) : dppf<0xFF>(own)));
            const float q2 = dppf<0x141>(q1);
            const float Ti = ((jl >> 2) == (r >> 2)) ? q1 : q2;
            if (jl == r) bT[i * 72 + col] = bfr(Ti);
#pragma unroll
            for (int kk = b; kk < 8; ++kk) s[kk] += mc[b & 1][r][kk] * Ti;
        }
    }
}

template <int DK, int DV>
DEVI void prepass_core(const float* Mab, const bf16_t* bMak, const bf16_t* bMrk, bf16_t* bT, bf16_t* bYT, const bf16_t* bAST, const bf16_t* bVT,
                       bf16_t* gW, bf16_t* gUT, bf16_t* gO1, const float* rs) {
    lds_mm4<DV / 32>(bMak, 72, bVT, 72, 4, DV / 16, 2, [&](int i0, int dv, f32x4 y) { *(u32x2*)(bYT + dv * 72 + i0) = (u32x2){pk2(y[0], y[1]), pk2(y[2], y[3])}; });
    lds_mm4<DV / 32>(bVT, 72, bMrk, 72, DV / 16, 4, 2, [&](int dv0, int i, f32x4 o) { *(u32x2*)(gO1 + i * DV + dv0) = (u32x2){pk2(o[0], o[1]), pk2(o[2], o[3])}; });
    tri_inverse8(Mab, bT);
    __syncthreads();
    lds_mm4<DV / 32>(bT, 72, bYT, 72, 4, DV / 16, 2, [&](int i0, int dv, f32x4 u) {
        if (rs) { u[0] *= rs[i0]; u[1] *= rs[i0 + 1]; u[2] *= rs[i0 + 2]; u[3] *= rs[i0 + 3]; }
        *(u32x2*)(gUT + dv * 64 + i0) = (u32x2){pk2(u[0], u[1]), pk2(u[2], u[3])};
    });
    lds_mm4<DK / 32>(bAST, 72, bT, 72, DK / 16, 4, 2, [&](int dk0, int i, f32x4 w) {
        if (rs) w = w * rs[i];
        *(u32x2*)(gW + i * DK + permpos(dk0)) = (u32x2){pk2(w[0], w[1]), pk2(w[2], w[3])};
    });
}

constexpr int PP_F = 0;
constexpr int PP_BK = 35840;
constexpr int PP_BQ = PP_BK + 17408;
constexpr int PP_AST = PP_BQ + 17408;
constexpr int PP_VT = PP_AST + 18432;
constexpr int PP_MAK = PP_VT + 18432;
constexpr int PP_MRK = PP_MAK + 9216;
constexpr int PP_T = PP_MRK + 9216;
constexpr int PP_SC = PP_T + 9216;
constexpr int PP_BYTES = PP_SC + 4096;

DEVI void prepass_dn(KP p, int l, int s, int h, int c, unsigned char* smem) {
    const int tid = tidx(), lane = tid & 63, wid = tid >> 6;
    float* F = (float*)(smem + PP_F);
    float* Mab = (float*)(smem + PP_F);
    bf16_t* bYT = (bf16_t*)(smem + PP_F + 17408);
    bf16_t* bK = (bf16_t*)(smem + PP_BK); bf16_t* bQ = (bf16_t*)(smem + PP_BQ);
    bf16_t* bAST = (bf16_t*)(smem + PP_AST); bf16_t* bVT = (bf16_t*)(smem + PP_VT);
    bf16_t* bMak = (bf16_t*)(smem + PP_MAK); bf16_t* bMrk = (bf16_t*)(smem + PP_MRK); bf16_t* bT = (bf16_t*)(smem + PP_T);
    float* Lam = (float*)(smem + PP_SC); float* Lm1 = Lam + 64; float* bb = Lam + 128; float* aa = Lam + 192;
    const int item = (s * 4 + h) * 32 + c;
    const int rowbase = s * 2048 + c * 64;
    bf16_t* gW = p->dnW + (size_t)item * 8192; bf16_t* gR = p->dnR + (size_t)item * 8192; bf16_t* gKT = p->dnKT + (size_t)item * 8192;
    bf16_t* gM = p->dnM + (size_t)item * 4096; bf16_t* gUT = p->dnUT + (size_t)item * 8192; bf16_t* gO1 = p->dnO1 + (size_t)item * 8192;
    bf16_t* gVT = p->dnVT + (size_t)item * 8192;
    if (wid == 0) {
        const int row = rowbase + lane;
        const float braw = bf2f(p->proj[(size_t)row * LDP + C_DNB + h]), araw = bf2f(p->proj[(size_t)row * LDP + C_DNA + h]);
        const float g = -fexp(p->a_log[l * 4 + h]) * softplusf(araw + p->dt_bias[l * 4 + h]);
        float L = g;
#pragma unroll
        for (int o = 1; o < 64; o <<= 1) { const float t = __shfl_up(L, o); if (lane >= o) L += t; }
        Lam[lane] = L; Lm1[lane] = L - g; bb[lane] = sigmf(braw); aa[lane] = fexp(g);
        p->dnav[(size_t)item * 64 + lane] = fexp(g);
        const float LC = __shfl(L, 63);
        p->dnpc[(size_t)item * 128 + lane] = fexp(LC); p->dnpc[(size_t)item * 128 + 64 + lane] = fexp(LC);
    }
    const int col = tid & 127, rg = tid >> 7;
    float raw[3][19];
    {
        const int t0 = c * 64 + rg * 16;
#pragma unroll
        for (int seg = 0; seg < 3; ++seg) {
            const bf16_t* pp = p->proj + (size_t)(s * 2048) * LDP + seg * 512 + h * 128 + col;
#pragma unroll
            for (int ii = 0; ii < 19; ++ii) {
                const int t = t0 - 3 + ii, tc = t < 0 ? 0 : t;
                const float v = bf2f(pp[(size_t)tc * LDP]);
                raw[seg][ii] = (ii < 3 && t < 0) ? 0.f : v;
            }
        }
    }
    auto conv_seg = [&](int seg, float (&outv)[16]) {
        const int pc = seg * 512 + h * 128 + col;
        const float cw0 = p->conv_w[(l * 4 + 0) * 1536 + pc], cw1 = p->conv_w[(l * 4 + 1) * 1536 + pc], cw2 = p->conv_w[(l * 4 + 2) * 1536 + pc], cw3 = p->conv_w[(l * 4 + 3) * 1536 + pc];
#pragma unroll
        for (int ii = 0; ii < 16; ++ii)
            outv[ii] = siluf(raw[seg][ii] * cw0 + raw[seg][ii + 1] * cw1 + raw[seg][ii + 2] * cw2 + raw[seg][ii + 3] * cw3);
    };
    float cv[16];
    conv_seg(1, cv);
#pragma unroll
    for (int ii = 0; ii < 16; ++ii) F[(rg * 16 + ii) * 129 + col] = cv[ii];
    __syncthreads();
    {
        const float LC = Lam[63];
        const int i0 = wid * 8;
        float kt0[8], kt1[8];
#pragma unroll
        for (int r = 0; r < 8; ++r) {
            const int i = i0 + r;
            const float v0 = F[i * 129 + lane], v1 = F[i * 129 + 64 + lane];
            const float rn = rsqrtf(wsum(v0 * v0 + v1 * v1) + 1e-6f);
            const float k0 = v0 * rn, k1 = v1 * rn;
            const float e1 = fexp(Lm1[i]), e2 = bb[i] * fexp(LC - Lam[i]);
            bK[i * 136 + lane] = bfr(k0); bK[i * 136 + 64 + lane] = bfr(k1);
            bAST[lane * 72 + i] = bfr(k0 * e1); bAST[(64 + lane) * 72 + i] = bfr(k1 * e1);
            kt0[r] = k0 * e2; kt1[r] = k1 * e2;
        }
        const int pb = (i0 & 32) + ((i0 & 8) << 1) + ((i0 & 16) >> 2);
        *(u32x2*)(gKT + lane * 64 + pb) = (u32x2){pk2(kt0[0], kt0[1]), pk2(kt0[2], kt0[3])}; *(u32x2*)(gKT + lane * 64 + pb + 8) = (u32x2){pk2(kt0[4], kt0[5]), pk2(kt0[6], kt0[7])};
        *(u32x2*)(gKT + (64 + lane) * 64 + pb) = (u32x2){pk2(kt1[0], kt1[1]), pk2(kt1[2], kt1[3])}; *(u32x2*)(gKT + (64 + lane) * 64 + pb + 8) = (u32x2){pk2(kt1[4], kt1[5]), pk2(kt1[6], kt1[7])};
    }
    __syncthreads();
    conv_seg(0, cv);
#pragma unroll
    for (int ii = 0; ii < 16; ++ii) F[(rg * 16 + ii) * 129 + col] = cv[ii];
    __syncthreads();
    for (int i = wid * 8; i < wid * 8 + 8; ++i) {
        const float v0 = F[i * 129 + lane], v1 = F[i * 129 + 64 + lane];
        const float rn = rsqrtf(wsum(v0 * v0 + v1 * v1) + 1e-6f) * 0.08838834764831845f;
        const float q0 = v0 * rn, q1 = v1 * rn, e = fexp(Lam[i]);
        bQ[i * 136 + lane] = bfr(q0); bQ[i * 136 + 64 + lane] = bfr(q1);
        gR[i * 128 + permpos(lane)] = bfr(q0 * e); gR[i * 128 + permpos(64 + lane)] = bfr(q1 * e);
    }
    conv_seg(2, cv);
#pragma unroll
    for (int ii = 0; ii < 16; ++ii) bVT[col * 72 + rg * 16 + ii] = bfr(cv[ii]);
#pragma unroll
    for (int g = 0; g < 4; ++g)
        *(u32x2*)(gVT + col * 64 + (rg >> 1) * 32 + 8 * g + 4 * (rg & 1)) = (u32x2){pk2(cv[4 * g], cv[4 * g + 1]), pk2(cv[4 * g + 2], cv[4 * g + 3])};
    if (c == 31) {
        for (int idx = tid; idx < 3 * 384; idx += NT) {
            const int j = idx / 384, cc = idx % 384, pc = (cc >> 7) * 512 + h * 128 + (cc & 127);
            p->out[O_PCONV + (size_t)((l * 8 + s) * 3 + j) * 1536 + pc] = bf2f(p->proj[(size_t)(s * 2048 + 2045 + j) * LDP + pc]);
        }
    }
    __syncthreads();
    lds_mm(bK, 136, bK, 136, 4, 4, 4, [&](int i, int j, float g) {
        float mak = 0.f;
        if (i > j) mak = bb[j] * g * fexp(Lm1[i] - Lam[j]);
        Mab[i * 68 + j] = -aa[j] * mak; bMak[i * 72 + j] = bfr(mak);
    });
    lds_mm(bQ, 136, bK, 136, 4, 4, 4, [&](int i, int j, float g) {
        float mrk = 0.f;
        if (i >= j) mrk = bb[j] * g * fexp(Lam[i] - Lam[j]);
        bMrk[i * 72 + j] = bfr(mrk); gM[i * 64 + permpos(j)] = bfr(-mrk);
    });
    __syncthreads();
    prepass_core<128, 128>(Mab, bMak, bMrk, bT, bYT, bAST, bVT, gW, gUT, gO1, aa);
    __syncthreads();
}

DEVI void prepass_rw(KP p, int l, int s, int h, int c, unsigned char* smem) {
    const int tid = tidx(), lane = tid & 63, wid = tid >> 6;
    bf16_t* bTW = (bf16_t*)(smem + PP_F); bf16_t* bAL = bTW + 64 * 72;
    float* awL = (float*)(smem + PP_F + 18432); float* aaL = (float*)(smem + PP_BK);
    bf16_t* bW2T = (bf16_t*)(smem + PP_MAK); bf16_t* bA2T = (bf16_t*)(smem + PP_MRK);
    float* Mab = (float*)(smem + PP_F); bf16_t* bYT = (bf16_t*)(smem + PP_F + 17408);
    bf16_t* bAS = (bf16_t*)(smem + PP_BK); bf16_t* bRS = (bf16_t*)(smem + PP_BQ);
    bf16_t* bAST = (bf16_t*)(smem + PP_AST); bf16_t* bBH = (bf16_t*)(smem + PP_AST + 9216);
    bf16_t* bVT = (bf16_t*)(smem + PP_VT); bf16_t* bKH = (bf16_t*)(smem + PP_VT + 9216);
    bf16_t* bMak = (bf16_t*)(smem + PP_MAK); bf16_t* bMrk = (bf16_t*)(smem + PP_MRK); bf16_t* bT = (bf16_t*)(smem + PP_T);
    float* tot = (float*)(smem + PP_SC);
    const int item = (s * 8 + h) * 32 + c;
    const int rowbase = s * 2048 + c * 64;
    bf16_t* gW = p->rwW + (size_t)item * 4096; bf16_t* gR = p->rwR + (size_t)item * 4096; bf16_t* gKT = p->rwKT + (size_t)item * 4096;
    bf16_t* gBT = p->rwBT + (size_t)item * 4096; bf16_t* gM = p->rwM + (size_t)item * 4096; bf16_t* gUT = p->rwUT + (size_t)item * 4096;
    bf16_t* gO1 = p->rwO1 + (size_t)item * 4096; bf16_t* gVT = p->rwVT + (size_t)item * 4096;
    const int colA = tid & 127, g4 = tid >> 7, iA = g4 * 16;
    const int ch = lane, hc = h * 64 + ch, i0 = wid * 8;
    const bool firstA = (c * 64 + iA == 0), firstB = (c * 64 + i0 == 0);
    float rawA[17], rawR[9], rawK[9], rawV[9], w2r[8], a2r[8];
    {
        const bf16_t* ppA = p->proj + (size_t)rowbase * LDP + C_RX + 1536 + colA;
#pragma unroll
        for (int ii = 0; ii < 17; ++ii) { const int r = iA - 1 + ii; rawA[ii] = bf2f(ppA[(ptrdiff_t)((firstA && ii == 0) ? 0 : r) * LDP]); }
        const bf16_t* ppB = p->proj + (size_t)rowbase * LDP + C_RX + hc;
#pragma unroll
        for (int ii = 0; ii < 9; ++ii) {
            const bf16_t* q = ppB + (ptrdiff_t)((firstB && ii == 0) ? 0 : (i0 - 1 + ii)) * LDP;
            rawR[ii] = bf2f(q[0]); rawK[ii] = bf2f(q[512]); rawV[ii] = bf2f(q[1024]);
        }
#pragma unroll
        for (int jj = 0; jj < 8; ++jj) { const int j = wid * 8 + jj; w2r[jj] = p->rw_w2[((size_t)l * 64 + j) * 512 + hc]; a2r[jj] = p->rw_a2[((size_t)l * 64 + j) * 512 + hc]; }
    }
    const float muA = p->rw_mu[l * 1664 + 1536 + colA];
    const float mur = p->rw_mu[l * 1664 + hc], muk = p->rw_mu[l * 1664 + 512 + hc], muv = p->rw_mu[l * 1664 + 1024 + hc];
    if (firstA) rawA[0] = 0.f;
    if (firstB) { rawR[0] = 0.f; rawK[0] = 0.f; rawV[0] = 0.f; }
#pragma unroll
    for (int ii = 0; ii < 16; ++ii) {
        const float cur = rawA[ii + 1], xm = cur + (rawA[ii] - cur) * muA;
        if (colA < 64) bTW[(iA + ii) * 72 + colA] = bfr(ftanh(xm)); else bAL[(iA + ii) * 72 + colA - 64] = bfr(xm);
    }
#pragma unroll
    for (int jj = 0; jj < 8; ++jj) { const int j = wid * 8 + jj; bW2T[ch * 72 + j] = bfr(w2r[jj]); bA2T[ch * 72 + j] = bfr(a2r[jj]); }
    float xr[8], xk[8], xv[8];
#pragma unroll
    for (int r = 0; r < 8; ++r) {
        xr[r] = rawR[r + 1] + (rawR[r] - rawR[r + 1]) * mur; xk[r] = rawK[r + 1] + (rawK[r] - rawK[r + 1]) * muk; xv[r] = rawV[r + 1] + (rawV[r] - rawV[r + 1]) * muv;
    }
    __syncthreads();
    lds_mm(bTW, 72, bW2T, 72, 4, 4, 2, [&](int i, int c2, float v) { awL[i * 65 + c2] = v; });
    lds_mm(bAL, 72, bA2T, 72, 4, 4, 2, [&](int i, int c2, float v) { aaL[i * 65 + c2] = v; });
    __syncthreads();
    float aw[8], aa[8];
#pragma unroll
    for (int r = 0; r < 8; ++r) { aw[r] = awL[(i0 + r) * 65 + ch]; aa[r] = aaL[(i0 + r) * 65 + ch]; }
    const float w0 = p->rw_w0[l * 512 + hc], a0 = p->rw_a0[l * 512 + hc], kkc = p->rw_k_k[l * 512 + hc], kac = p->rw_k_a[l * 512 + hc], rkc = p->rw_r_k[l * 512 + hc];
    float lw[8], Ll[8], kkv[8], k2v[8], bv[8];
    float run = 0.f;
#pragma unroll
    for (int r = 0; r < 8; ++r) {
        const float wl = -softplusf(-(w0 + aw[r])) - 0.5f;
        lw[r] = -fexp(wl);
        run += lw[r]; Ll[r] = run;
        const float a = sigmf(a0 + aa[r]);
        const float kr = xk[r] * kkc;
        const float kk = kr * rsqrtf(wsum(kr * kr) + 1e-6f);
        const float k2 = xk[r] * (1.f + (a - 1.f) * kac);
        const float bon = wsum(xr[r] * k2 * rkc) * xv[r];
        p->rbonus[(size_t)(rowbase + i0 + r) * 512 + hc] = bon;
        kkv[r] = kk; k2v[r] = k2; bv[r] = -(kk * a);
    }
    tot[wid * 64 + ch] = run;
    __syncthreads();
    {
        float off = 0.f, LC = 0.f;
#pragma unroll
        for (int g = 0; g < 8; ++g) { const float t = tot[g * 64 + ch]; LC += t; if (g < wid) off += t; }
        if (wid == 0) p->rwpc[(size_t)item * 64 + ch] = expc(LC);
        float kt8[8], bt8[8];
#pragma unroll
        for (int r = 0; r < 8; ++r) {
            const int i = i0 + r;
            const float L = off + Ll[r], Lm = L - lw[r];
            const float AS = kkv[r] * expc(Lm), RS = xr[r] * expc(L), em = expc(-L), eC = expc(LC - L);
            bAS[i * 72 + ch] = bfr(AS); bRS[i * 72 + ch] = bfr(RS); bBH[i * 72 + ch] = bfr(bv[r] * em); bKH[i * 72 + ch] = bfr(k2v[r] * em);
            bAST[ch * 72 + i] = bfr(AS); bVT[ch * 72 + i] = bfr(xv[r]);
            gR[i * 64 + permpos(ch)] = bfr(RS);
            kt8[r] = k2v[r] * eC; bt8[r] = bv[r] * eC;
        }
        const int pb = ch * 64 + (i0 & 32) + ((i0 & 8) << 1) + ((i0 & 16) >> 2);
        *(u32x2*)(gKT + pb) = (u32x2){pk2(kt8[0], kt8[1]), pk2(kt8[2], kt8[3])}; *(u32x2*)(gKT + pb + 8) = (u32x2){pk2(kt8[4], kt8[5]), pk2(kt8[6], kt8[7])};
        *(u32x2*)(gBT + pb) = (u32x2){pk2(bt8[0], bt8[1]), pk2(bt8[2], bt8[3])}; *(u32x2*)(gBT + pb + 8) = (u32x2){pk2(bt8[4], bt8[5]), pk2(bt8[6], bt8[7])};
        *(u32x2*)(gVT + pb) = (u32x2){pk2(xv[0], xv[1]), pk2(xv[2], xv[3])}; *(u32x2*)(gVT + pb + 8) = (u32x2){pk2(xv[4], xv[5]), pk2(xv[6], xv[7])};
    }
    if (c == 31 && h == 0) {
        for (int idx = tid; idx < 1664; idx += NT)
            p->out[O_PRS + (size_t)(l * 8 + s) * 1664 + idx] = bf2f(p->proj[(size_t)(s * 2048 + 2047) * LDP + C_RX + idx]);
    }
    __syncthreads();
    lds_mm(bAS, 72, bBH, 72, 4, 4, 2, [&](int i, int j, float g) { Mab[i * 68 + j] = i > j ? g : 0.f; });
    lds_mm(bAS, 72, bKH, 72, 4, 4, 2, [&](int i, int j, float g) { bMak[i * 72 + j] = bfr(i > j ? g : 0.f); });
    lds_mm(bRS, 72, bBH, 72, 4, 4, 2, [&](int i, int j, float g) { gM[i * 64 + permpos(j)] = bfr(i >= j ? g : 0.f); });
    lds_mm(bRS, 72, bKH, 72, 4, 4, 2, [&](int i, int j, float g) { bMrk[i * 72 + j] = bfr(i >= j ? g : 0.f); });
    __syncthreads();
    prepass_core<64, 64>(Mab, bMak, bMrk, bT, bYT, bAST, bVT, gW, gUT, gO1, nullptr);
    __syncthreads();
}

DEVI void prepass_gla(KP p, int l, int s, int h, int c, unsigned char* smem) {
    const int tid = tidx(), lane = tid & 63, wid = tid >> 6;
    float* glo = (float*)(smem + PP_F);
    bf16_t* bRS = (bf16_t*)(smem + PP_BK); bf16_t* bKH = bRS + 64 * 72;
    bf16_t* bVT = (bf16_t*)(smem + PP_VT); bf16_t* bMrk = (bf16_t*)(smem + PP_MRK);
    float* tot = (float*)(smem + PP_SC);
    const int item = (s * 4 + h) * 32 + c;
    const int rowbase = s * 2048 + c * 64;
    bf16_t* gR = p->glR + (size_t)item * 4096; bf16_t* gKT = p->glKT + (size_t)item * 4096;
    bf16_t* gO1 = p->glO1 + (size_t)item * 8192; bf16_t* gVT = p->glVT + (size_t)item * 8192;
    const int ch = lane, hc = h * 64 + ch, i0 = wid * 8;
    const int dv = tid & 127, g4v = tid >> 7;
    float glo0, glo1; bf16_t vv[16]; float qv[8], kv[8], wf[16];
    {
        glo0 = bf2f(p->proj[(size_t)(rowbase + (tid >> 4)) * LDP + C_GLO + (tid & 15)]);
        glo1 = bf2f(p->proj[(size_t)(rowbase + 32 + (tid >> 4)) * LDP + C_GLO + (tid & 15)]);
        const bf16_t* pv = p->proj + (size_t)rowbase * LDP + C_GV + h * 128 + dv;
#pragma unroll
        for (int ii = 0; ii < 16; ++ii) vv[ii] = pv[(size_t)(g4v * 16 + ii) * LDP];
#pragma unroll
        for (int r = 0; r < 8; ++r) {
            const bf16_t* pp = p->proj + (size_t)(rowbase + i0 + r) * LDP;
            qv[r] = bf2f(pp[C_GQ + hc]) * 0.125f; kv[r] = bf2f(pp[C_GK + hc]);
        }
#pragma unroll
        for (int j = 0; j < 16; ++j) wf[j] = p->gla_wf[(l * 16 + j) * 256 + hc];
    }
    const float bfv = p->gla_bf[l * 256 + hc];
    glo[tid] = glo0; glo[512 + tid] = glo1;
#pragma unroll
    for (int ii = 0; ii < 16; ++ii) bVT[dv * 72 + g4v * 16 + ii] = vv[ii];
#pragma unroll
    for (int g = 0; g < 4; ++g)
        *(u32x2*)(gVT + dv * 64 + (g4v >> 1) * 32 + 8 * g + 4 * (g4v & 1)) = (u32x2){(unsigned)vv[4 * g] | ((unsigned)vv[4 * g + 1] << 16), (unsigned)vv[4 * g + 2] | ((unsigned)vv[4 * g + 3] << 16)};
    __syncthreads();
    float Ll[8];
    float run = 0.f;
#pragma unroll
    for (int r = 0; r < 8; ++r) {
        const int i = i0 + r;
        float z = bfv;
#pragma unroll
        for (int j4 = 0; j4 < 4; ++j4) {
            const float4 g4 = *(const float4*)(glo + i * 16 + j4 * 4);
            z += g4.x * wf[j4 * 4 + 0] + g4.y * wf[j4 * 4 + 1] + g4.z * wf[j4 * 4 + 2] + g4.w * wf[j4 * 4 + 3];
        }
        run += -softplusf(-z) * (1.f / 16.f); Ll[r] = run;
    }
    tot[wid * 64 + ch] = run;
    __syncthreads();
    {
        float off = 0.f, LC = 0.f;
#pragma unroll
        for (int g = 0; g < 8; ++g) { const float t = tot[g * 64 + ch]; LC += t; if (g < wid) off += t; }
        if (wid == 0) p->glpc[(size_t)item * 64 + ch] = expc(LC);
        float kt8[8];
#pragma unroll
        for (int r = 0; r < 8; ++r) {
            const int i = i0 + r;
            const float L = off + Ll[r];
            const float RS = qv[r] * expc(L);
            bRS[i * 72 + ch] = bfr(RS); bKH[i * 72 + ch] = bfr(kv[r] * expc(-L));
            gR[i * 64 + permpos(ch)] = bfr(RS); kt8[r] = kv[r] * expc(LC - L);
        }
        const int pb = ch * 64 + (i0 & 32) + ((i0 & 8) << 1) + ((i0 & 16) >> 2);
        *(u32x2*)(gKT + pb) = (u32x2){pk2(kt8[0], kt8[1]), pk2(kt8[2], kt8[3])}; *(u32x2*)(gKT + pb + 8) = (u32x2){pk2(kt8[4], kt8[5]), pk2(kt8[6], kt8[7])};
    }
    __syncthreads();
    lds_mm(bRS, 72, bKH, 72, 4, 4, 2, [&](int i, int j, float g) { bMrk[i * 72 + j] = bfr(i >= j ? g : 0.f); });
    __syncthreads();
    lds_mm4<4>(bVT, 72, bMrk, 72, 8, 4, 2, [&](int dv0, int i, f32x4 o) { *(u32x2*)(gO1 + i * 128 + dv0) = (u32x2){pk2(o[0], o[1]), pk2(o[2], o[3])}; });
    __syncthreads();
}

DEVI void phase_prepass(KP p_, int l, unsigned char* smem) {
    KP p = launder(p_);
    for (int it = bidx(); it < 4096; it += gdim()) {
#ifdef NO_PRE
        continue;
#endif
        if (it < 2048) prepass_rw(p, l, it >> 8, (it >> 5) & 7, it & 31, smem);
        else if (it < 3072) { const int i = it - 2048; prepass_dn(p, l, i >> 7, (i >> 5) & 3, i & 31, smem); }
        else { const int i = it - 3072; prepass_gla(p, l, i >> 7, (i >> 5) & 3, i & 31, smem); }
    }
}

DEVI f32x4 unpack4(u32x2 u) { return (f32x4){__uint_as_float(u.x << 16), __uint_as_float(u.x & 0xffff0000u), __uint_as_float(u.y << 16), __uint_as_float(u.y & 0xffff0000u)}; }
DEVI bf16x8 pack8(f32x4 a, f32x4 b) { u32x4 r = {pk2(a[0], a[1]), pk2(a[2], a[3]), pk2(b[0], b[1]), pk2(b[2], b[3])}; return __builtin_bit_cast(bf16x8, r); }

template <int TYPE> struct SeqCfg {
    static constexpr int DK = TYPE == 0 ? 128 : 64, DV = TYPE == 2 ? 64 : 128, NDT = DK / 16, NKS = DK / 32, H = TYPE == 2 ? 8 : 4, NSL = DV / 16;
    static constexpr int NCP = TYPE == 0 ? 7 : (TYPE == 1 ? 2 : 5);
    static constexpr int SW = TYPE == 0 ? 272 : 144;
    static constexpr int OFF_W = 0, OFF_R = TYPE == 0 ? 17408 : (TYPE == 1 ? 0 : 9216), OFF_KT = TYPE == 0 ? 34816 : (TYPE == 1 ? 9216 : 18432);
    static constexpr int OFF_BT = 27648, OFF_M = TYPE == 0 ? 53248 : 36864;
    static constexpr int BUFB = TYPE == 0 ? 62464 : (TYPE == 1 ? 18432 : 46080);
};

template <int TYPE>
DEVI void chunk_seq_block(KP p, int l, int s, int h, int part, unsigned char* smem) {
    typedef SeqCfg<TYPE> C;
    constexpr int DK = C::DK, DV = C::DV, NDT = C::NDT, NKS = C::NKS, H = C::H, NSL = C::NSL, NCP = C::NCP, SW = C::SW;
    const int tid = tidx(), lane = tid & 63, wid = tid >> 6, q = lane >> 4, c = lane & 15;
    const int slice = TYPE == 0 ? part * 4 + wid : wid;
    const bool active = TYPE == 0 ? wid < 4 : wid < NSL;
    const bf16_t* cbase[NCP]; int cstride[NCP]; int soff[NCP], doff[NCP];
    if (TYPE == 0) {
#pragma unroll
        for (int i = 0; i < NCP; ++i) {
            if (i < 4) { const int j = tid + (i & 1) * 512, row = j >> 4, cc = j & 15; cbase[i] = i < 2 ? p->dnW : p->dnR; cstride[i] = 8192; soff[i] = row * 128 + cc * 8; doff[i] = (i < 2 ? C::OFF_W : C::OFF_R) + row * 272 + cc * 16; }
            else if (i < 6) { const int j = tid + (i & 1) * 512, row = j >> 3, cc = j & 7; cbase[i] = p->dnKT; cstride[i] = 8192; soff[i] = row * 64 + cc * 8; doff[i] = C::OFF_KT + row * 144 + cc * 16; }
            else { const int row = tid >> 3, cc = tid & 7; cbase[i] = p->dnM; cstride[i] = 4096; soff[i] = row * 64 + cc * 8; doff[i] = C::OFF_M + row * 144 + cc * 16; }
        }
    } else {
#pragma unroll
        for (int i = 0; i < NCP; ++i) {
            const int row = tid >> 3, cc = tid & 7;
            if (TYPE == 1) cbase[i] = i == 0 ? p->glR : p->glKT;
            else cbase[i] = i == 0 ? p->rwW : (i == 1 ? p->rwR : (i == 2 ? p->rwKT : (i == 3 ? p->rwBT : p->rwM)));
            cstride[i] = 4096; soff[i] = row * 64 + cc * 8; doff[i] = i * 9216 + row * 144 + cc * 16;
        }
    }
    const bf16_t* bUT = TYPE == 0 ? p->dnUT : p->rwUT;
    const bf16_t* bO1 = TYPE == 0 ? p->dnO1 : (TYPE == 1 ? p->glO1 : p->rwO1);
    const bf16_t* bVT = TYPE == 0 ? p->dnVT : (TYPE == 1 ? p->glVT : p->rwVT);
    const float* bpc = TYPE == 0 ? p->dnpc : (TYPE == 1 ? p->glpc : p->rwpc);
    const float* bav = p->dnav;
    float* oraw = p->oraw;
    const int ocol = (TYPE == 0 ? 0 : (TYPE == 1 ? 512 : 1024)) + h * DV + slice * 16 + 4 * q;
    const size_t item0 = (size_t)(s * H + h) * 32;
    u32x4 cr[NCP];
    u32x2 ut[4], o1[4], vtd[4]; u32x4 vtb[2]; f32x4 pcv[4]; float pcs = 1.f; f32x4 avv[4];
    auto load_priv_a = [&](size_t item) {
        if (!active) return;
        if (TYPE != 1) {
#pragma unroll
            for (int mt = 0; mt < 4; ++mt) ut[mt] = *(const u32x2*)(bUT + item * (64 * DV) + (slice * 16 + c) * 64 + mt * 16 + 4 * q);
        }
#pragma unroll
        for (int mt = 0; mt < 4; ++mt) o1[mt] = *(const u32x2*)(bO1 + item * (64 * DV) + (mt * 16 + c) * DV + slice * 16 + 4 * q);
    };
    auto load_priv_b = [&](size_t item) {
        if (!active) return;
        if (TYPE == 0) {
#pragma unroll
            for (int mt = 0; mt < 4; ++mt) {
                vtd[mt] = *(const u32x2*)(bVT + item * (64 * DV) + (slice * 16 + c) * 64 + (mt >> 1) * 32 + 8 * q + (mt & 1) * 4);
            }
        } else {
            vtb[0] = *(const u32x4*)(bVT + item * (64 * DV) + (slice * 16 + c) * 64 + 8 * q);
            vtb[1] = *(const u32x4*)(bVT + item * (64 * DV) + (slice * 16 + c) * 64 + 32 + 8 * q);
        }
        if (TYPE == 0) pcs = bpc[item * DK];
        else {
#pragma unroll
            for (int dt = 0; dt < 4; ++dt) pcv[dt] = *(const f32x4*)(bpc + item * DK + dt * 16 + 4 * q);
        }
    };
    f32x4 S[NDT];
#pragma unroll
    for (int dt = 0; dt < NDT; ++dt) S[dt] = (f32x4){0.f, 0.f, 0.f, 0.f};
#pragma unroll
    for (int i = 0; i < NCP; ++i) cr[i] = *(const u32x4*)(cbase[i] + item0 * cstride[i] + soff[i]);
#pragma unroll
    for (int i = 0; i < NCP; ++i) *(u32x4*)(smem + doff[i]) = cr[i];
    load_priv_a(item0); load_priv_b(item0);
    __syncthreads();
    for (int ch = 0; ch < 32; ++ch) {
        const unsigned char* lb = smem + (ch & 1) * C::BUFB;
        if (ch + 1 < 32) {
#pragma unroll
            for (int i = 0; i < NCP; ++i) cr[i] = *(const u32x4*)(cbase[i] + (item0 + ch + 1) * cstride[i] + soff[i]);
        }
        if (active) {
            bf16x8 Sb[NKS];
#pragma unroll
            for (int ks = 0; ks < NKS; ++ks) Sb[ks] = pack8(S[2 * ks], S[2 * ks + 1]);
            f32x4 X[4]; bf16x8 Xb[2];
            if (TYPE != 1) {
#pragma unroll
                for (int mt = 0; mt < 4; ++mt) X[mt] = (f32x4){0.f, 0.f, 0.f, 0.f};
#pragma unroll
                for (int ks = 0; ks < NKS; ++ks) {
                    bf16x8 fr[4];
#pragma unroll
                    for (int mt = 0; mt < 4; ++mt) fr[mt] = *(const bf16x8*)(lb + C::OFF_W + (mt * 16 + c) * SW + ks * 64 + 16 * q);
#pragma unroll
                    for (int mt = 0; mt < 4; ++mt) X[mt] = MFMA16(fr[mt], Sb[ks], X[mt]);
                }
#pragma unroll
                for (int mt = 0; mt < 4; ++mt) X[mt] = X[mt] + unpack4(ut[mt]);
                Xb[0] = pack8(X[0], X[1]); Xb[1] = pack8(X[2], X[3]);
            }
            {
                f32x4 O[4];
#pragma unroll
                for (int mt = 0; mt < 4; ++mt) O[mt] = (f32x4){0.f, 0.f, 0.f, 0.f};
#pragma unroll
                for (int ks = 0; ks < NKS; ++ks) {
                    bf16x8 fr[4];
#pragma unroll
                    for (int mt = 0; mt < 4; ++mt) fr[mt] = *(const bf16x8*)(lb + C::OFF_R + (mt * 16 + c) * SW + ks * 64 + 16 * q);
#pragma unroll
                    for (int mt = 0; mt < 4; ++mt) O[mt] = MFMA16(Sb[ks], fr[mt], O[mt]);
                }
                if (TYPE != 1) {
#pragma unroll
                    for (int k2 = 0; k2 < 2; ++k2) {
                        bf16x8 fr[4];
#pragma unroll
                        for (int mt = 0; mt < 4; ++mt) fr[mt] = *(const bf16x8*)(lb + C::OFF_M + (mt * 16 + c) * 144 + k2 * 64 + 16 * q);
#pragma unroll
                        for (int mt = 0; mt < 4; ++mt) O[mt] = MFMA16(Xb[k2], fr[mt], O[mt]);
                    }
                }
#pragma unroll
                for (int mt = 0; mt < 4; ++mt) {
                    O[mt] = O[mt] + unpack4(o1[mt]);
                    *(f32x4*)(oraw + (size_t)(s * 2048 + ch * 64 + mt * 16 + c) * 1536 + ocol) = O[mt];
                }
            }
            if (ch + 1 < 32) load_priv_a(item0 + ch + 1);
            bf16x8 Vb[2];
            if (TYPE == 0) {
                f32x4 Vn[4];
#pragma unroll
                for (int mt = 0; mt < 4; ++mt) Vn[mt] = unpack4(vtd[mt]) - X[mt];
                Vb[0] = pack8(Vn[0], Vn[1]); Vb[1] = pack8(Vn[2], Vn[3]);
            } else {
                Vb[0] = __builtin_bit_cast(bf16x8, vtb[0]); Vb[1] = __builtin_bit_cast(bf16x8, vtb[1]);
            }
#pragma unroll
            for (int dt = 0; dt < NDT; ++dt) { if (TYPE == 0) S[dt] = S[dt] * pcs; else S[dt] = S[dt] * pcv[dt & 3]; }
#pragma unroll
            for (int k2 = 0; k2 < 2; ++k2) {
#pragma unroll
                for (int d4 = 0; d4 < NDT; d4 += 4) {
                    bf16x8 fr[4];
#pragma unroll
                    for (int j = 0; j < 4; ++j) fr[j] = *(const bf16x8*)(lb + C::OFF_KT + ((d4 + j) * 16 + c) * 144 + k2 * 64 + 16 * q);
#pragma unroll
                    for (int j = 0; j < 4; ++j) S[d4 + j] = MFMA16(fr[j], Vb[k2], S[d4 + j]);
                    if (TYPE == 2) {
#pragma unroll
                        for (int j = 0; j < 4; ++j) fr[j] = *(const bf16x8*)(lb + C::OFF_BT + ((d4 + j) * 16 + c) * 144 + k2 * 64 + 16 * q);
#pragma unroll
                        for (int j = 0; j < 4; ++j) S[d4 + j] = MFMA16(fr[j], Xb[k2], S[d4 + j]);
                    }
                }
            }
            if (ch + 1 < 32) load_priv_b(item0 + ch + 1);
        }
        if (ch + 1 < 32) {
            unsigned char* nb = smem + ((ch + 1) & 1) * C::BUFB;
#pragma unroll
            for (int i = 0; i < NCP; ++i) *(u32x4*)(nb + doff[i]) = cr[i];
        }
        __syncthreads();
    }
    if (!active) return;
    if (TYPE == 2) {
        float* So = p->out + O_PRW + (size_t)((l * 8 + s) * 8 + h) * 4096;
#pragma unroll
        for (int dt = 0; dt < NDT; ++dt) *(f32x4*)(So + (slice * 16 + c) * 64 + dt * 16 + 4 * q) = S[dt];
    } else {
        float* So = p->out + (TYPE == 0 ? O_PDN + (size_t)((l * 8 + s) * 4 + h) * 16384 : O_PGLA + (size_t)((l * 8 + s) * 4 + h) * 8192);
#pragma unroll
        for (int dt = 0; dt < NDT; ++dt)
#pragma unroll
            for (int jj = 0; jj < 4; ++jj) So[(dt * 16 + 4 * q + jj) * 128 + slice * 16 + c] = S[dt][jj];
    }
}

DEVI void phase_scan(KP p_, int l, unsigned char* smem) {
    KP p = launder(p_);
    const int wid = tidx() >> 6, bid = bidx();
    if (bid < 160) {
        if (bid < 64) chunk_seq_block<0>(p, l, bid >> 3, (bid >> 1) & 3, bid & 1, smem);
        else if (bid < 96) chunk_seq_block<1>(p, l, (bid - 64) >> 2, bid & 3, 0, smem);
        else chunk_seq_block<2>(p, l, (bid - 96) >> 3, bid & 7, 0, smem);
    } else {
        float* wl = (float*)smem + wid * 512;
        for (int it = (bid - 160) * 8 + wid; it < 6144; it += (gdim() - 160) * 8) {
            if (it < 2048) dn_scan_item(p, l, 8 + (it >> 4), (it >> 2) & 3, it & 3, wl);
            else if (it < 4096) { const int i = it - 2048; gla_scan_item(p, l, 8 + (i >> 4), (i >> 2) & 3, i & 3, wl); }
            else { const int i = it - 4096; rw_scan_item(p, l, 8 + (i >> 4), (i >> 1) & 7, i & 1, wl); }
        }
    }
}

struct PostRow { f32x2 odn[4], ogl[4]; unsigned zdn[4], zgl[4]; float orw[8], bon[8]; unsigned zrw[8]; };
DEVI void post_load(KP p, int row, int lane, PostRow& R) {
    const float* orow = p->oraw + (size_t)row * 1536;
    const bf16_t* pr = p->proj + (size_t)row * LDP;
#pragma unroll
    for (int h = 0; h < 4; ++h) {
        R.odn[h] = *(const f32x2*)(orow + h * 128 + lane * 2); R.ogl[h] = *(const f32x2*)(orow + 512 + h * 128 + lane * 2);
        R.zdn[h] = *(const unsigned*)(pr + C_DNZ + h * 128 + lane * 2); R.zgl[h] = *(const unsigned*)(pr + C_GZ + h * 128 + lane * 2);
    }
#pragma unroll
    for (int h = 0; h < 8; ++h) { const int c = h * 64 + lane; R.orw[h] = orow[1024 + c]; R.bon[h] = p->rbonus[(size_t)row * 512 + c]; R.zrw[h] = pr[C_RZ + c]; }
}
DEVI void post_compute(KP p, int row, int lane, const PostRow& R, f32x2 gdn, f32x2 ggl, const float (&lnw)[8], const float (&lnb)[8]) {
    bf16_t* ob = p->obf + (size_t)row * 1536;
#pragma unroll
    for (int h = 0; h < 4; ++h) {
        {
            const f32x2 o = R.odn[h];
            const float rs = rsqrtf(wsum(o[0] * o[0] + o[1] * o[1]) * (1.f / 128.f) + 1e-6f);
            const float z0 = __uint_as_float(R.zdn[h] << 16), z1 = __uint_as_float(R.zdn[h] & 0xffff0000u);
            ushort2 w; w.x = f2bf(o[0] * rs * gdn[0] * siluf(z0)); w.y = f2bf(o[1] * rs * gdn[1] * siluf(z1));
            *(ushort2*)(ob + h * 128 + lane * 2) = w;
        }
        {
            const f32x2 o = R.ogl[h];
            const float rs = rsqrtf(wsum(o[0] * o[0] + o[1] * o[1]) * (1.f / 128.f) + 1e-6f);
            const float z0 = __uint_as_float(R.zgl[h] << 16), z1 = __uint_as_float(R.zgl[h] & 0xffff0000u);
            ushort2 w; w.x = f2bf(o[0] * rs * ggl[0] * siluf(z0)); w.y = f2bf(o[1] * rs * ggl[1] * siluf(z1));
            *(ushort2*)(ob + 512 + h * 128 + lane * 2) = w;
        }
    }
#pragma unroll
    for (int h = 0; h < 8; ++h) {
        const int c = h * 64 + lane;
        const float o = R.orw[h];
        const float mu = wsum(o) * (1.f / 64.f);
        const float d = o - mu;
        const float var = wsum(d * d) * (1.f / 64.f);
        float y = d * rsqrtf(var + 64e-5f) * lnw[h] + lnb[h];
        y += R.bon[h];
        y *= siluf(__uint_as_float(R.zrw[h] << 16));
        ob[1024 + c] = f2bf(y);
    }
}
DEVI void phase_post(KP p_, int l) {
    KP p = launder(p_);
    const int lane = tidx() & 63, wid = tidx() >> 6;
    const f32x2 gdn = *(const f32x2*)(p->dn_norm_g + l * 128 + lane * 2), ggl = *(const f32x2*)(p->gla_norm_g + l * 128 + lane * 2);
    float lnw[8], lnb[8];
#pragma unroll
    for (int h = 0; h < 8; ++h) { lnw[h] = p->rw_ln_w[l * 512 + h * 64 + lane]; lnb[h] = p->rw_ln_b[l * 512 + h * 64 + lane]; }
    const int stride = gdim() * 8;
    int row = bidx() * 8 + wid;
    PostRow A, B;
    post_load(p, row < NR ? row : NR - 1, lane, A);
    while (row < NR) {
        const int rowB = row + stride;
        post_load(p, rowB < NR ? rowB : NR - 1, lane, B);
        post_compute(p, row, lane, A, gdn, ggl, lnw, lnb);
        if (rowB >= NR) break;
        const int rowC = rowB + stride;
        post_load(p, rowC < NR ? rowC : NR - 1, lane, A);
        post_compute(p, rowB, lane, B, gdn, ggl, lnw, lnb);
        row = rowC;
    }
}

DEVI void phase_final(KP p_) {
    KP p = launder(p_);
    const int lane = tidx() & 63, wid = tidx() >> 6;
    for (int row = bidx() * 8 + wid; row < NR; row += gdim() * 8) {
        const float4* xr = (const float4*)(p->x + (size_t)row * 1024);
        float4 v[4], g[4]; float ss = 0.f;
#pragma unroll
        for (int i = 0; i < 4; ++i) { v[i] = xr[lane + i * 64]; g[i] = ((const float4*)p->final_g)[lane + i * 64]; }
#pragma unroll
        for (int i = 0; i < 4; ++i) ss += v[i].x * v[i].x + v[i].y * v[i].y + v[i].z * v[i].z + v[i].w * v[i].w;
        ss = wsum(ss);
        const float rstd = rsqrtf(ss * (1.f / 1024.f) + 1e-6f);
        float4* yo = (float4*)(p->out + (size_t)row * 1024);
#pragma unroll
        for (int i = 0; i < 4; ++i)
            yo[lane + i * 64] = make_float4(v[i].x * rstd * g[i].x, v[i].y * rstd * g[i].y, v[i].z * rstd * g[i].z, v[i].w * rstd * g[i].w);
    }
}

constexpr int SMEM_BYTES = PP_BYTES;
#define XB_TMO      128
#define XB_XCNT(j)  (256  + 64 * (j))
#define XB_XSUB(j)  (1280 + 64 * (j))
#define XB_XGEN(j)  (2304 + 64 * (j))
#define XB_TOP      3328
#define XB_TOPGEN   3392
#define XCD_BAR_WORDS 3456
#define XB_SPIN_CAP (1u << 18)
#ifndef LAS
#define LAS __attribute__((address_space(3)))
#endif

__device__ __forceinline__ unsigned xb_ld(unsigned* p)              { return __hip_atomic_load(p, __ATOMIC_RELAXED, __HIP_MEMORY_SCOPE_AGENT); }
__device__ __forceinline__ unsigned xb_add(unsigned* p, unsigned v) { return __hip_atomic_fetch_add(p, v, __ATOMIC_RELAXED, __HIP_MEMORY_SCOPE_AGENT); }
__device__ __forceinline__ unsigned xb_xcc_id() { return (unsigned)__builtin_amdgcn_s_getreg((3 << 11) | 20) & 0xFu; }
#define XB_SPIN(cond, bar) do { unsigned _sp = 0; while (cond) { __builtin_amdgcn_s_sleep(1); \
    if ((++_sp & 255u) == 0u) { if (xb_ld(&(bar)[XB_TMO])) break; if (_sp > XB_SPIN_CAP) { atomicAdd(&(bar)[XB_TMO], 1u); break; } } } } while (0)

struct XcdBarrier {
    unsigned* bar; unsigned x;
    volatile LAS unsigned* st;
};

__device__ __forceinline__ XcdBarrier xcd_barrier_post(unsigned* bar, volatile LAS unsigned* st) {
    XcdBarrier b; b.bar = bar; b.x = xb_xcc_id(); b.st = st;
    if (threadIdx.x == 0) (void)xb_add(&bar[XB_XCNT(b.x)], 1u);
    return b;
}
__device__ __forceinline__ void xcd_barrier_complete(unsigned* bar, unsigned x, unsigned& nloc, unsigned& nx) {
    const unsigned G = gridDim.x * gridDim.y * gridDim.z;
    unsigned sum, cnt, mine, sp = 0u;
    for (;;) {
        sum = 0u; cnt = 0u; mine = 0u;
#pragma unroll
        for (unsigned j = 0; j < 16; ++j) { const unsigned c = xb_ld(&bar[XB_XCNT(j)]); sum += c; cnt += (c > 0u) ? 1u : 0u; mine = (j == x) ? c : mine; }
        if (sum == G) break;
        __builtin_amdgcn_s_sleep(1);
        if ((++sp & 255u) == 0u) { if (xb_ld(&bar[XB_TMO])) break; if (sp > XB_SPIN_CAP) { atomicAdd(&bar[XB_TMO], 1u); break; } }
    }
    nloc = mine > 0u ? mine : 1u; nx = cnt > 0u ? cnt : 1u;
}

__device__ __forceinline__ void xcd_barrier(const XcdBarrier& b) {
    asm volatile("s_waitcnt vmcnt(0)" ::: "memory");
    __syncthreads();
    if (threadIdx.x == 0) {
        unsigned* bar = b.bar;
        __builtin_amdgcn_s_waitcnt(0);
        unsigned nloc = b.st[0], nx = b.st[1];
        if (nloc == 0u) { xcd_barrier_complete(bar, b.x, nloc, nx); b.st[0] = nloc; b.st[1] = nx; }
        const unsigned old = xb_add(&bar[XB_XSUB(b.x)], 1u);
        const unsigned gen = old / nloc;
        if (old + 1u == (gen + 1u) * nloc) {
            __builtin_amdgcn_fence(__ATOMIC_RELEASE, "agent");
            asm volatile("s_waitcnt vmcnt(0)" ::: "memory");
            const unsigned og = xb_add(&bar[XB_TOP], 1u);
            const unsigned tg = og / nx;
            if (og + 1u == (tg + 1u) * nx) xb_add(&bar[XB_TOPGEN], 1u);
            else XB_SPIN(xb_ld(&bar[XB_TOPGEN]) == tg, bar);
            __builtin_amdgcn_fence(__ATOMIC_ACQUIRE, "agent");
            xb_add(&bar[XB_XGEN(b.x)], 1u);
            asm volatile("s_waitcnt vmcnt(0)" ::: "memory");
        } else {
            XB_SPIN(xb_ld(&bar[XB_XGEN(b.x)]) == gen, bar);
            __builtin_amdgcn_fence(__ATOMIC_ACQUIRE, "agent");
            asm volatile("s_waitcnt vmcnt(0)" ::: "memory");
        }
    }
    __syncthreads();
}


DEVI void run_sub(KP p, int l, int sub, unsigned char* smem) {
    if (sub == 0) phase_norm(p, l);
    else if (sub == 1) {
        KP q = launder(p);
        {
            pg8::Gemm g{q->h, q->WinT + (size_t)l * LDP * 1024, NPR, LDP, 1024}; pg8::StaticOrder S; S.init(NPR, LDP, gdim(), bidx());
            EpiProjPG E{q->proj};
            pg8::gemm_phase<EpiProjPG, pg8::StaticOrder, false>((PG8_LAS unsigned char*)smem, g, S, E, nullptr);
        }
        __syncthreads();
        EpiProj e{q->proj}; gemm_phase(smem, q->h, 1024, q->WinT + (size_t)l * LDP * 1024, 1024, 1, LDP / G_BN, 1024, e, 192, 64);
    }
    else if (sub == 2) { phase_prepass(p, l, smem); phase_prep(p, l, smem); }
    else if (sub == 3) phase_scan(p, l, smem);
    else if (sub == 4) phase_post(p, l);
    else {
        KP q = launder(p);
        {
            pg8::Gemm g{q->obf, q->WoutT + (size_t)l * 1024 * 1536, NPR, 1024, 1536}; pg8::StaticOrder S; S.init(NPR, 1024, gdim(), bidx());
            EpiOutPG E{q->x, l == 0 ? q->x_prompt : q->x, q->mod + (size_t)l * NSEQ * 3072};
            pg8::gemm_phase<EpiOutPG, pg8::StaticOrder, false>((PG8_LAS unsigned char*)smem, g, S, E, nullptr);
        }
        out_gemm_sample(p, l);
    }
}
template <bool kCoop>
__global__ void __launch_bounds__(NT) fwd_kernel(Params p_arg) {
    KP p = (KP)__builtin_amdgcn_kernarg_segment_ptr();
    __shared__ __attribute__((aligned(16))) unsigned char smem[SMEM_BYTES];
    if (kCoop) {
        cg::grid_group grid = cg::this_grid();
        volatile LAS unsigned* xbst = (volatile LAS unsigned*)(LAS unsigned char*)(smem + SMEM_BYTES - 16);
        if (threadIdx.x < 4) xbst[threadIdx.x] = 0u;
        __syncthreads();
        const XcdBarrier xb = xcd_barrier_post(launder(p)->bar, xbst);
        phase_setup(p, smem);
        grid.sync();
#pragma unroll 1
        for (int l = 0; l < 2; ++l) {
            phase_norm(p, l); xcd_barrier(xb);
            for (int rep = 0; rep < REP_GEMM; ++rep) { run_sub(p, l, 1, smem); xcd_barrier(xb); }
            for (int rep = 0; rep < REP_PRE; ++rep) { phase_prepass(p, l, smem); phase_prep(p, l, smem); xcd_barrier(xb); }
            for (int rep = 0; rep < REP_SCAN; ++rep) { phase_scan(p, l, smem); xcd_barrier(xb); }
            phase_post(p, l); xcd_barrier(xb);
            run_sub(p, l, 5, smem); xcd_barrier(xb);
        }
        phase_final(p);
    } else {
        const int ph = launder(p)->p0;
        if (ph == 0) phase_setup(p, smem);
        else if (ph == 13) phase_final(p);
        else run_sub(p, (ph - 1) / 6, (ph - 1) % 6, smem);
    }
}

extern "C" void kernel_launch(void* const* d_in, const int* in_sizes, int n_in, void* d_out, int out_size, void* d_ws, size_t ws_size, hipStream_t stream) {
    Params hp{};
    const float** pf = (const float**)&hp;
    for (int i = 0; i < 32; ++i) pf[i] = (const float*)d_in[i];
    hp.out = (float*)d_out;
    char* w = (char*)d_ws;
    auto take = [&](size_t bytes) { char* r = w; w += (bytes + 255) & ~(size_t)255; return r; };
    hp.WinT = (bf16_t*)take((size_t)2 * LDP * 1024 * 2);
    hp.WoutT = (bf16_t*)take((size_t)2 * 1024 * 1536 * 2);
    hp.h = (bf16_t*)take((size_t)NRP * 1024 * 2);
    hp.proj = (bf16_t*)take((size_t)NRP * LDP * 2);
    hp.obf = (bf16_t*)take((size_t)NRP * 1536 * 2);
    hp.mod = (float*)take((size_t)2 * NSEQ * 3072 * 4);
    hp.x = (float*)d_out;
    const size_t soff = (size_t)NPR;
    hp.dnq = (float*)take((size_t)128 * 512 * 4) - soff * 512;
    hp.dnk = (float*)take((size_t)128 * 512 * 4) - soff * 512;
    hp.dnv = (float*)take((size_t)128 * 512 * 4) - soff * 512;
    hp.dnbeta = (float*)take((size_t)128 * 4 * 4) - soff * 4;
    hp.dna = (float*)take((size_t)128 * 4 * 4) - soff * 4;
    hp.glf = (float*)take((size_t)128 * 256 * 4) - soff * 256;
    hp.rr = (float*)take((size_t)128 * 512 * 4) - soff * 512;
    hp.rk = (float*)take((size_t)128 * 512 * 4) - soff * 512;
    hp.rv = (float*)take((size_t)128 * 512 * 4) - soff * 512;
    hp.rw = (float*)take((size_t)128 * 512 * 4) - soff * 512;
    hp.rkk = (float*)take((size_t)128 * 512 * 4) - soff * 512;
    hp.rb = (float*)take((size_t)128 * 512 * 4) - soff * 512;
    hp.rbonus = (float*)take((size_t)NR * 512 * 4);
    hp.oraw = (float*)take((size_t)NR * 1536 * 4);
    hp.dnW = (bf16_t*)take((size_t)1024 * 8192 * 2); hp.dnR = (bf16_t*)take((size_t)1024 * 8192 * 2); hp.dnKT = (bf16_t*)take((size_t)1024 * 8192 * 2);
    hp.dnM = (bf16_t*)take((size_t)1024 * 4096 * 2); hp.dnUT = (bf16_t*)take((size_t)1024 * 8192 * 2); hp.dnO1 = (bf16_t*)take((size_t)1024 * 8192 * 2);
    hp.dnVT = (bf16_t*)take((size_t)1024 * 8192 * 2);
    hp.rwW = (bf16_t*)take((size_t)2048 * 4096 * 2); hp.rwR = (bf16_t*)take((size_t)2048 * 4096 * 2); hp.rwKT = (bf16_t*)take((size_t)2048 * 4096 * 2);
    hp.rwBT = (bf16_t*)take((size_t)2048 * 4096 * 2); hp.rwM = (bf16_t*)take((size_t)2048 * 4096 * 2); hp.rwUT = (bf16_t*)take((size_t)2048 * 4096 * 2);
    hp.rwO1 = (bf16_t*)take((size_t)2048 * 4096 * 2); hp.rwVT = (bf16_t*)take((size_t)2048 * 4096 * 2);
    hp.glR = (bf16_t*)take((size_t)1024 * 4096 * 2); hp.glKT = (bf16_t*)take((size_t)1024 * 4096 * 2);
    hp.glO1 = (bf16_t*)take((size_t)1024 * 8192 * 2); hp.glVT = (bf16_t*)take((size_t)1024 * 8192 * 2);
    hp.dnpc = (float*)take((size_t)1024 * 128 * 4); hp.dnav = (float*)take((size_t)1024 * 64 * 4);
    hp.rwpc = (float*)take((size_t)2048 * 64 * 4); hp.glpc = (float*)take((size_t)1024 * 64 * 4);
    hp.bar = (unsigned*)take((size_t)XCD_BAR_WORDS * 4);
    if ((size_t)(w - (char*)d_ws) > ws_size) fprintf(stderr, "workspace too small: need %zu have %zu\n", (size_t)(w - (char*)d_ws), ws_size);
    static int grid_blocks = 0;
    if (!grid_blocks) {
        int dev = 0, cus = 0, per_cu = 0;
        hipGetDevice(&dev);
        hipDeviceGetAttribute(&cus, hipDeviceAttributeMultiprocessorCount, dev);
        hipOccupancyMaxActiveBlocksPerMultiprocessor(&per_cu, fwd_kernel<COOP != 0>, NT, 0);
        if (per_cu < 1) fprintf(stderr, "occupancy query returned %d\n", per_cu);
        grid_blocks = cus;
    }
#if COOP
    hp.p0 = 0; hp.p1 = 14;
    hipMemsetAsync(hp.bar, 0, (size_t)XCD_BAR_WORDS * 4, stream);
    void* args[] = {&hp};
    hipError_t e = hipLaunchCooperativeKernel((void*)fwd_kernel<true>, dim3(grid_blocks), dim3(NT), args, 0, stream);
    if (e != hipSuccess) fprintf(stderr, "cooperative launch failed: %s (grid %d)\n", hipGetErrorString(e), grid_blocks);
#else
    for (int ph = 0; ph < 14; ++ph) {
        hp.p0 = ph; hp.p1 = ph + 1;
        fwd_kernel<false><<<grid_blocks, NT, 0, stream>>>(hp);
    }
#endif
}
```

```cpp
#include <hip/hip_runtime.h>
#include <hip/hip_cooperative_groups.h>
#include <cstdio>
namespace cg = cooperative_groups;

#ifndef REP_PRE
#define REP_PRE 1
#endif
#ifndef REP_SCAN
#define REP_SCAN 1
#endif
#ifndef REP_GEMM
#define REP_GEMM 1
#endif
#ifndef COOP
#define COOP 1
#endif

#define DEVI __device__ __forceinline__
typedef unsigned short bf16_t;
typedef short bf16x8 __attribute__((ext_vector_type(8)));
typedef float f32x4 __attribute__((ext_vector_type(4)));

constexpr int NT = 512;
constexpr int DM = 1024;
constexpr int NPR = 16384;
constexpr int NR = 16512;
constexpr int NRP = 16640;
constexpr int LDP = 5888;
constexpr int DPROJ = 5784;
constexpr int NSEQ = 136;
constexpr int C_DNQ = 0, C_DNK = 512, C_DNV = 1024, C_DNZ = 1536, C_DNB = 2048, C_DNA = 2052;
constexpr int C_GQ = 2056, C_GK = 2312, C_GV = 2568, C_GZ = 3080, C_GLO = 3592;
constexpr int C_RX = 3608, C_RZ = 5272;
constexpr size_t O_YP = 0;
constexpr size_t O_YS = O_YP + (size_t)16384 * 1024;
constexpr size_t O_PCONV = O_YS + (size_t)128 * 1024;
constexpr size_t O_PDN = O_PCONV + (size_t)2 * 8 * 3 * 1536;
constexpr size_t O_PGLA = O_PDN + (size_t)2 * 8 * 4 * 128 * 128;
constexpr size_t O_PRS = O_PGLA + (size_t)2 * 8 * 4 * 64 * 128;
constexpr size_t O_PRW = O_PRS + (size_t)2 * 8 * 1664;
constexpr size_t O_SCONV = O_PRW + (size_t)2 * 8 * 8 * 64 * 64;
constexpr size_t O_SDN = O_SCONV + (size_t)2 * 128 * 3 * 1536;
constexpr size_t O_SGLA = O_SDN + (size_t)2 * 128 * 4 * 128 * 128;
constexpr size_t O_SRS = O_SGLA + (size_t)2 * 128 * 4 * 64 * 128;
constexpr size_t O_SRW = O_SRS + (size_t)2 * 128 * 1664;

struct Params {
    const float *x_prompt, *x_sample, *c_prompt, *c_sample, *st_conv, *st_dn, *st_gla, *st_rs, *st_rw;
    const float *norm_g, *ada_w, *ada_b, *w_in, *conv_w, *a_log, *dt_bias, *dn_norm_g, *gla_wf, *gla_bf, *gla_norm_g;
    const float *rw_mu, *rw_w0, *rw_w2, *rw_a0, *rw_a2, *rw_k_k, *rw_k_a, *rw_r_k, *rw_ln_w, *rw_ln_b, *w_out, *final_g;
    float* out;
    bf16_t *WinT, *WoutT, *h, *proj, *obf;
    float *mod, *x, *dnq, *dnk, *dnv, *dnbeta, *dna, *glf, *rr, *rk, *rv, *rw, *rkk, *rb, *rbonus, *oraw;
    bf16_t *dnW, *dnR, *dnKT, *dnM, *dnUT, *dnO1, *dnVT, *rwW, *rwR, *rwKT, *rwBT, *rwM, *rwUT, *rwO1, *rwVT, *glR, *glKT, *glO1, *glVT;
    float *dnpc, *dnav, *rwpc, *glpc;
    unsigned* bar;
    int p0, p1;
};

typedef const __attribute__((address_space(4))) Params* KP;
DEVI KP launder(KP q) { asm volatile("" : "+s"(q)); return q; }
DEVI int tidx() { int v = threadIdx.x; asm volatile("" : "+v"(v)); return v; }
DEVI int bidx() { int v = blockIdx.x; asm volatile("" : "+s"(v)); return v; }
DEVI int gdim() { int v = gridDim.x; asm volatile("" : "+s"(v)); return v; }
DEVI bf16_t f2bf(float f) { unsigned u = __float_as_uint(f); u += 0x7fffu + ((u >> 16) & 1u); return (bf16_t)(u >> 16); }
DEVI float bf2f(bf16_t b) { return __uint_as_float(((unsigned)b) << 16); }
template <int CTRL> DEVI float dppf(float v) { return __int_as_float(__builtin_amdgcn_update_dpp(0, __float_as_int(v), CTRL, 0xF, 0xF, true)); }
DEVI float rdlane(float v, int l) { return __int_as_float(__builtin_amdgcn_readlane(__float_as_int(v), l)); }
DEVI float wsum(float v) {
    v += dppf<0xB1>(v);
    v += dppf<0x4E>(v);
    v += dppf<0x141>(v);
    v += dppf<0x140>(v);
    return (rdlane(v, 0) + rdlane(v, 16)) + (rdlane(v, 32) + rdlane(v, 48));
}
DEVI float fexp(float x) { return __expf(x); }
DEVI float frcp(float x) { return __builtin_amdgcn_rcpf(x); }
DEVI float siluf(float x) { return x * frcp(1.f + fexp(-x)); }
DEVI float sigmf(float x) { return frcp(1.f + fexp(-x)); }
DEVI float softplusf(float x) { return x > 20.f ? x : __logf(1.f + fexp(x)); }
DEVI float ftanh(float x) { return 1.f - 2.f * frcp(1.f + fexp(2.f * x)); }
DEVI void wave_sync() {
    __builtin_amdgcn_fence(__ATOMIC_RELEASE, "wavefront");
    __builtin_amdgcn_wave_barrier();
    __builtin_amdgcn_fence(__ATOMIC_ACQUIRE, "wavefront");
}
DEVI int mod_row(int row) { return row < NPR ? (row >> 11) : (8 + row - NPR); }

typedef float f32x2 __attribute__((ext_vector_type(2)));
typedef __bf16 bf16x2_t __attribute__((ext_vector_type(2)));
typedef unsigned u32x2 __attribute__((ext_vector_type(2)));
typedef unsigned u32x4 __attribute__((ext_vector_type(4)));
DEVI unsigned pk2(float a, float b) { f32x2 v = {a, b}; bf16x2_t r = __builtin_convertvector(v, bf16x2_t); return __builtin_bit_cast(unsigned, r); }
#define MFMA16(a, b, c) __builtin_amdgcn_mfma_f32_16x16x32_bf16((a), (b), (c), 0, 0, 0)
DEVI void transpose_tile4(const float* src, bf16_t* dst, int K, int N, int k0, int n0, float* tl) {
    const int tid = tidx();
    float v[4][8];
#pragma unroll
    for (int t = 0; t < 4; ++t)
#pragma unroll
        for (int i = 0; i < 8; ++i) {
            const int kk = (tid >> 6) + i * 8, nn = n0 + t * 64 + (tid & 63);
            v[t][i] = nn < N ? src[(size_t)(k0 + kk) * N + nn] : 0.f;
        }
#pragma unroll
    for (int t = 0; t < 4; ++t)
#pragma unroll
        for (int i = 0; i < 8; ++i) tl[t * 4160 + ((tid >> 6) + i * 8) * 65 + (tid & 63)] = v[t][i];
    __syncthreads();
#pragma unroll
    for (int t = 0; t < 4; ++t)
#pragma unroll
        for (int i = 0; i < 4; ++i) {
            const int nn = (tid >> 5) + i * 16, kk = (tid & 31) * 2;
            *(unsigned*)(dst + (size_t)(n0 + t * 64 + nn) * K + k0 + kk) = pk2(tl[t * 4160 + kk * 65 + nn], tl[t * 4160 + (kk + 1) * 65 + nn]);
        }
    __syncthreads();
}

DEVI void phase_setup(KP p_, unsigned char* smem) {
    KP p = launder(p_);
    const int tid = tidx();
    float* tl = (float*)smem;
    for (int it = bidx(); it < 2 * 16 * 23; it += gdim()) {
        int l = it / (16 * 23), r = it % (16 * 23), kt = r / 23, ng = r % 23;
        transpose_tile4(p->w_in + (size_t)l * 1024 * DPROJ, p->WinT + (size_t)l * LDP * 1024, 1024, DPROJ, kt * 64, ng * 256, tl);
    }
    for (int it = bidx(); it < 2 * 24 * 4; it += gdim()) {
        int l = it / (24 * 4), r = it % (24 * 4), kt = r / 4, ng = r % 4;
        transpose_tile4(p->w_out + (size_t)l * 1536 * 1024, p->WoutT + (size_t)l * 1024 * 1536, 1536, 1024, kt * 64, ng * 256, tl);
    }
    {
        for (size_t i = (size_t)bidx() * NT + tid; i < (size_t)(NRP - NR) * 1024; i += (size_t)gdim() * NT) p->h[(size_t)NR * 1024 + i] = 0;
        for (size_t i = (size_t)bidx() * NT + tid; i < (size_t)(NRP - NR) * 1536; i += (size_t)gdim() * NT) p->obf[(size_t)NR * 1536 + i] = 0;
    }
    float* sc = (float*)smem;
    for (int it = bidx(); it < 2 * 6 * 17; it += gdim()) {
        int l = it / 102, r = it % 102, jt = r / 17, rg = r % 17;
        for (int idx = tid; idx < 8192; idx += NT) {
            int rr = idx >> 10, k = idx & 1023, mb = rg * 8 + rr;
            float c = mb < 8 ? p->c_prompt[mb * 1024 + k] : p->c_sample[(mb - 8) * 1024 + k];
            sc[k * 8 + rr] = siluf(c);
        }
        __syncthreads();
        const int col = jt * 512 + tid;
        f32x2 acc2[4];
#pragma unroll
        for (int i = 0; i < 4; ++i) acc2[i] = (f32x2){0.f, 0.f};
        const float* aw = p->ada_w + (size_t)l * 1024 * 3072 + col;
#pragma unroll 16
        for (int k = 0; k < 1024; ++k) {
            const float a = aw[(size_t)k * 3072];
            const f32x2 av = {a, a};
            const f32x4 s0 = ((const f32x4*)sc)[k * 2], s1 = ((const f32x4*)sc)[k * 2 + 1];
            acc2[0] = __builtin_elementwise_fma((f32x2){s0[0], s0[1]}, av, acc2[0]); acc2[1] = __builtin_elementwise_fma((f32x2){s0[2], s0[3]}, av, acc2[1]);
            acc2[2] = __builtin_elementwise_fma((f32x2){s1[0], s1[1]}, av, acc2[2]); acc2[3] = __builtin_elementwise_fma((f32x2){s1[2], s1[3]}, av, acc2[3]);
        }
        float bb = p->ada_b[l * 3072 + col];
#pragma unroll
        for (int i = 0; i < 8; ++i) p->mod[((size_t)l * NSEQ + rg * 8 + i) * 3072 + col] = acc2[i >> 1][i & 1] + bb;
        __syncthreads();
    }
}

DEVI void phase_norm(KP p_, int l) {
    KP p = launder(p_);
    const int lane = tidx() & 63, wid = tidx() >> 6;
    for (int row = bidx() * 8 + wid; row < NR; row += gdim() * 8) {
        const float4* xr = l == 0 ? (row < NPR ? (const float4*)(p->x_prompt + (size_t)row * 1024) : (const float4*)(p->x_sample + (size_t)(row - NPR) * 1024))
                                  : (const float4*)(p->x + (size_t)row * 1024);
        const float* md = p->mod + ((size_t)l * NSEQ + mod_row(row)) * 3072;
        float4 v[4], g[4], sh[4], sc[4];
#pragma unroll
        for (int i = 0; i < 4; ++i) {
            const int c = (lane + i * 64) * 4;
            v[i] = xr[lane + i * 64]; g[i] = *(const float4*)(p->norm_g + l * 1024 + c); sh[i] = *(const float4*)(md + c); sc[i] = *(const float4*)(md + 1024 + c);
        }
        float ss = 0.f;
#pragma unroll
        for (int i = 0; i < 4; ++i) ss += v[i].x * v[i].x + v[i].y * v[i].y + v[i].z * v[i].z + v[i].w * v[i].w;
        ss = wsum(ss);
        const float rstd = rsqrtf(ss * (1.f / 1024.f) + 1e-6f);
#pragma unroll
        for (int i = 0; i < 4; ++i) {
            const int c = (lane + i * 64) * 4;
            ushort4 o;
            o.x = f2bf(v[i].x * rstd * g[i].x * (1.f + sc[i].x) + sh[i].x);
            o.y = f2bf(v[i].y * rstd * g[i].y * (1.f + sc[i].y) + sh[i].y);
            o.z = f2bf(v[i].z * rstd * g[i].z * (1.f + sc[i].z) + sh[i].z);
            o.w = f2bf(v[i].w * rstd * g[i].w * (1.f + sc[i].w) + sh[i].w);
            *(ushort4*)(p->h + (size_t)row * 1024 + c) = o;
        }
    }
}

constexpr int G_BM = 256, G_BN = 128, G_BK = 64, G_LDS = 72;
template <class Epi>
DEVI void gemm_phase(unsigned char* smem, const bf16_t* A, int lda, const bf16_t* Bt, int ldb, int Mtiles, int Ntiles, int K, const Epi& epi, int first_block, int mt0) {
    bf16_t* As = (bf16_t*)smem;
    bf16_t* Bs = As + G_BM * G_LDS;
    const int tid = tidx(), lane = tid & 63, wid = tid >> 6, wm = wid >> 1, wn = wid & 1;
    const int fr = lane & 15, fq = lane >> 4;
    const int nk = K / G_BK;
    for (int t = bidx() - first_block; t < Mtiles * Ntiles; t += gdim()) {
        if (t < 0) continue;
        const int mt = mt0 + t / Ntiles, nt = t % Ntiles;
        const bf16_t* Ag = A + (size_t)mt * G_BM * lda;
        const bf16_t* Bg = Bt + (size_t)nt * G_BN * ldb;
        f32x4 acc[4][4];
#pragma unroll
        for (int i = 0; i < 4; ++i)
#pragma unroll
            for (int j = 0; j < 4; ++j) acc[i][j] = (f32x4){0.f, 0.f, 0.f, 0.f};
        const int sr = tid >> 3, scol = (tid & 7) * 8;
        const bf16_t* Ap = Ag + (size_t)sr * lda + scol;
        const bf16_t* Bp = Bg + (size_t)sr * ldb + scol;
        uint4 ra0 = *(const uint4*)(Ap), ra1 = *(const uint4*)(Ap + (size_t)64 * lda), ra2 = *(const uint4*)(Ap + (size_t)128 * lda), ra3 = *(const uint4*)(Ap + (size_t)192 * lda);
        uint4 rb0 = *(const uint4*)(Bp), rb1 = *(const uint4*)(Bp + (size_t)64 * ldb);
        for (int kt = 0; kt < nk; ++kt) {
            *(uint4*)(As + sr * G_LDS + scol) = ra0; *(uint4*)(As + (sr + 64) * G_LDS + scol) = ra1;
            *(uint4*)(As + (sr + 128) * G_LDS + scol) = ra2; *(uint4*)(As + (sr + 192) * G_LDS + scol) = ra3;
            *(uint4*)(Bs + sr * G_LDS + scol) = rb0; *(uint4*)(Bs + (sr + 64) * G_LDS + scol) = rb1;
            __syncthreads();
            if (kt + 1 < nk) {
                const int k0 = (kt + 1) * G_BK;
                ra0 = *(const uint4*)(Ap + k0); ra1 = *(const uint4*)(Ap + (size_t)64 * lda + k0); ra2 = *(const uint4*)(Ap + (size_t)128 * lda + k0); ra3 = *(const uint4*)(Ap + (size_t)192 * lda + k0);
                rb0 = *(const uint4*)(Bp + k0); rb1 = *(const uint4*)(Bp + (size_t)64 * ldb + k0);
            }
#pragma unroll
            for (int ks = 0; ks < 2; ++ks) {
                bf16x8 af[4], bfr[4];
#pragma unroll
                for (int i = 0; i < 4; ++i) af[i] = *(const bf16x8*)(As + (wm * 64 + i * 16 + fr) * G_LDS + ks * 32 + fq * 8);
#pragma unroll
                for (int j = 0; j < 4; ++j) bfr[j] = *(const bf16x8*)(Bs + (wn * 64 + j * 16 + fr) * G_LDS + ks * 32 + fq * 8);
#pragma unroll
                for (int i = 0; i < 4; ++i)
#pragma unroll
                    for (int j = 0; j < 4; ++j) acc[i][j] = __builtin_amdgcn_mfma_f32_16x16x32_bf16(bfr[j], af[i], acc[i][j], 0, 0, 0);
            }
            __syncthreads();
        }
#pragma unroll
        for (int i = 0; i < 4; ++i)
#pragma unroll
            for (int j = 0; j < 4; ++j) epi(mt * G_BM + wm * 64 + i * 16 + fr, nt * G_BN + wn * 64 + j * 16 + fq * 4, acc[i][j]);
    }
}
struct EpiProj {
    bf16_t* proj;
    DEVI void operator()(int m, int n, f32x4 v) const {
        ushort4 o; o.x = f2bf(v[0]); o.y = f2bf(v[1]); o.z = f2bf(v[2]); o.w = f2bf(v[3]);
        *(ushort4*)(proj + (size_t)m * LDP + n) = o;
    }
};
struct EpiOut {
    float* x; const float* mod;
    DEVI void operator()(int m, int n, f32x4 v) const {
        if (m >= NR) return;
        const float4 g = *(const float4*)(mod + (size_t)mod_row(m) * 3072 + 2048 + n);
        float4* xp = (float4*)(x + (size_t)m * 1024 + n);
        float4 xv = *xp;
        xv.x += g.x * v[0]; xv.y += g.y * v[1]; xv.z += g.z * v[2]; xv.w += g.w * v[3];
        *xp = xv;
    }
};

namespace pg8 {
#define PG8_LAS __attribute__((address_space(3)))
typedef unsigned short bf16_t;
typedef short bf16x8 __attribute__((ext_vector_type(8)));
typedef float f32x4 __attribute__((ext_vector_type(4)));
typedef unsigned u32x4 __attribute__((ext_vector_type(4)));
constexpr int BM = 256, BK = 64, HALF = 128, HTB = HALF * BK * 2  , STAGE_BYTES = 8 * HTB, NXCD = 8, WGM = 8;

__host__ __device__ __forceinline__ int lds_byte(int r, int c) { const int st = (r >> 4) * 2 + (c >> 5), rr = r & 15, cc = c & 31, ob = rr * 64 + cc * 2; return st * 1024 + (ob ^ (((ob >> 9) & 1) << 5)); }
__host__ __device__ __forceinline__ void stage_rc(int b, int& R, int& C) { const int st = b / 1024, sb = b % 1024, swz = sb ^ (((sb >> 9) & 1) << 5); R = (st >> 1) * 16 + swz / 64; C = (st & 1) * 32 + (swz % 64) / 2; }
__host__ __device__ __forceinline__ int perm32(int rho) { const int n = rho >> 4, i = rho & 15; return 8 * (i >> 2) + 4 * n + (i & 3); }

struct Unit { int pm, pn; };
struct Gemm { const bf16_t* A; const bf16_t* Bt; int M, N, K; };

struct StaticOrder {
    int nM, nN, nwg, G, c;
    __host__ __device__ void init(int M, int N, int G_, int c_) { nM = M / BM; nN = N / BM; nwg = nM * nN; G = G_; c = c_; }
    __host__ __device__ bool next(int i, Unit& u) const {
        const long L = (long)i * G + c; if (L >= nwg) return false;
        int wgid = (int)L; { const int q = nwg / NXCD, r = nwg % NXCD, xcd = wgid % NXCD, off = wgid / NXCD; wgid = (xcd < r ? xcd * (q + 1) : r * (q + 1) + (xcd - r) * q) + off; }
        const int nig = WGM * nN, gid = wgid / nig, fm = gid * WGM, gsz = (nM - fm) < WGM ? (nM - fm) : WGM;
        u.pm = fm + ((wgid % nig) % gsz); u.pn = (wgid % nig) / gsz; return true;
    }
    __device__ __forceinline__ void a_ready(const Unit&) const {}
    __device__ __forceinline__ void done(const Unit&) const {}
};
template <class Epi, class Sched, bool STAMP = false>
__device__ __forceinline__ void gemm_phase(PG8_LAS unsigned char* lds, const Gemm g, const Sched& S, const Epi& E, unsigned long long* stamps) {
    const int tid = tidx(), wid = __builtin_amdgcn_readfirstlane(tid >> 6), lane = tid & 63, wr = wid >> 2, wc = wid & 3, fr = lane & 15, fq = lane >> 4;
    const int K = g.K, nt = K / BK;
    int ts_lo = 0, ts_hi = 0, nts = 0; const unsigned long long rt_entry = STAMP ? (unsigned long long)wall_clock64() : 0ull;
#define PG8_STAMP() do { if (STAMP && wid == 0 && nts < 64) { const unsigned long long _c = (unsigned long long)clock64(); \
        ts_lo = (lane == nts) ? (int)(unsigned)_c : ts_lo; ts_hi = (lane == nts) ? (int)(unsigned)(_c >> 32) : ts_hi; ++nts; } } while (0)
    PG8_STAMP();
    unsigned voffA[2], voffB[2];
#pragma unroll
    for (int i = 0; i < 2; ++i) { int R, C; stage_rc(tid * 16 + i * 8192, R, C); const int Rb = Epi::PERM ? ((R & ~31) + perm32(R & 31)) : R;
        voffA[i] = (unsigned)(R * K + C) * 2u; voffB[i] = (unsigned)(Rb * K + C) * 2u; }
    const size_t kstep = (size_t)(BK * 2);
    const size_t hstep = (size_t)HALF * K * 2;
    const size_t tstep = 2 * hstep;
    const unsigned ldsw = (unsigned)wid * 1024u;
    const int aoff = lds_byte(wr * 64 + fr, fq * 8), boff = lds_byte(wc * 32 + fr, fq * 8);
#define PG8_SA(b, h) (((b) * 2 + (h)) * HTB)
#define PG8_SB(b, h) ((4 + (b) * 2 + (h)) * HTB)
#define PG8_STAGE(bufoff, gbase, voff) do { _Pragma("unroll") for (int _i = 0; _i < 2; ++_i) \
        __builtin_amdgcn_global_load_lds((const unsigned*)((const char*)(gbase) + (voff)[_i]), (PG8_LAS unsigned*)(lds + (bufoff) + ldsw + _i * 8192), 16, 0, 0); } while (0)
#define PG8_LDA(dst, b, h) do { _Pragma("unroll") for (int m = 0; m < 4; ++m) _Pragma("unroll") for (int k = 0; k < 2; ++k) dst[m][k] = *(const PG8_LAS bf16x8*)(lds + PG8_SA(b, h) + aoff + m * 2048 + k * 1024); } while (0)
#define PG8_LDB(dst, b, h) do { _Pragma("unroll") for (int n = 0; n < 2; ++n) _Pragma("unroll") for (int k = 0; k < 2; ++k) dst[n][k] = *(const PG8_LAS bf16x8*)(lds + PG8_SB(b, h) + boff + n * 2048 + k * 1024); } while (0)
#define PG8_MMA(ai, bj, At, Bt) do { __builtin_amdgcn_s_setprio(1); _Pragma("unroll") for (int m = 0; m < 4; ++m) _Pragma("unroll") for (int n = 0; n < 2; ++n) _Pragma("unroll") for (int k = 0; k < 2; ++k) \
        acc[ai][bj][m][n] = __builtin_amdgcn_mfma_f32_16x16x32_bf16(Bt[n][k], At[m][k], acc[ai][bj][m][n], 0, 0, 0); __builtin_amdgcn_s_setprio(0); } while (0)
#define PG8_WAIT_V(n) asm volatile("s_waitcnt vmcnt(" #n ")" ::: "memory")
#define PG8_WAIT_L(n) asm volatile("s_waitcnt lgkmcnt(" #n ")" ::: "memory")
#define PG8_BAR __builtin_amdgcn_s_barrier()
#define PG8_SCHED __builtin_amdgcn_sched_barrier(0)
    Unit cur, nxt; int ui = 0;
    if (!S.next(0, cur)) return;
    f32x4 acc[2][2][4][2];
#pragma unroll
    for (int a = 0; a < 2; ++a)
#pragma unroll
        for (int b = 0; b < 2; ++b)
#pragma unroll
            for (int m = 0; m < 4; ++m)
#pragma unroll
                for (int n = 0; n < 2; ++n) acc[a][b][m][n] = (f32x4){0.f, 0.f, 0.f, 0.f};
    bf16x8 At[4][2], B0[2][2], B1[2][2];
    const char* cA = (const char*)g.A + (size_t)cur.pm * tstep; const char* cB = (const char*)g.Bt + (size_t)cur.pn * tstep;
    S.a_ready(cur);
    PG8_STAGE(PG8_SB(0, 0), cB, voffB); PG8_STAGE(PG8_SA(0, 0), cA, voffA); PG8_STAGE(PG8_SB(0, 1), cB + hstep, voffB); PG8_STAGE(PG8_SA(0, 1), cA + hstep, voffA);
    if (wr == 1) PG8_BAR;
    PG8_WAIT_V(4); PG8_BAR;
    PG8_STAGE(PG8_SB(1, 0), cB + kstep, voffB); PG8_STAGE(PG8_SA(1, 0), cA + kstep, voffA); PG8_STAGE(PG8_SB(1, 1), cB + hstep + kstep, voffB);
    PG8_WAIT_V(6); PG8_BAR;
    PG8_STAMP();
    for (;;) {
        const bool has_next = S.next(ui + 1, nxt);
        const char* nA = has_next ? (const char*)g.A + (size_t)nxt.pm * tstep : cA; const char* nB = has_next ? (const char*)g.Bt + (size_t)nxt.pn * tstep : cB;
        for (int t = 0; t < nt; t += 2) {
            const bool last = (t == nt - 2);
            const char* a1 = cA + (size_t)(t + 1) * kstep;
            const char* a2 = last ? nA : cA + (size_t)(t + 2) * kstep; const char* b2 = last ? nB : cB + (size_t)(t + 2) * kstep;
            const char* a3 = a2 + kstep; const char* b3 = b2 + kstep;
            if (last && has_next) S.a_ready(nxt);
            PG8_LDB(B0, 0, 0); PG8_SCHED; PG8_LDA(At, 0, 0); PG8_STAGE(PG8_SA(1, 1), a1 + hstep, voffA);
            PG8_WAIT_L(8); PG8_BAR; PG8_WAIT_L(0); PG8_MMA(0, 0, At, B0); PG8_BAR; PG8_SCHED;
            PG8_LDB(B1, 0, 1); PG8_STAGE(PG8_SB(0, 0), b2, voffB);
            PG8_BAR; PG8_WAIT_L(0); PG8_MMA(0, 1, At, B1); PG8_BAR;
            PG8_LDA(At, 0, 1); PG8_STAGE(PG8_SA(0, 0), a2, voffA);
            PG8_BAR; PG8_WAIT_L(0); PG8_MMA(1, 0, At, B0); PG8_BAR; PG8_SCHED;
            PG8_STAGE(PG8_SB(0, 1), b2 + hstep, voffB);
            PG8_WAIT_V(6); PG8_BAR; PG8_MMA(1, 1, At, B1); PG8_BAR;
            PG8_LDB(B0, 1, 0); PG8_SCHED; PG8_LDA(At, 1, 0); PG8_STAGE(PG8_SA(0, 1), a2 + hstep, voffA);
            PG8_WAIT_L(8); PG8_BAR; PG8_WAIT_L(0); PG8_MMA(0, 0, At, B0); PG8_BAR; PG8_SCHED;
            PG8_LDB(B1, 1, 1); PG8_STAGE(PG8_SB(1, 0), b3, voffB);
            PG8_BAR; PG8_WAIT_L(0); PG8_MMA(0, 1, At, B1); PG8_BAR;
            PG8_LDA(At, 1, 1); PG8_STAGE(PG8_SA(1, 0), a3, voffA);
            PG8_BAR; PG8_WAIT_L(0); PG8_MMA(1, 0, At, B0); PG8_BAR; PG8_SCHED;
            PG8_STAGE(PG8_SB(1, 1), b3 + hstep, voffB);
            PG8_WAIT_V(6); PG8_BAR; PG8_MMA(1, 1, At, B1); PG8_BAR;
        }
        PG8_STAMP();
        if constexpr (!Epi::AFTER_DRAIN) { E(acc, cur, wr, wc, fr, fq); S.done(cur); }
        PG8_STAMP();
        if (!has_next) break;
#pragma unroll
        for (int a = 0; a < 2; ++a)
#pragma unroll
            for (int b = 0; b < 2; ++b)
#pragma unroll
                for (int m = 0; m < 4; ++m)
#pragma unroll
                    for (int n = 0; n < 2; ++n) acc[a][b][m][n] = (f32x4){0.f, 0.f, 0.f, 0.f};
        cur = nxt; cA = nA; cB = nB; ++ui;
    }
    PG8_WAIT_V(0);
    if (wr == 0) PG8_BAR;
    PG8_BAR;
    if constexpr (Epi::AFTER_DRAIN) { E.fused(acc, cur, wr, wc, fr, fq, lds, wid, lane); S.done(cur); }
    PG8_STAMP();
    if (STAMP && wid == 0) { stamps[lane] = lane < nts ? (((unsigned long long)(unsigned)ts_hi << 32) | (unsigned)ts_lo) : 0ull;
        if (lane == 62) stamps[62] = rt_entry; if (lane == 63) stamps[63] = (unsigned long long)wall_clock64(); }
#undef PG8_STAMP
#undef PG8_SA
#undef PG8_SB
#undef PG8_STAGE
#undef PG8_LDA
#undef PG8_LDB
#undef PG8_MMA
#undef PG8_WAIT_V
#undef PG8_WAIT_L
#undef PG8_BAR
#undef PG8_SCHED
}
}

struct EpiProjPG {
    static constexpr bool PERM = true, AFTER_DRAIN = false;
    bf16_t* O;
    DEVI void operator()(const pg8::f32x4 (&acc)[2][2][4][2], const pg8::Unit& u, int wr, int wc, int fr, int fq) const {
        const int row0 = u.pm * 256 + wr * 64 + fr, col0 = u.pn * 256 + wc * 32 + 8 * fq;
#pragma unroll
        for (int ai = 0; ai < 2; ++ai)
#pragma unroll
            for (int m = 0; m < 4; ++m) {
                bf16_t* rowp = O + (size_t)(row0 + ai * 128 + m * 16) * LDP + col0;
#pragma unroll
                for (int bj = 0; bj < 2; ++bj) {
                    const pg8::f32x4 v0 = acc[ai][bj][m][0], v1 = acc[ai][bj][m][1];
                    u32x4 w = {pk2(v0[0], v0[1]), pk2(v0[2], v0[3]), pk2(v1[0], v1[1]), pk2(v1[2], v1[3])};
                    *(u32x4*)(rowp + bj * 128) = w;
                }
            }
    }
};
struct EpiOutPG {
    static constexpr bool PERM = false, AFTER_DRAIN = false;
    float* x; const float* xin; const float* mod;
    DEVI void operator()(const pg8::f32x4 (&acc)[2][2][4][2], const pg8::Unit& u, int wr, int wc, int fr, int fq) const {
        const int row0 = u.pm * 256 + wr * 64 + fr, col0 = u.pn * 256 + wc * 32 + 4 * fq;
        const float* gp = mod + (size_t)(u.pm >> 3) * 3072 + 2048 + col0;
        pg8::f32x4 gv[2][2];
#pragma unroll
        for (int bj = 0; bj < 2; ++bj)
#pragma unroll
            for (int n = 0; n < 2; ++n) gv[bj][n] = *(const pg8::f32x4*)(gp + bj * 128 + n * 16);
#pragma unroll
        for (int ai = 0; ai < 2; ++ai)
#pragma unroll
            for (int m = 0; m < 4; ++m) {
                const size_t ro = (size_t)(row0 + ai * 128 + m * 16) * 1024 + col0;
#pragma unroll
                for (int bj = 0; bj < 2; ++bj)
#pragma unroll
                    for (int n = 0; n < 2; ++n)
                        *(pg8::f32x4*)(x + ro + bj * 128 + n * 16) = *(const pg8::f32x4*)(xin + ro + bj * 128 + n * 16) + gv[bj][n] * acc[ai][bj][m][n];
            }
    }
};
DEVI void out_gemm_sample(KP p_, int l) {
    KP p = launder(p_);
    const int nt = bidx();
    if (nt >= 64) return;
    const int lane = tidx() & 63, wid = tidx() >> 6, q = lane >> 4, c = lane & 15;
    const bf16_t* a = p->obf + (size_t)(NPR + wid * 16 + c) * 1536 + 8 * q;
    const bf16_t* b = p->WoutT + (size_t)l * 1024 * 1536 + (size_t)(nt * 16 + c) * 1536 + 8 * q;
    f32x4 acc0 = {0.f, 0.f, 0.f, 0.f}, acc1 = {0.f, 0.f, 0.f, 0.f};
#pragma unroll 8
    for (int ks = 0; ks < 48; ks += 2) {
        acc0 = MFMA16(*(const bf16x8*)(b + ks * 32), *(const bf16x8*)(a + ks * 32), acc0);
        acc1 = MFMA16(*(const bf16x8*)(b + ks * 32 + 32), *(const bf16x8*)(a + ks * 32 + 32), acc1);
    }
    const int m = NPR + wid * 16 + c, n = nt * 16 + 4 * q;
    const f32x4 g = *(const f32x4*)(p->mod + ((size_t)l * NSEQ + mod_row(m)) * 3072 + 2048 + n);
    const float* xi = l == 0 ? p->x_sample + (size_t)(m - NPR) * 1024 + n : p->x + (size_t)m * 1024 + n;
    *(f32x4*)(p->x + (size_t)m * 1024 + n) = *(const f32x4*)xi + g * (acc0 + acc1);
}
DEVI float dn_full(KP p, int l, int s, int row0, int f, int col) {
    if (f < 3) { if (s < 8) return 0.f; return p->st_conv[((size_t)(l * 128 + (s - 8)) * 3 + f) * 1536 + col]; }
    return bf2f(p->proj[(size_t)(row0 + f - 3) * LDP + col]);
}
DEVI void seq_of_row(int row, int& s, int& t, int& T, int& row0) {
    if (row < NPR) { s = row >> 11; t = row & 2047; T = 2048; row0 = s * 2048; }
    else { s = 8 + row - NPR; t = 0; T = 1; row0 = row; }
}

DEVI void phase_prep(KP p_, int l, unsigned char* smem) {
    KP p = launder(p_);
    const int tid = tidx(), lane = tid & 63, wid = tid >> 6;
    for (int it = NPR * 4 + bidx() * 8 + wid; it < NR * 4; it += gdim() * 8) {
        const int row = it >> 2, h = it & 3, b = row - NPR;
        const float* st = p->st_conv + (size_t)(l * 128 + b) * 3 * 1536;
        float* cdst = p->out + O_SCONV + (size_t)(l * 128 + b) * 3 * 1536;
        float val[3][2];
#pragma unroll
        for (int seg = 0; seg < 3; ++seg) {
            const int col = seg * 512 + h * 128 + lane * 2;
            const float2 s0 = *(const float2*)(st + col), s1 = *(const float2*)(st + 1536 + col), s2 = *(const float2*)(st + 3072 + col);
            const unsigned cu = *(const unsigned*)(p->proj + (size_t)row * LDP + col);
            const float2 cur = make_float2(__uint_as_float(cu << 16), __uint_as_float(cu & 0xffff0000u));
            const float2 w0 = *(const float2*)(p->conv_w + (l * 4 + 0) * 1536 + col), w1 = *(const float2*)(p->conv_w + (l * 4 + 1) * 1536 + col);
            const float2 w2 = *(const float2*)(p->conv_w + (l * 4 + 2) * 1536 + col), w3 = *(const float2*)(p->conv_w + (l * 4 + 3) * 1536 + col);
            val[seg][0] = siluf(s0.x * w0.x + s1.x * w1.x + s2.x * w2.x + cur.x * w3.x);
            val[seg][1] = siluf(s0.y * w0.y + s1.y * w1.y + s2.y * w2.y + cur.y * w3.y);
            *(float2*)(cdst + col) = s1; *(float2*)(cdst + 1536 + col) = s2; *(float2*)(cdst + 3072 + col) = cur;
        }
        float sq = wsum(val[0][0] * val[0][0] + val[0][1] * val[0][1]);
        float sk = wsum(val[1][0] * val[1][0] + val[1][1] * val[1][1]);
        const float rq = rsqrtf(sq + 1e-6f) * 0.08838834764831845f, rk = rsqrtf(sk + 1e-6f);
        const size_t o = (size_t)row * 512 + h * 128 + lane * 2;
        *(float2*)(p->dnq + o) = make_float2(val[0][0] * rq, val[0][1] * rq);
        *(float2*)(p->dnk + o) = make_float2(val[1][0] * rk, val[1][1] * rk);
        *(float2*)(p->dnv + o) = make_float2(val[2][0], val[2][1]);
        if (lane == 0) {
            float braw = bf2f(p->proj[(size_t)row * LDP + C_DNB + h]), araw = bf2f(p->proj[(size_t)row * LDP + C_DNA + h]);
            p->dnbeta[row * 4 + h] = sigmf(braw);
            float g = -fexp(p->a_log[l * 4 + h]) * softplusf(araw + p->dt_bias[l * 4 + h]);
            p->dna[row * 4 + h] = fexp(g);
        }
    }
    for (int row = NPR + ((bidx() + gdim() - 64) % gdim()) * 8 + wid; row < NR; row += gdim() * 8) {
        float glo[16];
#pragma unroll
        for (int j = 0; j < 16; ++j) glo[j] = bf2f(p->proj[(size_t)row * LDP + C_GLO + j]);
#pragma unroll
        for (int i = 0; i < 4; ++i) {
            const int c = lane + i * 64;
            float z = p->gla_bf[l * 256 + c];
#pragma unroll
            for (int j = 0; j < 16; ++j) z += glo[j] * p->gla_wf[(l * 16 + j) * 256 + c];
            p->glf[(size_t)row * 256 + c] = -softplusf(-z) * (1.f / 16.f);
        }
    }
    constexpr int RT = 2;
    float* twT = (float*)smem;
    float* alT = twT + 64 * RT;
    for (int tile = NPR / RT + (bidx() + gdim() - 128) % gdim(); tile < NR / RT; tile += gdim()) {
        const int c = tid;
        const int rbase = tile * RT;
        const float mur = p->rw_mu[l * 1664 + c], muk = p->rw_mu[l * 1664 + 512 + c], muv = p->rw_mu[l * 1664 + 1024 + c];
        float xr[RT], xk[RT], xv[RT];
#pragma unroll
        for (int r = 0; r < RT; ++r) {
            const int row = rbase + r;
            const bf16_t* pp = p->proj + (size_t)row * LDP + C_RX;
            const float cr = bf2f(pp[c]), ck = bf2f(pp[512 + c]), cv = bf2f(pp[1024 + c]);
            const float* st = p->st_rs + (size_t)(l * 128 + row - NPR) * 1664;
            const float pr = st[c], pk = st[512 + c], pv = st[1024 + c];
            xr[r] = cr + (pr - cr) * mur; xk[r] = ck + (pk - ck) * muk; xv[r] = cv + (pv - cv) * muv;
            float* dst = p->out + O_SRS + (size_t)(l * 128 + row - NPR) * 1664;
            dst[c] = cr; dst[512 + c] = ck; dst[1024 + c] = cv;
            if (c < 128) dst[1536 + c] = bf2f(pp[1536 + c]);
        }
        if (c < 128) {
            const int col = 1536 + c, j = c & 63;
            const float mu = p->rw_mu[l * 1664 + col];
#pragma unroll
            for (int r = 0; r < RT; ++r) {
                const int row = rbase + r;
                const float cw = bf2f(p->proj[(size_t)row * LDP + C_RX + col]);
                const float pw = p->st_rs[(size_t)(l * 128 + row - NPR) * 1664 + col];
                const float xm = cw + (pw - cw) * mu;
                if (c < 64) twT[j * RT + r] = ftanh(xm); else alT[j * RT + r] = xm;
            }
        }
        __syncthreads();
        float aw[RT], aa[RT];
#pragma unroll
        for (int r = 0; r < RT; ++r) { aw[r] = 0.f; aa[r] = 0.f; }
#pragma unroll 32
        for (int j = 0; j < 64; ++j) {
            const float w2v = p->rw_w2[((size_t)l * 64 + j) * 512 + c], a2v = p->rw_a2[((size_t)l * 64 + j) * 512 + c];
            const float2 t2 = ((const float2*)twT)[j], a2 = ((const float2*)alT)[j];
            aw[0] += t2.x * w2v; aw[1] += t2.y * w2v;
            aa[0] += a2.x * a2v; aa[1] += a2.y * a2v;
        }
        const float w0 = p->rw_w0[l * 512 + c], a0 = p->rw_a0[l * 512 + c], kkc = p->rw_k_k[l * 512 + c], kac = p->rw_k_a[l * 512 + c], rkc = p->rw_r_k[l * 512 + c];
#pragma unroll
        for (int r = 0; r < RT; ++r) {
            const size_t o = (size_t)(rbase + r) * 512 + c;
            const float wl = -softplusf(-(w0 + aw[r])) - 0.5f;
            const float decay = fexp(-fexp(wl));
            const float a = sigmf(a0 + aa[r]);
            const float kr = xk[r] * kkc;
            const float ss = wsum(kr * kr);
            const float kk = kr * rsqrtf(ss + 1e-6f);
            const float k2 = xk[r] * (1.f + (a - 1.f) * kac);
            const float bon = wsum(xr[r] * k2 * rkc) * xv[r];
            p->rr[o] = xr[r]; p->rk[o] = k2; p->rv[o] = xv[r]; p->rw[o] = decay; p->rkk[o] = kk; p->rb[o] = kk * a; p->rbonus[o] = bon;
        }
        __syncthreads();
    }
}

DEVI void dn_scan_item(KP p, int l, int s, int h, int quarter, float* wl) {
    const int lane = tidx() & 63, kh = lane & 1;
    const int row = NPR + s - 8;
    const float* Sin = p->st_dn + (size_t)((l * 128 + s - 8) * 4 + h) * 16384;
    float* Sout = p->out + O_SDN + (size_t)((l * 128 + s - 8) * 4 + h) * 16384;
    const int col = quarter * 32 + (lane >> 1);
    float S[64];
#pragma unroll
    for (int k = 0; k < 64; ++k) S[k] = Sin[(kh * 64 + k) * 128 + col];
    const size_t o = (size_t)row * 512 + h * 128;
    wave_sync();
    wl[lane] = p->dnq[o + lane]; wl[64 + lane] = p->dnq[o + 64 + lane]; wl[128 + lane] = p->dnk[o + lane]; wl[192 + lane] = p->dnk[o + 64 + lane];
    const float v = p->dnv[o + col], beta = p->dnbeta[row * 4 + h], a = p->dna[row * 4 + h];
    wave_sync();
    const float4* kp = (const float4*)(wl + 128 + kh * 64);
    const float4* qp = (const float4*)(wl + kh * 64);
    float x0 = 0.f, x1 = 0.f, x2 = 0.f, x3 = 0.f;
#pragma unroll
    for (int k4 = 0; k4 < 16; ++k4) {
        const float4 kv = kp[k4];
        x0 += S[k4 * 4 + 0] * kv.x; x1 += S[k4 * 4 + 1] * kv.y; x2 += S[k4 * 4 + 2] * kv.z; x3 += S[k4 * 4 + 3] * kv.w;
    }
    float x = (x0 + x1) + (x2 + x3);
    x += __shfl_xor(x, 1);
    const float coef = beta * (v - a * x);
    float o0 = 0.f, o1 = 0.f, o2 = 0.f, o3 = 0.f;
#pragma unroll
    for (int k4 = 0; k4 < 16; ++k4) {
        const float4 kv = kp[k4];
        const float4 qv = qp[k4];
        S[k4 * 4 + 0] = a * S[k4 * 4 + 0] + coef * kv.x; o0 += S[k4 * 4 + 0] * qv.x;
        S[k4 * 4 + 1] = a * S[k4 * 4 + 1] + coef * kv.y; o1 += S[k4 * 4 + 1] * qv.y;
        S[k4 * 4 + 2] = a * S[k4 * 4 + 2] + coef * kv.z; o2 += S[k4 * 4 + 2] * qv.z;
        S[k4 * 4 + 3] = a * S[k4 * 4 + 3] + coef * kv.w; o3 += S[k4 * 4 + 3] * qv.w;
    }
    float ov = (o0 + o1) + (o2 + o3);
    ov += __shfl_xor(ov, 1);
    if (kh == 0) p->oraw[(size_t)row * 1536 + h * 128 + col] = ov;
#pragma unroll
    for (int k = 0; k < 64; ++k) Sout[(kh * 64 + k) * 128 + col] = S[k];
}

DEVI void gla_scan_item(KP p, int l, int s, int h, int quarter, float* wl) {
    const int lane = tidx() & 63, kh = lane & 1;
    const int row = NPR + s - 8;
    const float* Sin = p->st_gla + (size_t)((l * 128 + s - 8) * 4 + h) * 8192;
    float* Sout = p->out + O_SGLA + (size_t)((l * 128 + s - 8) * 4 + h) * 8192;
    const int col = quarter * 32 + (lane >> 1);
    float S[32];
#pragma unroll
    for (int k = 0; k < 32; ++k) S[k] = Sin[(kh * 32 + k) * 128 + col];
    const bf16_t* pp = p->proj + (size_t)row * LDP;
    wave_sync();
    wl[lane] = bf2f(pp[C_GQ + h * 64 + lane]) * 0.125f; wl[64 + lane] = bf2f(pp[C_GK + h * 64 + lane]);
    wl[128 + lane] = fexp(p->glf[(size_t)row * 256 + h * 64 + lane]);
    const float v = bf2f(pp[C_GV + h * 128 + col]);
    wave_sync();
    float o0 = 0.f, o1 = 0.f, o2 = 0.f, o3 = 0.f;
#pragma unroll
    for (int k4 = 0; k4 < 8; ++k4) {
        const float4 qv = ((const float4*)(wl + kh * 32))[k4], kv = ((const float4*)(wl + 64 + kh * 32))[k4], fv = ((const float4*)(wl + 128 + kh * 32))[k4];
        S[k4 * 4 + 0] = fv.x * S[k4 * 4 + 0] + kv.x * v; o0 += S[k4 * 4 + 0] * qv.x;
        S[k4 * 4 + 1] = fv.y * S[k4 * 4 + 1] + kv.y * v; o1 += S[k4 * 4 + 1] * qv.y;
        S[k4 * 4 + 2] = fv.z * S[k4 * 4 + 2] + kv.z * v; o2 += S[k4 * 4 + 2] * qv.z;
        S[k4 * 4 + 3] = fv.w * S[k4 * 4 + 3] + kv.w * v; o3 += S[k4 * 4 + 3] * qv.w;
    }
    float ov = (o0 + o1) + (o2 + o3);
    ov += __shfl_xor(ov, 1);
    if (kh == 0) p->oraw[(size_t)row * 1536 + 512 + h * 128 + col] = ov;
#pragma unroll
    for (int k = 0; k < 32; ++k) Sout[(kh * 32 + k) * 128 + col] = S[k];
}

DEVI void rw_scan_item(KP p, int l, int s, int h, int half, float* wl) {
    const int lane = tidx() & 63, kh = lane & 1;
    const int row = NPR + s - 8;
    const float* Sin = p->st_rw + (size_t)((l * 128 + s - 8) * 8 + h) * 4096;
    float* Sout = p->out + O_SRW + (size_t)((l * 128 + s - 8) * 8 + h) * 4096;
    const int vr = half * 32 + (lane >> 1);
    float S[32];
#pragma unroll
    for (int k4 = 0; k4 < 8; ++k4) {
        const float4 v4 = ((const float4*)(Sin + vr * 64 + kh * 32))[k4];
        S[k4 * 4 + 0] = v4.x; S[k4 * 4 + 1] = v4.y; S[k4 * 4 + 2] = v4.z; S[k4 * 4 + 3] = v4.w;
    }
    const size_t o = (size_t)row * 512 + h * 64;
    wave_sync();
    wl[lane] = p->rr[o + lane]; wl[64 + lane] = p->rw[o + lane]; wl[128 + lane] = p->rk[o + lane]; wl[192 + lane] = p->rkk[o + lane]; wl[256 + lane] = p->rb[o + lane];
    const float v = p->rv[o + vr];
    wave_sync();
    float x0 = 0.f, x1 = 0.f, x2 = 0.f, x3 = 0.f;
#pragma unroll
    for (int k4 = 0; k4 < 8; ++k4) {
        const float4 kv = ((const float4*)(wl + 192 + kh * 32))[k4];
        x0 += S[k4 * 4 + 0] * kv.x; x1 += S[k4 * 4 + 1] * kv.y; x2 += S[k4 * 4 + 2] * kv.z; x3 += S[k4 * 4 + 3] * kv.w;
    }
    float x = (x0 + x1) + (x2 + x3);
    x += __shfl_xor(x, 1);
    float o0 = 0.f, o1 = 0.f, o2 = 0.f, o3 = 0.f;
#pragma unroll
    for (int k4 = 0; k4 < 8; ++k4) {
        const float4 rv = ((const float4*)(wl + kh * 32))[k4], wv = ((const float4*)(wl + 64 + kh * 32))[k4], kv = ((const float4*)(wl + 128 + kh * 32))[k4], bv = ((const float4*)(wl + 256 + kh * 32))[k4];
        S[k4 * 4 + 0] = S[k4 * 4 + 0] * wv.x - x * bv.x + v * kv.x; o0 += S[k4 * 4 + 0] * rv.x;
        S[k4 * 4 + 1] = S[k4 * 4 + 1] * wv.y - x * bv.y + v * kv.y; o1 += S[k4 * 4 + 1] * rv.y;
        S[k4 * 4 + 2] = S[k4 * 4 + 2] * wv.z - x * bv.z + v * kv.z; o2 += S[k4 * 4 + 2] * rv.z;
        S[k4 * 4 + 3] = S[k4 * 4 + 3] * wv.w - x * bv.w + v * kv.w; o3 += S[k4 * 4 + 3] * rv.w;
    }
    float ov = (o0 + o1) + (o2 + o3);
    ov += __shfl_xor(ov, 1);
    if (kh == 0) p->oraw[(size_t)row * 1536 + 1024 + h * 64 + vr] = ov;
#pragma unroll
    for (int k4 = 0; k4 < 8; ++k4)
        ((float4*)(Sout + vr * 64 + kh * 32))[k4] = make_float4(S[k4 * 4 + 0], S[k4 * 4 + 1], S[k4 * 4 + 2], S[k4 * 4 + 3]);
}

DEVI bf16_t bfr(float a) { return (bf16_t)(pk2(a, 0.f) & 0xffffu); }
DEVI int permpos(int i) { return (i & ~31) | ((i & 12) << 1) | ((i & 16) >> 2) | (i & 3); }
DEVI float expc(float x) { return fexp(fminf(x, 80.f)); }

template <class F>
DEVI void lds_mm(const bf16_t* A, int lda, const bf16_t* Bt, int ldb, int MT, int NTl, int KS, F epi) {
    const int tid = tidx(), lane = tid & 63, wid = tid >> 6, r = lane & 15, q = lane >> 4;
    const int ntile = MT * NTl;
    for (int t = wid; t < ntile; t += 16) {
        const int t2 = t + 8;
        const bool two = t2 < ntile;
        const int mt = t / NTl, nt = t % NTl, mt2 = two ? t2 / NTl : mt, nt2 = two ? t2 % NTl : nt;
        f32x4 acc = {0.f, 0.f, 0.f, 0.f}, acc2 = {0.f, 0.f, 0.f, 0.f};
        for (int ks = 0; ks < KS; ++ks) {
            const bf16x8 a = *(const bf16x8*)(A + (mt * 16 + r) * lda + ks * 32 + q * 8);
            const bf16x8 b = *(const bf16x8*)(Bt + (nt * 16 + r) * ldb + ks * 32 + q * 8);
            const bf16x8 a2 = *(const bf16x8*)(A + (mt2 * 16 + r) * lda + ks * 32 + q * 8);
            const bf16x8 b2 = *(const bf16x8*)(Bt + (nt2 * 16 + r) * ldb + ks * 32 + q * 8);
            acc = MFMA16(a, b, acc);
            acc2 = MFMA16(a2, b2, acc2);
        }
#pragma unroll
        for (int jj = 0; jj < 4; ++jj) epi(mt * 16 + q * 4 + jj, nt * 16 + r, acc[jj]);
        if (two) {
#pragma unroll
            for (int jj = 0; jj < 4; ++jj) epi(mt2 * 16 + q * 4 + jj, nt2 * 16 + r, acc2[jj]);
        }
    }
}

template <int NPAR, class F>
DEVI void lds_mm4(const bf16_t* A, int lda, const bf16_t* Bt, int ldb, int MT, int NTl, int KS, F epi4) {
    const int tid = tidx(), lane = tid & 63, wid = tid >> 6, r = lane & 15, q = lane >> 4;
    f32x4 acc[NPAR];
    const bf16_t* ap[NPAR]; const bf16_t* bp[NPAR];
#pragma unroll
    for (int u = 0; u < NPAR; ++u) {
        const int t = wid + 8 * u, mt = t / NTl, nt = t % NTl;
        acc[u] = (f32x4){0.f, 0.f, 0.f, 0.f};
        ap[u] = A + (mt * 16 + r) * lda + q * 8; bp[u] = Bt + (nt * 16 + r) * ldb + q * 8;
    }
    for (int ks = 0; ks < KS; ++ks) {
        bf16x8 a[NPAR], b[NPAR];
#pragma unroll
        for (int u = 0; u < NPAR; ++u) { a[u] = *(const bf16x8*)(ap[u] + ks * 32); b[u] = *(const bf16x8*)(bp[u] + ks * 32); }
#pragma unroll
        for (int u = 0; u < NPAR; ++u) acc[u] = MFMA16(a[u], b[u], acc[u]);
    }
#pragma unroll
    for (int u = 0; u < NPAR; ++u) { const int t = wid + 8 * u, mt = t / NTl, nt = t % NTl; epi4(mt * 16 + q * 4, nt * 16 + r, acc[u]); }
}

DEVI void tri_inverse(const float* Mab, bf16_t* bT, int lane) {
    float Tc[64];
#pragma unroll
    for (int i = 0; i < 64; ++i) {
        float a0 = (lane == i) ? 1.f : 0.f, a1 = 0.f, a2 = 0.f, a3 = 0.f;
#pragma unroll
        for (int j4 = 0; j4 < (i + 3) / 4; ++j4) {
            const float4 m = *(const float4*)(Mab + i * 68 + j4 * 4);
            if (j4 * 4 + 0 < i) a0 += m.x * Tc[j4 * 4 + 0];
            if (j4 * 4 + 1 < i) a1 += m.y * Tc[j4 * 4 + 1];
            if (j4 * 4 + 2 < i) a2 += m.z * Tc[j4 * 4 + 2];
            if (j4 * 4 + 3 < i) a3 += m.w * Tc[j4 * 4 + 3];
        }
        Tc[i] = (a0 + a1) + (a2 + a3);
        bT[i * 72 + lane] = bfr(Tc[i]);
    }
}

DEVI void tri_inverse8(const float* Mab, bf16_t* bT) {
    const int tid = tidx(), lane = tid & 63, wid = tid >> 6, jl = lane & 7, col = wid * 8 + (lane >> 3);
    float s[8];
#pragma unroll
    for (int k = 0; k < 8; ++k) s[k] = 0.f;
    float mc[2][8][8];
#pragma unroll
    for (int r = 0; r < 8; ++r)
#pragma unroll
        for (int kk = 0; kk < 8; ++kk) mc[0][r][kk] = Mab[(kk * 8 + jl) * 68 + r];
#pragma unroll
    for (int b = 0; b < 8; ++b) {
        if (b + 1 < 8) {
#pragma unroll
            for (int r = 0; r < 8; ++r)
#pragma unroll
                for (int kk = b + 1; kk < 8; ++kk) mc[(b + 1) & 1][r][kk] = Mab[(kk * 8 + jl) * 68 + (b + 1) * 8 + r];
        }
#pragma unroll
        for (int r = 0; r < 8; ++r) {
            const int i = b * 8 + r;
            const float own = s[b] + (col == i ? 1.f : 0.f);
            const float q1 = (r & 3) == 0 ? dppf<0x00>(own) : ((r & 3) == 1 ? dppf<0x55>(own) : ((r & 3) == 2 ? dppf<0xAA>(own) : dppf<0xFF>(own)));
            const float q2 = dppf<0x141>(q1);
            const float Ti = ((jl >> 2) == (r >> 2)) ? q1 : q2;
            if (jl == r) bT[i * 72 + col] = bfr(Ti);
#pragma unroll
            for (int kk = b; kk < 8; ++kk) s[kk] += mc[b & 1][r][kk] * Ti;
        }
    }
}

template <int DK, int DV>
DEVI void prepass_core(const float* Mab, const bf16_t* bMak, const bf16_t* bMrk, bf16_t* bT, bf16_t* bYT, const bf16_t* bAST, const bf16_t* bVT,
                       bf16_t* gW, bf16_t* gUT, bf16_t* gO1, const float* rs) {
    lds_mm4<DV / 32>(bMak, 72, bVT, 72, 4, DV / 16, 2, [&](int i0, int dv, f32x4 y) { *(u32x2*)(bYT + dv * 72 + i0) = (u32x2){pk2(y[0], y[1]), pk2(y[2], y[3])}; });
    lds_mm4<DV / 32>(bVT, 72, bMrk, 72, DV / 16, 4, 2, [&](int dv0, int i, f32x4 o) { *(u32x2*)(gO1 + i * DV + dv0) = (u32x2){pk2(o[0], o[1]), pk2(o[2], o[3])}; });
    tri_inverse8(Mab, bT);
    __syncthreads();
    lds_mm4<DV / 32>(bT, 72, bYT, 72, 4, DV / 16, 2, [&](int i0, int dv, f32x4 u) {
        if (rs) { u[0] *= rs[i0]; u[1] *= rs[i0 + 1]; u[2] *= rs[i0 + 2]; u[3] *= rs[i0 + 3]; }
        *(u32x2*)(gUT + dv * 64 + i0) = (u32x2){pk2(u[0], u[1]), pk2(u[2], u[3])};
    });
    lds_mm4<DK / 32>(bAST, 72, bT, 72, DK / 16, 4, 2, [&](int dk0, int i, f32x4 w) {
        if (rs) w = w * rs[i];
        *(u32x2*)(gW + i * DK + permpos(dk0)) = (u32x2){pk2(w[0], w[1]), pk2(w[2], w[3])};
    });
}

constexpr int PP_F = 0;
constexpr int PP_BK = 35840;
constexpr int PP_BQ = PP_BK + 17408;
constexpr int PP_AST = PP_BQ + 17408;
constexpr int PP_VT = PP_AST + 18432;
constexpr int PP_MAK = PP_VT + 18432;
constexpr int PP_MRK = PP_MAK + 9216;
constexpr int PP_T = PP_MRK + 9216;
constexpr int PP_SC = PP_T + 9216;
constexpr int PP_BYTES = PP_SC + 4096;

DEVI void prepass_dn(KP p, int l, int s, int h, int c, unsigned char* smem) {
    const int tid = tidx(), lane = tid & 63, wid = tid >> 6;
    float* F = (float*)(smem + PP_F);
    float* Mab = (float*)(smem + PP_F);
    bf16_t* bYT = (bf16_t*)(smem + PP_F + 17408);
    bf16_t* bK = (bf16_t*)(smem + PP_BK); bf16_t* bQ = (bf16_t*)(smem + PP_BQ);
    bf16_t* bAST = (bf16_t*)(smem + PP_AST); bf16_t* bVT = (bf16_t*)(smem + PP_VT);
    bf16_t* bMak = (bf16_t*)(smem + PP_MAK); bf16_t* bMrk = (bf16_t*)(smem + PP_MRK); bf16_t* bT = (bf16_t*)(smem + PP_T);
    float* Lam = (float*)(smem + PP_SC); float* Lm1 = Lam + 64; float* bb = Lam + 128; float* aa = Lam + 192;
    const int item = (s * 4 + h) * 32 + c;
    const int rowbase = s * 2048 + c * 64;
    bf16_t* gW = p->dnW + (size_t)item * 8192; bf16_t* gR = p->dnR + (size_t)item * 8192; bf16_t* gKT = p->dnKT + (size_t)item * 8192;
    bf16_t* gM = p->dnM + (size_t)item * 4096; bf16_t* gUT = p->dnUT + (size_t)item * 8192; bf16_t* gO1 = p->dnO1 + (size_t)item * 8192;
    bf16_t* gVT = p->dnVT + (size_t)item * 8192;
    if (wid == 0) {
        const int row = rowbase + lane;
        const float braw = bf2f(p->proj[(size_t)row * LDP + C_DNB + h]), araw = bf2f(p->proj[(size_t)row * LDP + C_DNA + h]);
        const float g = -fexp(p->a_log[l * 4 + h]) * softplusf(araw + p->dt_bias[l * 4 + h]);
        float L = g;
#pragma unroll
        for (int o = 1; o < 64; o <<= 1) { const float t = __shfl_up(L, o); if (lane >= o) L += t; }
        Lam[lane] = L; Lm1[lane] = L - g; bb[lane] = sigmf(braw); aa[lane] = fexp(g);
        p->dnav[(size_t)item * 64 + lane] = fexp(g);
        const float LC = __shfl(L, 63);
        p->dnpc[(size_t)item * 128 + lane] = fexp(LC); p->dnpc[(size_t)item * 128 + 64 + lane] = fexp(LC);
    }
    const int col = tid & 127, rg = tid >> 7;
    float raw[3][19];
    {
        const int t0 = c * 64 + rg * 16;
#pragma unroll
        for (int seg = 0; seg < 3; ++seg) {
            const bf16_t* pp = p->proj + (size_t)(s * 2048) * LDP + seg * 512 + h * 128 + col;
#pragma unroll
            for (int ii = 0; ii < 19; ++ii) {
                const int t = t0 - 3 + ii, tc = t < 0 ? 0 : t;
                const float v = bf2f(pp[(size_t)tc * LDP]);
                raw[seg][ii] = (ii < 3 && t < 0) ? 0.f : v;
            }
        }
    }
    auto conv_seg = [&](int seg, float (&outv)[16]) {
        const int pc = seg * 512 + h * 128 + col;
        const float cw0 = p->conv_w[(l * 4 + 0) * 1536 + pc], cw1 = p->conv_w[(l * 4 + 1) * 1536 + pc], cw2 = p->conv_w[(l * 4 + 2) * 1536 + pc], cw3 = p->conv_w[(l * 4 + 3) * 1536 + pc];
#pragma unroll
        for (int ii = 0; ii < 16; ++ii)
            outv[ii] = siluf(raw[seg][ii] * cw0 + raw[seg][ii + 1] * cw1 + raw[seg][ii + 2] * cw2 + raw[seg][ii + 3] * cw3);
    };
    float cv[16];
    conv_seg(1, cv);
#pragma unroll
    for (int ii = 0; ii < 16; ++ii) F[(rg * 16 + ii) * 129 + col] = cv[ii];
    __syncthreads();
    {
        const float LC = Lam[63];
        const int i0 = wid * 8;
        float kt0[8], kt1[8];
#pragma unroll
        for (int r = 0; r < 8; ++r) {
            const int i = i0 + r;
            const float v0 = F[i * 129 + lane], v1 = F[i * 129 + 64 + lane];
            const float rn = rsqrtf(wsum(v0 * v0 + v1 * v1) + 1e-6f);
            const float k0 = v0 * rn, k1 = v1 * rn;
            const float e1 = fexp(Lm1[i]), e2 = bb[i] * fexp(LC - Lam[i]);
            bK[i * 136 + lane] = bfr(k0); bK[i * 136 + 64 + lane] = bfr(k1);
            bAST[lane * 72 + i] = bfr(k0 * e1); bAST[(64 + lane) * 72 + i] = bfr(k1 * e1);
            kt0[r] = k0 * e2; kt1[r] = k1 * e2;
        }
        const int pb = (i0 & 32) + ((i0 & 8) << 1) + ((i0 & 16) >> 2);
        *(u32x2*)(gKT + lane * 64 + pb) = (u32x2){pk2(kt0[0], kt0[1]), pk2(kt0[2], kt0[3])}; *(u32x2*)(gKT + lane * 64 + pb + 8) = (u32x2){pk2(kt0[4], kt0[5]), pk2(kt0[6], kt0[7])};
        *(u32x2*)(gKT + (64 + lane) * 64 + pb) = (u32x2){pk2(kt1[0], kt1[1]), pk2(kt1[2], kt1[3])}; *(u32x2*)(gKT + (64 + lane) * 64 + pb + 8) = (u32x2){pk2(kt1[4], kt1[5]), pk2(kt1[6], kt1[7])};
    }
    __syncthreads();
    conv_seg(0, cv);
#pragma unroll
    for (int ii = 0; ii < 16; ++ii) F[(rg * 16 + ii) * 129 + col] = cv[ii];
    __syncthreads();
    for (int i = wid * 8; i < wid * 8 + 8; ++i) {
        const float v0 = F[i * 129 + lane], v1 = F[i * 129 + 64 + lane];
        const float rn = rsqrtf(wsum(v0 * v0 + v1 * v1) + 1e-6f) * 0.08838834764831845f;
        const float q0 = v0 * rn, q1 = v1 * rn, e = fexp(Lam[i]);
        bQ[i * 136 + lane] = bfr(q0); bQ[i * 136 + 64 + lane] = bfr(q1);
        gR[i * 128 + permpos(lane)] = bfr(q0 * e); gR[i * 128 + permpos(64 + lane)] = bfr(q1 * e);
    }
    conv_seg(2, cv);
#pragma unroll
    for (int ii = 0; ii < 16; ++ii) bVT[col * 72 + rg * 16 + ii] = bfr(cv[ii]);
#pragma unroll
    for (int g = 0; g < 4; ++g)
        *(u32x2*)(gVT + col * 64 + (rg >> 1) * 32 + 8 * g + 4 * (rg & 1)) = (u32x2){pk2(cv[4 * g], cv[4 * g + 1]), pk2(cv[4 * g + 2], cv[4 * g + 3])};
    if (c == 31) {
        for (int idx = tid; idx < 3 * 384; idx += NT) {
            const int j = idx / 384, cc = idx % 384, pc = (cc >> 7) * 512 + h * 128 + (cc & 127);
            p->out[O_PCONV + (size_t)((l * 8 + s) * 3 + j) * 1536 + pc] = bf2f(p->proj[(size_t)(s * 2048 + 2045 + j) * LDP + pc]);
        }
    }
    __syncthreads();
    lds_mm(bK, 136, bK, 136, 4, 4, 4, [&](int i, int j, float g) {
        float mak = 0.f;
        if (i > j) mak = bb[j] * g * fexp(Lm1[i] - Lam[j]);
        Mab[i * 68 + j] = -aa[j] * mak; bMak[i * 72 + j] = bfr(mak);
    });
    lds_mm(bQ, 136, bK, 136, 4, 4, 4, [&](int i, int j, float g) {
        float mrk = 0.f;
        if (i >= j) mrk = bb[j] * g * fexp(Lam[i] - Lam[j]);
        bMrk[i * 72 + j] = bfr(mrk); gM[i * 64 + permpos(j)] = bfr(-mrk);
    });
    __syncthreads();
    prepass_core<128, 128>(Mab, bMak, bMrk, bT, bYT, bAST, bVT, gW, gUT, gO1, aa);
    __syncthreads();
}

DEVI void prepass_rw(KP p, int l, int s, int h, int c, unsigned char* smem) {
    const int tid = tidx(), lane = tid & 63, wid = tid >> 6;
    bf16_t* bTW = (bf16_t*)(smem + PP_F); bf16_t* bAL = bTW + 64 * 72;
    float* awL = (float*)(smem + PP_F + 18432); float* aaL = (float*)(smem + PP_BK);
    bf16_t* bW2T = (bf16_t*)(smem + PP_MAK); bf16_t* bA2T = (bf16_t*)(smem + PP_MRK);
    float* Mab = (float*)(smem + PP_F); bf16_t* bYT = (bf16_t*)(smem + PP_F + 17408);
    bf16_t* bAS = (bf16_t*)(smem + PP_BK); bf16_t* bRS = (bf16_t*)(smem + PP_BQ);
    bf16_t* bAST = (bf16_t*)(smem + PP_AST); bf16_t* bBH = (bf16_t*)(smem + PP_AST + 9216);
    bf16_t* bVT = (bf16_t*)(smem + PP_VT); bf16_t* bKH = (bf16_t*)(smem + PP_VT + 9216);
    bf16_t* bMak = (bf16_t*)(smem + PP_MAK); bf16_t* bMrk = (bf16_t*)(smem + PP_MRK); bf16_t* bT = (bf16_t*)(smem + PP_T);
    float* tot = (float*)(smem + PP_SC);
    const int item = (s * 8 + h) * 32 + c;
    const int rowbase = s * 2048 + c * 64;
    bf16_t* gW = p->rwW + (size_t)item * 4096; bf16_t* gR = p->rwR + (size_t)item * 4096; bf16_t* gKT = p->rwKT + (size_t)item * 4096;
    bf16_t* gBT = p->rwBT + (size_t)item * 4096; bf16_t* gM = p->rwM + (size_t)item * 4096; bf16_t* gUT = p->rwUT + (size_t)item * 4096;
    bf16_t* gO1 = p->rwO1 + (size_t)item * 4096; bf16_t* gVT = p->rwVT + (size_t)item * 4096;
    const int colA = tid & 127, g4 = tid >> 7, iA = g4 * 16;
    const int ch = lane, hc = h * 64 + ch, i0 = wid * 8;
    const bool firstA = (c * 64 + iA == 0), firstB = (c * 64 + i0 == 0);
    float rawA[17], rawR[9], rawK[9], rawV[9], w2r[8], a2r[8];
    {
        const bf16_t* ppA = p->proj + (size_t)rowbase * LDP + C_RX + 1536 + colA;
#pragma unroll
        for (int ii = 0; ii < 17; ++ii) { const int r = iA - 1 + ii; rawA[ii] = bf2f(ppA[(ptrdiff_t)((firstA && ii == 0) ? 0 : r) * LDP]); }
        const bf16_t* ppB = p->proj + (size_t)rowbase * LDP + C_RX + hc;
#pragma unroll
        for (int ii = 0; ii < 9; ++ii) {
            const bf16_t* q = ppB + (ptrdiff_t)((firstB && ii == 0) ? 0 : (i0 - 1 + ii)) * LDP;
            rawR[ii] = bf2f(q[0]); rawK[ii] = bf2f(q[512]); rawV[ii] = bf2f(q[1024]);
        }
#pragma unroll
        for (int jj = 0; jj < 8; ++jj) { const int j = wid * 8 + jj; w2r[jj] = p->rw_w2[((size_t)l * 64 + j) * 512 + hc]; a2r[jj] = p->rw_a2[((size_t)l * 64 + j) * 512 + hc]; }
    }
    const float muA = p->rw_mu[l * 1664 + 1536 + colA];
    const float mur = p->rw_mu[l * 1664 + hc], muk = p->rw_mu[l * 1664 + 512 + hc], muv = p->rw_mu[l * 1664 + 1024 + hc];
    if (firstA) rawA[0] = 0.f;
    if (firstB) { rawR[0] = 0.f; rawK[0] = 0.f; rawV[0] = 0.f; }
#pragma unroll
    for (int ii = 0; ii < 16; ++ii) {
        const float cur = rawA[ii + 1], xm = cur + (rawA[ii] - cur) * muA;
        if (colA < 64) bTW[(iA + ii) * 72 + colA] = bfr(ftanh(xm)); else bAL[(iA + ii) * 72 + colA - 64] = bfr(xm);
    }
#pragma unroll
    for (int jj = 0; jj < 8; ++jj) { const int j = wid * 8 + jj; bW2T[ch * 72 + j] = bfr(w2r[jj]); bA2T[ch * 72 + j] = bfr(a2r[jj]); }
    float xr[8], xk[8], xv[8];
#pragma unroll
    for (int r = 0; r < 8; ++r) {
        xr[r] = rawR[r + 1] + (rawR[r] - rawR[r + 1]) * mur; xk[r] = rawK[r + 1] + (rawK[r] - rawK[r + 1]) * muk; xv[r] = rawV[r + 1] + (rawV[r] - rawV[r + 1]) * muv;
    }
    __syncthreads();
    lds_mm(bTW, 72, bW2T, 72, 4, 4, 2, [&](int i, int c2, float v) { awL[i * 65 + c2] = v; });
    lds_mm(bAL, 72, bA2T, 72, 4, 4, 2, [&](int i, int c2, float v) { aaL[i * 65 + c2] = v; });
    __syncthreads();
    float aw[8], aa[8];
#pragma unroll
    for (int r = 0; r < 8; ++r) { aw[r] = awL[(i0 + r) * 65 + ch]; aa[r] = aaL[(i0 + r) * 65 + ch]; }
    const float w0 = p->rw_w0[l * 512 + hc], a0 = p->rw_a0[l * 512 + hc], kkc = p->rw_k_k[l * 512 + hc], kac = p->rw_k_a[l * 512 + hc], rkc = p->rw_r_k[l * 512 + hc];
    float lw[8], Ll[8], kkv[8], k2v[8], bv[8];
    float run = 0.f;
#pragma unroll
    for (int r = 0; r < 8; ++r) {
        const float wl = -softplusf(-(w0 + aw[r])) - 0.5f;
        lw[r] = -fexp(wl);
        run += lw[r]; Ll[r] = run;
        const float a = sigmf(a0 + aa[r]);
        const float kr = xk[r] * kkc;
        const float kk = kr * rsqrtf(wsum(kr * kr) + 1e-6f);
        const float k2 = xk[r] * (1.f + (a - 1.f) * kac);
        const float bon = wsum(xr[r] * k2 * rkc) * xv[r];
        p->rbonus[(size_t)(rowbase + i0 + r) * 512 + hc] = bon;
        kkv[r] = kk; k2v[r] = k2; bv[r] = -(kk * a);
    }
    tot[wid * 64 + ch] = run;
    __syncthreads();
    {
        float off = 0.f, LC = 0.f;
#pragma unroll
        for (int g = 0; g < 8; ++g) { const float t = tot[g * 64 + ch]; LC += t; if (g < wid) off += t; }
        if (wid == 0) p->rwpc[(size_t)item * 64 + ch] = expc(LC);
        float kt8[8], bt8[8];
#pragma unroll
        for (int r = 0; r < 8; ++r) {
            const int i = i0 + r;
            const float L = off + Ll[r], Lm = L - lw[r];
            const float AS = kkv[r] * expc(Lm), RS = xr[r] * expc(L), em = expc(-L), eC = expc(LC - L);
            bAS[i * 72 + ch] = bfr(AS); bRS[i * 72 + ch] = bfr(RS); bBH[i * 72 + ch] = bfr(bv[r] * em); bKH[i * 72 + ch] = bfr(k2v[r] * em);
            bAST[ch * 72 + i] = bfr(AS); bVT[ch * 72 + i] = bfr(xv[r]);
            gR[i * 64 + permpos(ch)] = bfr(RS);
            kt8[r] = k2v[r] * eC; bt8[r] = bv[r] * eC;
        }
        const int pb = ch * 64 + (i0 & 32) + ((i0 & 8) << 1) + ((i0 & 16) >> 2);
        *(u32x2*)(gKT + pb) = (u32x2){pk2(kt8[0], kt8[1]), pk2(kt8[2], kt8[3])}; *(u32x2*)(gKT + pb + 8) = (u32x2){pk2(kt8[4], kt8[5]), pk2(kt8[6], kt8[7])};
        *(u32x2*)(gBT + pb) = (u32x2){pk2(bt8[0], bt8[1]), pk2(bt8[2], bt8[3])}; *(u32x2*)(gBT + pb + 8) = (u32x2){pk2(bt8[4], bt8[5]), pk2(bt8[6], bt8[7])};
        *(u32x2*)(gVT + pb) = (u32x2){pk2(xv[0], xv[1]), pk2(xv[2], xv[3])}; *(u32x2*)(gVT + pb + 8) = (u32x2){pk2(xv[4], xv[5]), pk2(xv[6], xv[7])};
    }
    if (c == 31 && h == 0) {
        for (int idx = tid; idx < 1664; idx += NT)
            p->out[O_PRS + (size_t)(l * 8 + s) * 1664 + idx] = bf2f(p->proj[(size_t)(s * 2048 + 2047) * LDP + C_RX + idx]);
    }
    __syncthreads();
    lds_mm(bAS, 72, bBH, 72, 4, 4, 2, [&](int i, int j, float g) { Mab[i * 68 + j] = i > j ? g : 0.f; });
    lds_mm(bAS, 72, bKH, 72, 4, 4, 2, [&](int i, int j, float g) { bMak[i * 72 + j] = bfr(i > j ? g : 0.f); });
    lds_mm(bRS, 72, bBH, 72, 4, 4, 2, [&](int i, int j, float g) { gM[i * 64 + permpos(j)] = bfr(i >= j ? g : 0.f); });
    lds_mm(bRS, 72, bKH, 72, 4, 4, 2, [&](int i, int j, float g) { bMrk[i * 72 + j] = bfr(i >= j ? g : 0.f); });
    __syncthreads();
    prepass_core<64, 64>(Mab, bMak, bMrk, bT, bYT, bAST, bVT, gW, gUT, gO1, nullptr);
    __syncthreads();
}

DEVI void prepass_gla(KP p, int l, int s, int h, int c, unsigned char* smem) {
    const int tid = tidx(), lane = tid & 63, wid = tid >> 6;
    float* glo = (float*)(smem + PP_F);
    bf16_t* bRS = (bf16_t*)(smem + PP_BK); bf16_t* bKH = bRS + 64 * 72;
    bf16_t* bVT = (bf16_t*)(smem + PP_VT); bf16_t* bMrk = (bf16_t*)(smem + PP_MRK);
    float* tot = (float*)(smem + PP_SC);
    const int item = (s * 4 + h) * 32 + c;
    const int rowbase = s * 2048 + c * 64;
    bf16_t* gR = p->glR + (size_t)item * 4096; bf16_t* gKT = p->glKT + (size_t)item * 4096;
    bf16_t* gO1 = p->glO1 + (size_t)item * 8192; bf16_t* gVT = p->glVT + (size_t)item * 8192;
    const int ch = lane, hc = h * 64 + ch, i0 = wid * 8;
    const int dv = tid & 127, g4v = tid >> 7;
    float glo0, glo1; bf16_t vv[16]; float qv[8], kv[8], wf[16];
    {
        glo0 = bf2f(p->proj[(size_t)(rowbase + (tid >> 4)) * LDP + C_GLO + (tid & 15)]);
        glo1 = bf2f(p->proj[(size_t)(rowbase + 32 + (tid >> 4)) * LDP + C_GLO + (tid & 15)]);
        const bf16_t* pv = p->proj + (size_t)rowbase * LDP + C_GV + h * 128 + dv;
#pragma unroll
        for (int ii = 0; ii < 16; ++ii) vv[ii] = pv[(size_t)(g4v * 16 + ii) * LDP];
#pragma unroll
        for (int r = 0; r < 8; ++r) {
            const bf16_t* pp = p->proj + (size_t)(rowbase + i0 + r) * LDP;
            qv[r] = bf2f(pp[C_GQ + hc]) * 0.125f; kv[r] = bf2f(pp[C_GK + hc]);
        }
#pragma unroll
        for (int j = 0; j < 16; ++j) wf[j] = p->gla_wf[(l * 16 + j) * 256 + hc];
    }
    const float bfv = p->gla_bf[l * 256 + hc];
    glo[tid] = glo0; glo[512 + tid] = glo1;
#pragma unroll
    for (int ii = 0; ii < 16; ++ii) bVT[dv * 72 + g4v * 16 + ii] = vv[ii];
#pragma unroll
    for (int g = 0; g < 4; ++g)
        *(u32x2*)(gVT + dv * 64 + (g4v >> 1) * 32 + 8 * g + 4 * (g4v & 1)) = (u32x2){(unsigned)vv[4 * g] | ((unsigned)vv[4 * g + 1] << 16), (unsigned)vv[4 * g + 2] | ((unsigned)vv[4 * g + 3] << 16)};
    __syncthreads();
    float Ll[8];
    float run = 0.f;
#pragma unroll
    for (int r = 0; r < 8; ++r) {
        const int i = i0 + r;
        float z = bfv;
#pragma unroll
        for (int j4 = 0; j4 < 4; ++j4) {
            const float4 g4 = *(const float4*)(glo + i * 16 + j4 * 4);
            z += g4.x * wf[j4 * 4 + 0] + g4.y * wf[j4 * 4 + 1] + g4.z * wf[j4 * 4 + 2] + g4.w * wf[j4 * 4 + 3];
        }
        run += -softplusf(-z) * (1.f / 16.f); Ll[r] = run;
    }
    tot[wid * 64 + ch] = run;
    __syncthreads();
    {
        float off = 0.f, LC = 0.f;
#pragma unroll
        for (int g = 0; g < 8; ++g) { const float t = tot[g * 64 + ch]; LC += t; if (g < wid) off += t; }
        if (wid == 0) p->glpc[(size_t)item * 64 + ch] = expc(LC);
        float kt8[8];
#pragma unroll
        for (int r = 0; r < 8; ++r) {
            const int i = i0 + r;
            const float L = off + Ll[r];
            const float RS = qv[r] * expc(L);
            bRS[i * 72 + ch] = bfr(RS); bKH[i * 72 + ch] = bfr(kv[r] * expc(-L));
            gR[i * 64 + permpos(ch)] = bfr(RS); kt8[r] = kv[r] * expc(LC - L);
        }
        const int pb = ch * 64 + (i0 & 32) + ((i0 & 8) << 1) + ((i0 & 16) >> 2);
        *(u32x2*)(gKT + pb) = (u32x2){pk2(kt8[0], kt8[1]), pk2(kt8[2], kt8[3])}; *(u32x2*)(gKT + pb + 8) = (u32x2){pk2(kt8[4], kt8[5]), pk2(kt8[6], kt8[7])};
    }
    __syncthreads();
    lds_mm(bRS, 72, bKH, 72, 4, 4, 2, [&](int i, int j, float g) { bMrk[i * 72 + j] = bfr(i >= j ? g : 0.f); });
    __syncthreads();
    lds_mm(bMrk, 72, bVT, 72, 4, 8, 2, [&](int i, int dv, float o) { gO1[i * 128 + dv] = bfr(o); });
    __syncthreads();
}

DEVI void phase_prepass(KP p_, int l, unsigned char* smem) {
    KP p = launder(p_);
    for (int it = bidx(); it < 4096; it += gdim()) {
#ifdef NO_PRE
        continue;
#endif
        if (it < 2048) prepass_rw(p, l, it >> 8, (it >> 5) & 7, it & 31, smem);
        else if (it < 3072) { const int i = it - 2048; prepass_dn(p, l, i >> 7, (i >> 5) & 3, i & 31, smem); }
        else { const int i = it - 3072; prepass_gla(p, l, i >> 7, (i >> 5) & 3, i & 31, smem); }
    }
}

DEVI f32x4 unpack4(u32x2 u) { return (f32x4){__uint_as_float(u.x << 16), __uint_as_float(u.x & 0xffff0000u), __uint_as_float(u.y << 16), __uint_as_float(u.y & 0xffff0000u)}; }
DEVI bf16x8 pack8(f32x4 a, f32x4 b) { u32x4 r = {pk2(a[0], a[1]), pk2(a[2], a[3]), pk2(b[0], b[1]), pk2(b[2], b[3])}; return __builtin_bit_cast(bf16x8, r); }

template <int TYPE> struct SeqCfg {
    static constexpr int DK = TYPE == 0 ? 128 : 64, DV = TYPE == 2 ? 64 : 128, NDT = DK / 16, NKS = DK / 32, H = TYPE == 2 ? 8 : 4, NSL = DV / 16;
    static constexpr int NCP = TYPE == 0 ? 7 : (TYPE == 1 ? 2 : 5);
    static constexpr int SW = TYPE == 0 ? 272 : 144;
    static constexpr int OFF_W = 0, OFF_R = TYPE == 0 ? 17408 : (TYPE == 1 ? 0 : 9216), OFF_KT = TYPE == 0 ? 34816 : (TYPE == 1 ? 9216 : 18432);
    static constexpr int OFF_BT = 27648, OFF_M = TYPE == 0 ? 53248 : 36864;
    static constexpr int BUFB = TYPE == 0 ? 62464 : (TYPE == 1 ? 18432 : 46080);
};

template <int TYPE>
DEVI void chunk_seq_block(KP p, int l, int s, int h, int part, unsigned char* smem) {
    typedef SeqCfg<TYPE> C;
    constexpr int DK = C::DK, DV = C::DV, NDT = C::NDT, NKS = C::NKS, H = C::H, NSL = C::NSL, NCP = C::NCP, SW = C::SW;
    const int tid = tidx(), lane = tid & 63, wid = tid >> 6, q = lane >> 4, c = lane & 15;
    const int slice = TYPE == 0 ? part * 4 + wid : wid;
    const bool active = TYPE == 0 ? wid < 4 : wid < NSL;
    const bf16_t* cbase[NCP]; int cstride[NCP]; int soff[NCP], doff[NCP];
    if (TYPE == 0) {
#pragma unroll
        for (int i = 0; i < NCP; ++i) {
            if (i < 4) { const int j = tid + (i & 1) * 512, row = j >> 4, cc = j & 15; cbase[i] = i < 2 ? p->dnW : p->dnR; cstride[i] = 8192; soff[i] = row * 128 + cc * 8; doff[i] = (i < 2 ? C::OFF_W : C::OFF_R) + row * 272 + cc * 16; }
            else if (i < 6) { const int j = tid + (i & 1) * 512, row = j >> 3, cc = j & 7; cbase[i] = p->dnKT; cstride[i] = 8192; soff[i] = row * 64 + cc * 8; doff[i] = C::OFF_KT + row * 144 + cc * 16; }
            else { const int row = tid >> 3, cc = tid & 7; cbase[i] = p->dnM; cstride[i] = 4096; soff[i] = row * 64 + cc * 8; doff[i] = C::OFF_M + row * 144 + cc * 16; }
        }
    } else {
#pragma unroll
        for (int i = 0; i < NCP; ++i) {
            const int row = tid >> 3, cc = tid & 7;
            if (TYPE == 1) cbase[i] = i == 0 ? p->glR : p->glKT;
            else cbase[i] = i == 0 ? p->rwW : (i == 1 ? p->rwR : (i == 2 ? p->rwKT : (i == 3 ? p->rwBT : p->rwM)));
            cstride[i] = 4096; soff[i] = row * 64 + cc * 8; doff[i] = i * 9216 + row * 144 + cc * 16;
        }
    }
    const bf16_t* bUT = TYPE == 0 ? p->dnUT : p->rwUT;
    const bf16_t* bO1 = TYPE == 0 ? p->dnO1 : (TYPE == 1 ? p->glO1 : p->rwO1);
    const bf16_t* bVT = TYPE == 0 ? p->dnVT : (TYPE == 1 ? p->glVT : p->rwVT);
    const float* bpc = TYPE == 0 ? p->dnpc : (TYPE == 1 ? p->glpc : p->rwpc);
    const float* bav = p->dnav;
    float* oraw = p->oraw;
    const int ocol = (TYPE == 0 ? 0 : (TYPE == 1 ? 512 : 1024)) + h * DV + slice * 16 + 4 * q;
    const size_t item0 = (size_t)(s * H + h) * 32;
    u32x4 cr[NCP];
    u32x2 ut[4], o1[4], vtd[4]; u32x4 vtb[2]; f32x4 pcv[4]; float pcs = 1.f; f32x4 avv[4];
    auto load_priv_a = [&](size_t item) {
        if (!active) return;
        if (TYPE != 1) {
#pragma unroll
            for (int mt = 0; mt < 4; ++mt) ut[mt] = *(const u32x2*)(bUT + item * (64 * DV) + (slice * 16 + c) * 64 + mt * 16 + 4 * q);
        }
#pragma unroll
        for (int mt = 0; mt < 4; ++mt) o1[mt] = *(const u32x2*)(bO1 + item * (64 * DV) + (mt * 16 + c) * DV + slice * 16 + 4 * q);
    };
    auto load_priv_b = [&](size_t item) {
        if (!active) return;
        if (TYPE == 0) {
#pragma unroll
            for (int mt = 0; mt < 4; ++mt) {
                vtd[mt] = *(const u32x2*)(bVT + item * (64 * DV) + (slice * 16 + c) * 64 + (mt >> 1) * 32 + 8 * q + (mt & 1) * 4);
            }
        } else {
            vtb[0] = *(const u32x4*)(bVT + item * (64 * DV) + (slice * 16 + c) * 64 + 8 * q);
            vtb[1] = *(const u32x4*)(bVT + item * (64 * DV) + (slice * 16 + c) * 64 + 32 + 8 * q);
        }
        if (TYPE == 0) pcs = bpc[item * DK];
        else {
#pragma unroll
            for (int dt = 0; dt < 4; ++dt) pcv[dt] = *(const f32x4*)(bpc + item * DK + dt * 16 + 4 * q);
        }
    };
    f32x4 S[NDT];
#pragma unroll
    for (int dt = 0; dt < NDT; ++dt) S[dt] = (f32x4){0.f, 0.f, 0.f, 0.f};
#pragma unroll
    for (int i = 0; i < NCP; ++i) cr[i] = *(const u32x4*)(cbase[i] + item0 * cstride[i] + soff[i]);
#pragma unroll
    for (int i = 0; i < NCP; ++i) *(u32x4*)(smem + doff[i]) = cr[i];
    load_priv_a(item0); load_priv_b(item0);
    __syncthreads();
    for (int ch = 0; ch < 32; ++ch) {
        const unsigned char* lb = smem + (ch & 1) * C::BUFB;
        if (ch + 1 < 32) {
#pragma unroll
            for (int i = 0; i < NCP; ++i) cr[i] = *(const u32x4*)(cbase[i] + (item0 + ch + 1) * cstride[i] + soff[i]);
        }
        if (active) {
            bf16x8 Sb[NKS];
#pragma unroll
            for (int ks = 0; ks < NKS; ++ks) Sb[ks] = pack8(S[2 * ks], S[2 * ks + 1]);
            f32x4 X[4]; bf16x8 Xb[2];
            if (TYPE != 1) {
#pragma unroll
                for (int mt = 0; mt < 4; ++mt) X[mt] = (f32x4){0.f, 0.f, 0.f, 0.f};
#pragma unroll
                for (int ks = 0; ks < NKS; ++ks) {
                    bf16x8 fr[4];
#pragma unroll
                    for (int mt = 0; mt < 4; ++mt) fr[mt] = *(const bf16x8*)(lb + C::OFF_W + (mt * 16 + c) * SW + ks * 64 + 16 * q);
#pragma unroll
                    for (int mt = 0; mt < 4; ++mt) X[mt] = MFMA16(fr[mt], Sb[ks], X[mt]);
                }
#pragma unroll
                for (int mt = 0; mt < 4; ++mt) X[mt] = X[mt] + unpack4(ut[mt]);
                Xb[0] = pack8(X[0], X[1]); Xb[1] = pack8(X[2], X[3]);
            }
            {
                f32x4 O[4];
#pragma unroll
                for (int mt = 0; mt < 4; ++mt) O[mt] = (f32x4){0.f, 0.f, 0.f, 0.f};
#pragma unroll
                for (int ks = 0; ks < NKS; ++ks) {
                    bf16x8 fr[4];
#pragma unroll
                    for (int mt = 0; mt < 4; ++mt) fr[mt] = *(const bf16x8*)(lb + C::OFF_R + (mt * 16 + c) * SW + ks * 64 + 16 * q);
#pragma unroll
                    for (int mt = 0; mt < 4; ++mt) O[mt] = MFMA16(Sb[ks], fr[mt], O[mt]);
                }
                if (TYPE != 1) {
#pragma unroll
                    for (int k2 = 0; k2 < 2; ++k2) {
                        bf16x8 fr[4];
#pragma unroll
                        for (int mt = 0; mt < 4; ++mt) fr[mt] = *(const bf16x8*)(lb + C::OFF_M + (mt * 16 + c) * 144 + k2 * 64 + 16 * q);
#pragma unroll
                        for (int mt = 0; mt < 4; ++mt) O[mt] = MFMA16(Xb[k2], fr[mt], O[mt]);
                    }
                }
#pragma unroll
                for (int mt = 0; mt < 4; ++mt) {
                    O[mt] = O[mt] + unpack4(o1[mt]);
                    *(f32x4*)(oraw + (size_t)(s * 2048 + ch * 64 + mt * 16 + c) * 1536 + ocol) = O[mt];
                }
            }
            if (ch + 1 < 32) load_priv_a(item0 + ch + 1);
            bf16x8 Vb[2];
            if (TYPE == 0) {
                f32x4 Vn[4];
#pragma unroll
                for (int mt = 0; mt < 4; ++mt) Vn[mt] = unpack4(vtd[mt]) - X[mt];
                Vb[0] = pack8(Vn[0], Vn[1]); Vb[1] = pack8(Vn[2], Vn[3]);
            } else {
                Vb[0] = __builtin_bit_cast(bf16x8, vtb[0]); Vb[1] = __builtin_bit_cast(bf16x8, vtb[1]);
            }
#pragma unroll
            for (int dt = 0; dt < NDT; ++dt) { if (TYPE == 0) S[dt] = S[dt] * pcs; else S[dt] = S[dt] * pcv[dt & 3]; }
#pragma unroll
            for (int k2 = 0; k2 < 2; ++k2) {
#pragma unroll
                for (int d4 = 0; d4 < NDT; d4 += 4) {
                    bf16x8 fr[4];
#pragma unroll
                    for (int j = 0; j < 4; ++j) fr[j] = *(const bf16x8*)(lb + C::OFF_KT + ((d4 + j) * 16 + c) * 144 + k2 * 64 + 16 * q);
#pragma unroll
                    for (int j = 0; j < 4; ++j) S[d4 + j] = MFMA16(fr[j], Vb[k2], S[d4 + j]);
                    if (TYPE == 2) {
#pragma unroll
                        for (int j = 0; j < 4; ++j) fr[j] = *(const bf16x8*)(lb + C::OFF_BT + ((d4 + j) * 16 + c) * 144 + k2 * 64 + 16 * q);
#pragma unroll
                        for (int j = 0; j < 4; ++j) S[d4 + j] = MFMA16(fr[j], Xb[k2], S[d4 + j]);
                    }
                }
            }
            if (ch + 1 < 32) load_priv_b(item0 + ch + 1);
        }
        if (ch + 1 < 32) {
            unsigned char* nb = smem + ((ch + 1) & 1) * C::BUFB;
#pragma unroll
            for (int i = 0; i < NCP; ++i) *(u32x4*)(nb + doff[i]) = cr[i];
        }
        __syncthreads();
    }
    if (!active) return;
    if (TYPE == 2) {
        float* So = p->out + O_PRW + (size_t)((l * 8 + s) * 8 + h) * 4096;
#pragma unroll
        for (int dt = 0; dt < NDT; ++dt) *(f32x4*)(So + (slice * 16 + c) * 64 + dt * 16 + 4 * q) = S[dt];
    } else {
        float* So = p->out + (TYPE == 0 ? O_PDN + (size_t)((l * 8 + s) * 4 + h) * 16384 : O_PGLA + (size_t)((l * 8 + s) * 4 + h) * 8192);
#pragma unroll
        for (int dt = 0; dt < NDT; ++dt)
#pragma unroll
            for (int jj = 0; jj < 4; ++jj) So[(dt * 16 + 4 * q + jj) * 128 + slice * 16 + c] = S[dt][jj];
    }
}

DEVI void phase_scan(KP p_, int l, unsigned char* smem) {
    KP p = launder(p_);
    const int wid = tidx() >> 6, bid = bidx();
    if (bid < 160) {
        if (bid < 64) chunk_seq_block<0>(p, l, bid >> 3, (bid >> 1) & 3, bid & 1, smem);
        else if (bid < 96) chunk_seq_block<1>(p, l, (bid - 64) >> 2, bid & 3, 0, smem);
        else chunk_seq_block<2>(p, l, (bid - 96) >> 3, bid & 7, 0, smem);
    } else {
        float* wl = (float*)smem + wid * 512;
        for (int it = (bid - 160) * 8 + wid; it < 6144; it += (gdim() - 160) * 8) {
            if (it < 2048) dn_scan_item(p, l, 8 + (it >> 4), (it >> 2) & 3, it & 3, wl);
            else if (it < 4096) { const int i = it - 2048; gla_scan_item(p, l, 8 + (i >> 4), (i >> 2) & 3, i & 3, wl); }
            else { const int i = it - 4096; rw_scan_item(p, l, 8 + (i >> 4), (i >> 1) & 7, i & 1, wl); }
        }
    }
}

struct PostRow { f32x2 odn[4], ogl[4]; unsigned zdn[4], zgl[4]; float orw[8], bon[8]; unsigned zrw[8]; };
DEVI void post_load(KP p, int row, int lane, PostRow& R) {
    const float* orow = p->oraw + (size_t)row * 1536;
    const bf16_t* pr = p->proj + (size_t)row * LDP;
#pragma unroll
    for (int h = 0; h < 4; ++h) {
        R.odn[h] = *(const f32x2*)(orow + h * 128 + lane * 2); R.ogl[h] = *(const f32x2*)(orow + 512 + h * 128 + lane * 2);
        R.zdn[h] = *(const unsigned*)(pr + C_DNZ + h * 128 + lane * 2); R.zgl[h] = *(const unsigned*)(pr + C_GZ + h * 128 + lane * 2);
    }
#pragma unroll
    for (int h = 0; h < 8; ++h) { const int c = h * 64 + lane; R.orw[h] = orow[1024 + c]; R.bon[h] = p->rbonus[(size_t)row * 512 + c]; R.zrw[h] = pr[C_RZ + c]; }
}
DEVI void post_compute(KP p, int row, int lane, const PostRow& R, f32x2 gdn, f32x2 ggl, const float (&lnw)[8], const float (&lnb)[8]) {
    bf16_t* ob = p->obf + (size_t)row * 1536;
#pragma unroll
    for (int h = 0; h < 4; ++h) {
        {
            const f32x2 o = R.odn[h];
            const float rs = rsqrtf(wsum(o[0] * o[0] + o[1] * o[1]) * (1.f / 128.f) + 1e-6f);
            const float z0 = __uint_as_float(R.zdn[h] << 16), z1 = __uint_as_float(R.zdn[h] & 0xffff0000u);
            ushort2 w; w.x = f2bf(o[0] * rs * gdn[0] * siluf(z0)); w.y = f2bf(o[1] * rs * gdn[1] * siluf(z1));
            *(ushort2*)(ob + h * 128 + lane * 2) = w;
        }
        {
            const f32x2 o = R.ogl[h];
            const float rs = rsqrtf(wsum(o[0] * o[0] + o[1] * o[1]) * (1.f / 128.f) + 1e-6f);
            const float z0 = __uint_as_float(R.zgl[h] << 16), z1 = __uint_as_float(R.zgl[h] & 0xffff0000u);
            ushort2 w; w.x = f2bf(o[0] * rs * ggl[0] * siluf(z0)); w.y = f2bf(o[1] * rs * ggl[1] * siluf(z1));
            *(ushort2*)(ob + 512 + h * 128 + lane * 2) = w;
        }
    }
#pragma unroll
    for (int h = 0; h < 8; ++h) {
        const int c = h * 64 + lane;
        const float o = R.orw[h];
        const float mu = wsum(o) * (1.f / 64.f);
        const float d = o - mu;
        const float var = wsum(d * d) * (1.f / 64.f);
        float y = d * rsqrtf(var + 64e-5f) * lnw[h] + lnb[h];
        y += R.bon[h];
        y *= siluf(__uint_as_float(R.zrw[h] << 16));
        ob[1024 + c] = f2bf(y);
    }
}
DEVI void phase_post(KP p_, int l) {
    KP p = launder(p_);
    const int lane = tidx() & 63, wid = tidx() >> 6;
    const f32x2 gdn = *(const f32x2*)(p->dn_norm_g + l * 128 + lane * 2), ggl = *(const f32x2*)(p->gla_norm_g + l * 128 + lane * 2);
    float lnw[8], lnb[8];
#pragma unroll
    for (int h = 0; h < 8; ++h) { lnw[h] = p->rw_ln_w[l * 512 + h * 64 + lane]; lnb[h] = p->rw_ln_b[l * 512 + h * 64 + lane]; }
    const int stride = gdim() * 8;
    int row = bidx() * 8 + wid;
    PostRow A, B, C;
    post_load(p, row < NR ? row : NR - 1, lane, A);
    post_load(p, row + stride < NR ? row + stride : NR - 1, lane, B);
    while (row < NR) {
        const int r1 = row + stride, r2 = r1 + stride, r3 = r2 + stride, r4 = r3 + stride;
        post_load(p, r2 < NR ? r2 : NR - 1, lane, C);
        post_compute(p, row, lane, A, gdn, ggl, lnw, lnb);
        if (r1 >= NR) break;
        post_load(p, r3 < NR ? r3 : NR - 1, lane, A);
        post_compute(p, r1, lane, B, gdn, ggl, lnw, lnb);
        if (r2 >= NR) break;
        post_load(p, r4 < NR ? r4 : NR - 1, lane, B);
        post_compute(p, r2, lane, C, gdn, ggl, lnw, lnb);
        row = r3;
    }
}

DEVI void phase_final(KP p_) {
    KP p = launder(p_);
    const int lane = tidx() & 63, wid = tidx() >> 6;
    for (int row = bidx() * 8 + wid; row < NR; row += gdim() * 8) {
        const float4* xr = (const float4*)(p->x + (size_t)row * 1024);
        float4 v[4], g[4]; float ss = 0.f;
#pragma unroll
        for (int i = 0; i < 4; ++i) { v[i] = xr[lane + i * 64]; g[i] = ((const float4*)p->final_g)[lane + i * 64]; }
#pragma unroll
        for (int i = 0; i < 4; ++i) ss += v[i].x * v[i].x + v[i].y * v[i].y + v[i].z * v[i].z + v[i].w * v[i].w;
        ss = wsum(ss);
        const float rstd = rsqrtf(ss * (1.f / 1024.f) + 1e-6f);
        float4* yo = (float4*)(p->out + (size_t)row * 1024);
#pragma unroll
        for (int i = 0; i < 4; ++i)
            yo[lane + i * 64] = make_float4(v[i].x * rstd * g[i].x, v[i].y * rstd * g[i].y, v[i].z * rstd * g[i].z, v[i].w * rstd * g[i].w);
    }
}

constexpr int SMEM_BYTES = PP_BYTES;
#define XB_TMO      128
#define XB_XCNT(j)  (256  + 64 * (j))
#define XB_XSUB(j)  (1280 + 64 * (j))
#define XB_XGEN(j)  (2304 + 64 * (j))
#define XB_TOP      3328
#define XB_TOPGEN   3392
#define XCD_BAR_WORDS 3456
#define XB_SPIN_CAP (1u << 18)
#ifndef LAS
#define LAS __attribute__((address_space(3)))
#endif

__device__ __forceinline__ unsigned xb_ld(unsigned* p)              { return __hip_atomic_load(p, __ATOMIC_RELAXED, __HIP_MEMORY_SCOPE_AGENT); }
__device__ __forceinline__ unsigned xb_add(unsigned* p, unsigned v) { return __hip_atomic_fetch_add(p, v, __ATOMIC_RELAXED, __HIP_MEMORY_SCOPE_AGENT); }
__device__ __forceinline__ unsigned xb_xcc_id() { return (unsigned)__builtin_amdgcn_s_getreg((3 << 11) | 20) & 0xFu; }
#define XB_SPIN(cond, bar) do { unsigned _sp = 0; while (cond) { __builtin_amdgcn_s_sleep(1); \
    if ((++_sp & 255u) == 0u) { if (xb_ld(&(bar)[XB_TMO])) break; if (_sp > XB_SPIN_CAP) { atomicAdd(&(bar)[XB_TMO], 1u); break; } } } } while (0)

struct XcdBarrier {
    unsigned* bar; unsigned x;
    volatile LAS unsigned* st;
};

__device__ __forceinline__ XcdBarrier xcd_barrier_post(unsigned* bar, volatile LAS unsigned* st) {
    XcdBarrier b; b.bar = bar; b.x = xb_xcc_id(); b.st = st;
    if (threadIdx.x == 0) (void)xb_add(&bar[XB_XCNT(b.x)], 1u);
    return b;
}
__device__ __forceinline__ void xcd_barrier_complete(unsigned* bar, unsigned x, unsigned& nloc, unsigned& nx) {
    const unsigned G = gridDim.x * gridDim.y * gridDim.z;
    unsigned sum, cnt, mine, sp = 0u;
    for (;;) {
        sum = 0u; cnt = 0u; mine = 0u;
#pragma unroll
        for (unsigned j = 0; j < 16; ++j) { const unsigned c = xb_ld(&bar[XB_XCNT(j)]); sum += c; cnt += (c > 0u) ? 1u : 0u; mine = (j == x) ? c : mine; }
        if (sum == G) break;
        __builtin_amdgcn_s_sleep(1);
        if ((++sp & 255u) == 0u) { if (xb_ld(&bar[XB_TMO])) break; if (sp > XB_SPIN_CAP) { atomicAdd(&bar[XB_TMO], 1u); break; } }
    }
    nloc = mine > 0u ? mine : 1u; nx = cnt > 0u ? cnt : 1u;
}

__device__ __forceinline__ void xcd_barrier(const XcdBarrier& b) {
    asm volatile("s_waitcnt vmcnt(0)" ::: "memory");
    __syncthreads();
    if (threadIdx.x == 0) {
        unsigned* bar = b.bar;
        __builtin_amdgcn_s_waitcnt(0);
        unsigned nloc = b.st[0], nx = b.st[1];
        if (nloc == 0u) { xcd_barrier_complete(bar, b.x, nloc, nx); b.st[0] = nloc; b.st[1] = nx; }
        const unsigned old = xb_add(&bar[XB_XSUB(b.x)], 1u);
        const unsigned gen = old / nloc;
        if (old + 1u == (gen + 1u) * nloc) {
            __builtin_amdgcn_fence(__ATOMIC_RELEASE, "agent");
            asm volatile("s_waitcnt vmcnt(0)" ::: "memory");
            const unsigned og = xb_add(&bar[XB_TOP], 1u);
            const unsigned tg = og / nx;
            if (og + 1u == (tg + 1u) * nx) xb_add(&bar[XB_TOPGEN], 1u);
            else XB_SPIN(xb_ld(&bar[XB_TOPGEN]) == tg, bar);
            __builtin_amdgcn_fence(__ATOMIC_ACQUIRE, "agent");
            xb_add(&bar[XB_XGEN(b.x)], 1u);
            asm volatile("s_waitcnt vmcnt(0)" ::: "memory");
        } else {
            XB_SPIN(xb_ld(&bar[XB_XGEN(b.x)]) == gen, bar);
            __builtin_amdgcn_fence(__ATOMIC_ACQUIRE, "agent");
            asm volatile("s_waitcnt vmcnt(0)" ::: "memory");
        }
    }
    __syncthreads();
}


DEVI void run_sub(KP p, int l, int sub, unsigned char* smem) {
    if (sub == 0) phase_norm(p, l);
    else if (sub == 1) {
        KP q = launder(p);
        {
            pg8::Gemm g{q->h, q->WinT + (size_t)l * LDP * 1024, NPR, LDP, 1024}; pg8::StaticOrder S; S.init(NPR, LDP, gdim(), bidx());
            EpiProjPG E{q->proj};
            pg8::gemm_phase<EpiProjPG, pg8::StaticOrder, false>((PG8_LAS unsigned char*)smem, g, S, E, nullptr);
        }
        __syncthreads();
        EpiProj e{q->proj}; gemm_phase(smem, q->h, 1024, q->WinT + (size_t)l * LDP * 1024, 1024, 1, LDP / G_BN, 1024, e, 192, 64);
    }
    else if (sub == 2) { phase_prepass(p, l, smem); phase_prep(p, l, smem); }
    else if (sub == 3) phase_scan(p, l, smem);
    else if (sub == 4) phase_post(p, l);
    else {
        KP q = launder(p);
        {
            pg8::Gemm g{q->obf, q->WoutT + (size_t)l * 1024 * 1536, NPR, 1024, 1536}; pg8::StaticOrder S; S.init(NPR, 1024, gdim(), bidx());
            EpiOutPG E{q->x, l == 0 ? q->x_prompt : q->x, q->mod + (size_t)l * NSEQ * 3072};
            pg8::gemm_phase<EpiOutPG, pg8::StaticOrder, false>((PG8_LAS unsigned char*)smem, g, S, E, nullptr);
        }
        out_gemm_sample(p, l);
    }
}
template <bool kCoop>
__global__ void __launch_bounds__(NT) fwd_kernel(Params p_arg) {
    KP p = (KP)__builtin_amdgcn_kernarg_segment_ptr();
    __shared__ __attribute__((aligned(16))) unsigned char smem[SMEM_BYTES];
    if (kCoop) {
        cg::grid_group grid = cg::this_grid();
        volatile LAS unsigned* xbst = (volatile LAS unsigned*)(LAS unsigned char*)(smem + SMEM_BYTES - 16);
        if (threadIdx.x < 4) xbst[threadIdx.x] = 0u;
        __syncthreads();
        const XcdBarrier xb = xcd_barrier_post(launder(p)->bar, xbst);
        phase_setup(p, smem);
        grid.sync();
#pragma unroll 1
        for (int l = 0; l < 2; ++l) {
            phase_norm(p, l); xcd_barrier(xb);
            for (int rep = 0; rep < REP_GEMM; ++rep) { run_sub(p, l, 1, smem); xcd_barrier(xb); }
            for (int rep = 0; rep < REP_PRE; ++rep) { phase_prepass(p, l, smem); phase_prep(p, l, smem); xcd_barrier(xb); }
            for (int rep = 0; rep < REP_SCAN; ++rep) { phase_scan(p, l, smem); xcd_barrier(xb); }
            phase_post(p, l); xcd_barrier(xb);
            run_sub(p, l, 5, smem); xcd_barrier(xb);
        }
        phase_final(p);
    } else {
        const int ph = launder(p)->p0;
        if (ph == 0) phase_setup(p, smem);
        else if (ph == 13) phase_final(p);
        else run_sub(p, (ph - 1) / 6, (ph - 1) % 6, smem);
    }
}

extern "C" void kernel_launch(void* const* d_in, const int* in_sizes, int n_in, void* d_out, int out_size, void* d_ws, size_t ws_size, hipStream_t stream) {
    Params hp{};
    const float** pf = (const float**)&hp;
    for (int i = 0; i < 32; ++i) pf[i] = (const float*)d_in[i];
    hp.out = (float*)d_out;
    char* w = (char*)d_ws;
    auto take = [&](size_t bytes) { char* r = w; w += (bytes + 255) & ~(size_t)255; return r; };
    hp.WinT = (bf16_t*)take((size_t)2 * LDP * 1024 * 2);
    hp.WoutT = (bf16_t*)take((size_t)2 * 1024 * 1536 * 2);
    hp.h = (bf16_t*)take((size_t)NRP * 1024 * 2);
    hp.proj = (bf16_t*)take((size_t)NRP * LDP * 2);
    hp.obf = (bf16_t*)take((size_t)NRP * 1536 * 2);
    hp.mod = (float*)take((size_t)2 * NSEQ * 3072 * 4);
    hp.x = (float*)d_out;
    const size_t soff = (size_t)NPR;
    hp.dnq = (float*)take((size_t)128 * 512 * 4) - soff * 512;
    hp.dnk = (float*)take((size_t)128 * 512 * 4) - soff * 512;
    hp.dnv = (float*)take((size_t)128 * 512 * 4) - soff * 512;
    hp.dnbeta = (float*)take((size_t)128 * 4 * 4) - soff * 4;
    hp.dna = (float*)take((size_t)128 * 4 * 4) - soff * 4;
    hp.glf = (float*)take((size_t)128 * 256 * 4) - soff * 256;
    hp.rr = (float*)take((size_t)128 * 512 * 4) - soff * 512;
    hp.rk = (float*)take((size_t)128 * 512 * 4) - soff * 512;
    hp.rv = (float*)take((size_t)128 * 512 * 4) - soff * 512;
    hp.rw = (float*)take((size_t)128 * 512 * 4) - soff * 512;
    hp.rkk = (float*)take((size_t)128 * 512 * 4) - soff * 512;
    hp.rb = (float*)take((size_t)128 * 512 * 4) - soff * 512;
    hp.rbonus = (float*)take((size_t)NR * 512 * 4);
    hp.oraw = (float*)take((size_t)NR * 1536 * 4);
    hp.dnW = (bf16_t*)take((size_t)1024 * 8192 * 2); hp.dnR = (bf16_t*)take((size_t)1024 * 8192 * 2); hp.dnKT = (bf16_t*)take((size_t)1024 * 8192 * 2);
    hp.dnM = (bf16_t*)take((size_t)1024 * 4096 * 2); hp.dnUT = (bf16_t*)take((size_t)1024 * 8192 * 2); hp.dnO1 = (bf16_t*)take((size_t)1024 * 8192 * 2);
    hp.dnVT = (bf16_t*)take((size_t)1024 * 8192 * 2);
    hp.rwW = (bf16_t*)take((size_t)2048 * 4096 * 2); hp.rwR = (bf16_t*)take((size_t)2048 * 4096 * 2); hp.rwKT = (bf16_t*)take((size_t)2048 * 4096 * 2);
    hp.rwBT = (bf16_t*)take((size_t)2048 * 4096 * 2); hp.rwM = (bf16_t*)take((size_t)2048 * 4096 * 2); hp.rwUT = (bf16_t*)take((size_t)2048 * 4096 * 2);
    hp.rwO1 = (bf16_t*)take((size_t)2048 * 4096 * 2); hp.rwVT = (bf16_t*)take((size_t)2048 * 4096 * 2);
    hp.glR = (bf16_t*)take((size_t)1024 * 4096 * 2); hp.glKT = (bf16_t*)take((size_t)1024 * 4096 * 2);
    hp.glO1 = (bf16_t*)take((size_t)1024 * 8192 * 2); hp.glVT = (bf16_t*)take((size_t)1024 * 8192 * 2);
    hp.dnpc = (float*)take((size_t)1024 * 128 * 4); hp.dnav = (float*)take((size_t)1024 * 64 * 4);
    hp.rwpc = (float*)take((size_t)2048 * 64 * 4); hp.glpc = (float*)take((size_t)1024 * 64 * 4);
    hp.bar = (unsigned*)take((size_t)XCD_BAR_WORDS * 4);
    if ((size_t)(w - (char*)d_ws) > ws_size) fprintf(stderr, "workspace too small: need %zu have %zu\n", (size_t)(w - (char*)d_ws), ws_size);
    static int grid_blocks = 0;
    if (!grid_blocks) {
        int dev = 0, cus = 0, per_cu = 0;
        hipGetDevice(&dev);
        hipDeviceGetAttribute(&cus, hipDeviceAttributeMultiprocessorCount, dev);
        hipOccupancyMaxActiveBlocksPerMultiprocessor(&per_cu, fwd_kernel<COOP != 0>, NT, 0);
        if (per_cu < 1) fprintf(stderr, "occupancy query returned %d\n", per_cu);
        grid_blocks = cus;
    }
#if COOP
    hp.p0 = 0; hp.p1 = 14;
    hipMemsetAsync(hp.bar, 0, (size_t)XCD_BAR_WORDS * 4, stream);
    void* args[] = {&hp};
    hipError_t e = hipLaunchCooperativeKernel((void*)fwd_kernel<true>, dim3(grid_blocks), dim3(NT), args, 0, stream);
    if (e != hipSuccess) fprintf(stderr, "cooperative launch failed: %s (grid %d)\n", hipGetErrorString(e), grid_blocks);
#else
    for (int ph = 0; ph < 14; ++ph) {
        hp.p0 = ph; hp.p1 = ph + 1;
        fwd_kernel<false><<<grid_blocks, NT, 0, stream>>>(hp);
    }
#endif
}
```

```cpp
#include <hip/hip_runtime.h>
#include <hip/hip_cooperative_groups.h>
#include <cstdio>
namespace cg = cooperative_groups;

#ifndef REP_PRE
#define REP_PRE 1
#endif
#ifndef REP_SCAN
#define REP_SCAN 1
#endif
#ifndef REP_GEMM
#define REP_GEMM 1
#endif
#ifndef COOP
#define COOP 1
#endif

#define DEVI __device__ __forceinline__
typedef unsigned short bf16_t;
typedef short bf16x8 __attribute__((ext_vector_type(8)));
typedef float f32x4 __attribute__((ext_vector_type(4)));

constexpr int NT = 512;
constexpr int DM = 1024;
constexpr int NPR = 16384;
constexpr int NR = 16512;
constexpr int NRP = 16640;
constexpr int LDP = 5888;
constexpr int DPROJ = 5784;
constexpr int NSEQ = 136;
constexpr int C_DNQ = 0, C_DNK = 512, C_DNV = 1024, C_DNZ = 1536, C_DNB = 2048, C_DNA = 2052;
constexpr int C_GQ = 2056, C_GK = 2312, C_GV = 2568, C_GZ = 3080, C_GLO = 3592;
constexpr int C_RX = 3608, C_RZ = 5272;
constexpr size_t O_YP = 0;
constexpr size_t O_YS = O_YP + (size_t)16384 * 1024;
constexpr size_t O_PCONV = O_YS + (size_t)128 * 1024;
constexpr size_t O_PDN = O_PCONV + (size_t)2 * 8 * 3 * 1536;
constexpr size_t O_PGLA = O_PDN + (size_t)2 * 8 * 4 * 128 * 128;
constexpr size_t O_PRS = O_PGLA + (size_t)2 * 8 * 4 * 64 * 128;
constexpr size_t O_PRW = O_PRS + (size_t)2 * 8 * 1664;
constexpr size_t O_SCONV = O_PRW + (size_t)2 * 8 * 8 * 64 * 64;
constexpr size_t O_SDN = O_SCONV + (size_t)2 * 128 * 3 * 1536;
constexpr size_t O_SGLA = O_SDN + (size_t)2 * 128 * 4 * 128 * 128;
constexpr size_t O_SRS = O_SGLA + (size_t)2 * 128 * 4 * 64 * 128;
constexpr size_t O_SRW = O_SRS + (size_t)2 * 128 * 1664;

struct Params {
    const float *x_prompt, *x_sample, *c_prompt, *c_sample, *st_conv, *st_dn, *st_gla, *st_rs, *st_rw;
    const float *norm_g, *ada_w, *ada_b, *w_in, *conv_w, *a_log, *dt_bias, *dn_norm_g, *gla_wf, *gla_bf, *gla_norm_g;
    const float *rw_mu, *rw_w0, *rw_w2, *rw_a0, *rw_a2, *rw_k_k, *rw_k_a, *rw_r_k, *rw_ln_w, *rw_ln_b, *w_out, *final_g;
    float* out;
    bf16_t *WinT, *WoutT, *h, *proj, *obf;
    float *mod, *x, *dnq, *dnk, *dnv, *dnbeta, *dna, *glf, *rr, *rk, *rv, *rw, *rkk, *rb, *rbonus, *oraw;
    bf16_t *dnW, *dnR, *dnKT, *dnM, *dnUT, *dnO1, *dnVT, *rwW, *rwR, *rwKT, *rwBT, *rwM, *rwUT, *rwO1, *rwVT, *glR, *glKT, *glO1, *glVT;
    float *dnpc, *dnav, *rwpc, *glpc;
    unsigned* bar;
    int p0, p1;
};

typedef const __attribute__((address_space(4))) Params* KP;
DEVI KP launder(KP q) { asm volatile("" : "+s"(q)); return q; }
DEVI int tidx() { int v = threadIdx.x; asm volatile("" : "+v"(v)); return v; }
DEVI int bidx() { int v = blockIdx.x; asm volatile("" : "+s"(v)); return v; }
DEVI int gdim() { int v = gridDim.x; asm volatile("" : "+s"(v)); return v; }
DEVI bf16_t f2bf(float f) { unsigned u = __float_as_uint(f); u += 0x7fffu + ((u >> 16) & 1u); return (bf16_t)(u >> 16); }
DEVI float bf2f(bf16_t b) { return __uint_as_float(((unsigned)b) << 16); }
template <int CTRL> DEVI float dppf(float v) { return __int_as_float(__builtin_amdgcn_update_dpp(0, __float_as_int(v), CTRL, 0xF, 0xF, true)); }
DEVI float rdlane(float v, int l) { return __int_as_float(__builtin_amdgcn_readlane(__float_as_int(v), l)); }
DEVI float wsum(float v) {
    v += dppf<0xB1>(v);
    v += dppf<0x4E>(v);
    v += dppf<0x141>(v);
    v += dppf<0x140>(v);
    return (rdlane(v, 0) + rdlane(v, 16)) + (rdlane(v, 32) + rdlane(v, 48));
}
DEVI float fexp(float x) { return __expf(x); }
DEVI float frcp(float x) { return __builtin_amdgcn_rcpf(x); }
DEVI float siluf(float x) { return x * frcp(1.f + fexp(-x)); }
DEVI float sigmf(float x) { return frcp(1.f + fexp(-x)); }
DEVI float softplusf(float x) { return x > 20.f ? x : __logf(1.f + fexp(x)); }
DEVI float ftanh(float x) { return 1.f - 2.f * frcp(1.f + fexp(2.f * x)); }
DEVI void wave_sync() {
    __builtin_amdgcn_fence(__ATOMIC_RELEASE, "wavefront");
    __builtin_amdgcn_wave_barrier();
    __builtin_amdgcn_fence(__ATOMIC_ACQUIRE, "wavefront");
}
DEVI int mod_row(int row) { return row < NPR ? (row >> 11) : (8 + row - NPR); }

typedef float f32x2 __attribute__((ext_vector_type(2)));
typedef __bf16 bf16x2_t __attribute__((ext_vector_type(2)));
typedef unsigned u32x2 __attribute__((ext_vector_type(2)));
typedef unsigned u32x4 __attribute__((ext_vector_type(4)));
DEVI unsigned pk2(float a, float b) { f32x2 v = {a, b}; bf16x2_t r = __builtin_convertvector(v, bf16x2_t); return __builtin_bit_cast(unsigned, r); }
#define MFMA16(a, b, c) __builtin_amdgcn_mfma_f32_16x16x32_bf16((a), (b), (c), 0, 0, 0)
DEVI void transpose_tile4(const float* src, bf16_t* dst, int K, int N, int k0, int n0, float* tl) {
    const int tid = tidx();
    float v[4][8];
#pragma unroll
    for (int t = 0; t < 4; ++t)
#pragma unroll
        for (int i = 0; i < 8; ++i) {
            const int kk = (tid >> 6) + i * 8, nn = n0 + t * 64 + (tid & 63);
            v[t][i] = nn < N ? src[(size_t)(k0 + kk) * N + nn] : 0.f;
        }
#pragma unroll
    for (int t = 0; t < 4; ++t)
#pragma unroll
        for (int i = 0; i < 8; ++i) tl[t * 4160 + ((tid >> 6) + i * 8) * 65 + (tid & 63)] = v[t][i];
    __syncthreads();
#pragma unroll
    for (int t = 0; t < 4; ++t)
#pragma unroll
        for (int i = 0; i < 4; ++i) {
            const int nn = (tid >> 5) + i * 16, kk = (tid & 31) * 2;
            *(unsigned*)(dst + (size_t)(n0 + t * 64 + nn) * K + k0 + kk) = pk2(tl[t * 4160 + kk * 65 + nn], tl[t * 4160 + (kk + 1) * 65 + nn]);
        }
    __syncthreads();
}

DEVI void phase_setup(KP p_, unsigned char* smem) {
    KP p = launder(p_);
    const int tid = tidx();
    float* tl = (float*)smem;
    for (int it = bidx(); it < 2 * 16 * 23; it += gdim()) {
        int l = it / (16 * 23), r = it % (16 * 23), kt = r / 23, ng = r % 23;
        transpose_tile4(p->w_in + (size_t)l * 1024 * DPROJ, p->WinT + (size_t)l * LDP * 1024, 1024, DPROJ, kt * 64, ng * 256, tl);
    }
    for (int it = bidx(); it < 2 * 24 * 4; it += gdim()) {
        int l = it / (24 * 4), r = it % (24 * 4), kt = r / 4, ng = r % 4;
        transpose_tile4(p->w_out + (size_t)l * 1536 * 1024, p->WoutT + (size_t)l * 1024 * 1536, 1536, 1024, kt * 64, ng * 256, tl);
    }
    {
        for (size_t i = (size_t)bidx() * NT + tid; i < (size_t)(NRP - NR) * 1024; i += (size_t)gdim() * NT) p->h[(size_t)NR * 1024 + i] = 0;
        for (size_t i = (size_t)bidx() * NT + tid; i < (size_t)(NRP - NR) * 1536; i += (size_t)gdim() * NT) p->obf[(size_t)NR * 1536 + i] = 0;
    }
    float* sc = (float*)smem;
    for (int it = bidx(); it < 2 * 6 * 17; it += gdim()) {
        int l = it / 102, r = it % 102, jt = r / 17, rg = r % 17;
        for (int idx = tid; idx < 8192; idx += NT) {
            int rr = idx >> 10, k = idx & 1023, mb = rg * 8 + rr;
            float c = mb < 8 ? p->c_prompt[mb * 1024 + k] : p->c_sample[(mb - 8) * 1024 + k];
            sc[k * 8 + rr] = siluf(c);
        }
        __syncthreads();
        const int col = jt * 512 + tid;
        f32x2 acc2[4];
#pragma unroll
        for (int i = 0; i < 4; ++i) acc2[i] = (f32x2){0.f, 0.f};
        const float* aw = p->ada_w + (size_t)l * 1024 * 3072 + col;
#pragma unroll 16
        for (int k = 0; k < 1024; ++k) {
            const float a = aw[(size_t)k * 3072];
            const f32x2 av = {a, a};
            const f32x4 s0 = ((const f32x4*)sc)[k * 2], s1 = ((const f32x4*)sc)[k * 2 + 1];
            acc2[0] = __builtin_elementwise_fma((f32x2){s0[0], s0[1]}, av, acc2[0]); acc2[1] = __builtin_elementwise_fma((f32x2){s0[2], s0[3]}, av, acc2[1]);
            acc2[2] = __builtin_elementwise_fma((f32x2){s1[0], s1[1]}, av, acc2[2]); acc2[3] = __builtin_elementwise_fma((f32x2){s1[2], s1[3]}, av, acc2[3]);
        }
        float bb = p->ada_b[l * 3072 + col];
#pragma unroll
        for (int i = 0; i < 8; ++i) p->mod[((size_t)l * NSEQ + rg * 8 + i) * 3072 + col] = acc2[i >> 1][i & 1] + bb;
        __syncthreads();
    }
}

DEVI void phase_norm(KP p_, int l) {
    KP p = launder(p_);
    const int lane = tidx() & 63, wid = tidx() >> 6;
    for (int row = bidx() * 8 + wid; row < NR; row += gdim() * 8) {
        const float4* xr = l == 0 ? (row < NPR ? (const float4*)(p->x_prompt + (size_t)row * 1024) : (const float4*)(p->x_sample + (size_t)(row - NPR) * 1024))
                                  : (const float4*)(p->x + (size_t)row * 1024);
        const float* md = p->mod + ((size_t)l * NSEQ + mod_row(row)) * 3072;
        float4 v[4], g[4], sh[4], sc[4];
#pragma unroll
        for (int i = 0; i < 4; ++i) {
            const int c = (lane + i * 64) * 4;
            v[i] = xr[lane + i * 64]; g[i] = *(const float4*)(p->norm_g + l * 1024 + c); sh[i] = *(const float4*)(md + c); sc[i] = *(const float4*)(md + 1024 + c);
        }
        float ss = 0.f;
#pragma unroll
        for (int i = 0; i < 4; ++i) ss += v[i].x * v[i].x + v[i].y * v[i].y + v[i].z * v[i].z + v[i].w * v[i].w;
        ss = wsum(ss);
        const float rstd = rsqrtf(ss * (1.f / 1024.f) + 1e-6f);
#pragma unroll
        for (int i = 0; i < 4; ++i) {
            const int c = (lane + i * 64) * 4;
            ushort4 o;
            o.x = f2bf(v[i].x * rstd * g[i].x * (1.f + sc[i].x) + sh[i].x);
            o.y = f2bf(v[i].y * rstd * g[i].y * (1.f + sc[i].y) + sh[i].y);
            o.z = f2bf(v[i].z * rstd * g[i].z * (1.f + sc[i].z) + sh[i].z);
            o.w = f2bf(v[i].w * rstd * g[i].w * (1.f + sc[i].w) + sh[i].w);
            *(ushort4*)(p->h + (size_t)row * 1024 + c) = o;
        }
    }
}

constexpr int G_BM = 256, G_BN = 128, G_BK = 64, G_LDS = 72;
template <class Epi>
DEVI void gemm_phase(unsigned char* smem, const bf16_t* A, int lda, const bf16_t* Bt, int ldb, int Mtiles, int Ntiles, int K, const Epi& epi, int first_block, int mt0) {
    bf16_t* As = (bf16_t*)smem;
    bf16_t* Bs = As + G_BM * G_LDS;
    const int tid = tidx(), lane = tid & 63, wid = tid >> 6, wm = wid >> 1, wn = wid & 1;
    const int fr = lane & 15, fq = lane >> 4;
    const int nk = K / G_BK;
    for (int t = bidx() - first_block; t < Mtiles * Ntiles; t += gdim()) {
        if (t < 0) continue;
        const int mt = mt0 + t / Ntiles, nt = t % Ntiles;
        const bf16_t* Ag = A + (size_t)mt * G_BM * lda;
        const bf16_t* Bg = Bt + (size_t)nt * G_BN * ldb;
        f32x4 acc[4][4];
#pragma unroll
        for (int i = 0; i < 4; ++i)
#pragma unroll
            for (int j = 0; j < 4; ++j) acc[i][j] = (f32x4){0.f, 0.f, 0.f, 0.f};
        const int sr = tid >> 3, scol = (tid & 7) * 8;
        const bf16_t* Ap = Ag + (size_t)sr * lda + scol;
        const bf16_t* Bp = Bg + (size_t)sr * ldb + scol;
        uint4 ra0 = *(const uint4*)(Ap), ra1 = *(const uint4*)(Ap + (size_t)64 * lda), ra2 = *(const uint4*)(Ap + (size_t)128 * lda), ra3 = *(const uint4*)(Ap + (size_t)192 * lda);
        uint4 rb0 = *(const uint4*)(Bp), rb1 = *(const uint4*)(Bp + (size_t)64 * ldb);
        for (int kt = 0; kt < nk; ++kt) {
            *(uint4*)(As + sr * G_LDS + scol) = ra0; *(uint4*)(As + (sr + 64) * G_LDS + scol) = ra1;
            *(uint4*)(As + (sr + 128) * G_LDS + scol) = ra2; *(uint4*)(As + (sr + 192) * G_LDS + scol) = ra3;
            *(uint4*)(Bs + sr * G_LDS + scol) = rb0; *(uint4*)(Bs + (sr + 64) * G_LDS + scol) = rb1;
            __syncthreads();
            if (kt + 1 < nk) {
                const int k0 = (kt + 1) * G_BK;
                ra0 = *(const uint4*)(Ap + k0); ra1 = *(const uint4*)(Ap + (size_t)64 * lda + k0); ra2 = *(const uint4*)(Ap + (size_t)128 * lda + k0); ra3 = *(const uint4*)(Ap + (size_t)192 * lda + k0);
                rb0 = *(const uint4*)(Bp + k0); rb1 = *(const uint4*)(Bp + (size_t)64 * ldb + k0);
            }
#pragma unroll
            for (int ks = 0; ks < 2; ++ks) {
                bf16x8 af[4], bfr[4];
#pragma unroll
                for (int i = 0; i < 4; ++i) af[i] = *(const bf16x8*)(As + (wm * 64 + i * 16 + fr) * G_LDS + ks * 32 + fq * 8);
#pragma unroll
                for (int j = 0; j < 4; ++j) bfr[j] = *(const bf16x8*)(Bs + (wn * 64 + j * 16 + fr) * G_LDS + ks * 32 + fq * 8);
#pragma unroll
                for (int i = 0; i < 4; ++i)
#pragma unroll
                    for (int j = 0; j < 4; ++j) acc[i][j] = __builtin_amdgcn_mfma_f32_16x16x32_bf16(bfr[j], af[i], acc[i][j], 0, 0, 0);
            }
            __syncthreads();
        }
#pragma unroll
        for (int i = 0; i < 4; ++i)
#pragma unroll
            for (int j = 0; j < 4; ++j) epi(mt * G_BM + wm * 64 + i * 16 + fr, nt * G_BN + wn * 64 + j * 16 + fq * 4, acc[i][j]);
    }
}
struct EpiProj {
    bf16_t* proj;
    DEVI void operator()(int m, int n, f32x4 v) const {
        ushort4 o; o.x = f2bf(v[0]); o.y = f2bf(v[1]); o.z = f2bf(v[2]); o.w = f2bf(v[3]);
        *(ushort4*)(proj + (size_t)m * LDP + n) = o;
    }
};
struct EpiOut {
    float* x; const float* mod;
    DEVI void operator()(int m, int n, f32x4 v) const {
        if (m >= NR) return;
        const float4 g = *(const float4*)(mod + (size_t)mod_row(m) * 3072 + 2048 + n);
        float4* xp = (float4*)(x + (size_t)m * 1024 + n);
        float4 xv = *xp;
        xv.x += g.x * v[0]; xv.y += g.y * v[1]; xv.z += g.z * v[2]; xv.w += g.w * v[3];
        *xp = xv;
    }
};

namespace pg8 {
#define PG8_LAS __attribute__((address_space(3)))
typedef unsigned short bf16_t;
typedef short bf16x8 __attribute__((ext_vector_type(8)));
typedef float f32x4 __attribute__((ext_vector_type(4)));
typedef unsigned u32x4 __attribute__((ext_vector_type(4)));
constexpr int BM = 256, BK = 64, HALF = 128, HTB = HALF * BK * 2  , STAGE_BYTES = 8 * HTB, NXCD = 8, WGM = 8;

__host__ __device__ __forceinline__ int lds_byte(int r, int c) { const int st = (r >> 4) * 2 + (c >> 5), rr = r & 15, cc = c & 31, ob = rr * 64 + cc * 2; return st * 1024 + (ob ^ (((ob >> 9) & 1) << 5)); }
__host__ __device__ __forceinline__ void stage_rc(int b, int& R, int& C) { const int st = b / 1024, sb = b % 1024, swz = sb ^ (((sb >> 9) & 1) << 5); R = (st >> 1) * 16 + swz / 64; C = (st & 1) * 32 + (swz % 64) / 2; }
__host__ __device__ __forceinline__ int perm32(int rho) { const int n = rho >> 4, i = rho & 15; return 8 * (i >> 2) + 4 * n + (i & 3); }

struct Unit { int pm, pn; };
struct Gemm { const bf16_t* A; const bf16_t* Bt; int M, N, K; };

struct StaticOrder {
    int nM, nN, nwg, G, c;
    __host__ __device__ void init(int M, int N, int G_, int c_) { nM = M / BM; nN = N / BM; nwg = nM * nN; G = G_; c = c_; }
    __host__ __device__ bool next(int i, Unit& u) const {
        const long L = (long)i * G + c; if (L >= nwg) return false;
        int wgid = (int)L; { const int q = nwg / NXCD, r = nwg % NXCD, xcd = wgid % NXCD, off = wgid / NXCD; wgid = (xcd < r ? xcd * (q + 1) : r * (q + 1) + (xcd - r) * q) + off; }
        const int nig = WGM * nN, gid = wgid / nig, fm = gid * WGM, gsz = (nM - fm) < WGM ? (nM - fm) : WGM;
        u.pm = fm + ((wgid % nig) % gsz); u.pn = (wgid % nig) / gsz; return true;
    }
    __device__ __forceinline__ void a_ready(const Unit&) const {}
    __device__ __forceinline__ void done(const Unit&) const {}
};
template <class Epi, class Sched, bool STAMP = false>
__device__ __forceinline__ void gemm_phase(PG8_LAS unsigned char* lds, const Gemm g, const Sched& S, const Epi& E, unsigned long long* stamps) {
    const int tid = tidx(), wid = __builtin_amdgcn_readfirstlane(tid >> 6), lane = tid & 63, wr = wid >> 2, wc = wid & 3, fr = lane & 15, fq = lane >> 4;
    const int K = g.K, nt = K / BK;
    int ts_lo = 0, ts_hi = 0, nts = 0; const unsigned long long rt_entry = STAMP ? (unsigned long long)wall_clock64() : 0ull;
#define PG8_STAMP() do { if (STAMP && wid == 0 && nts < 64) { const unsigned long long _c = (unsigned long long)clock64(); \
        ts_lo = (lane == nts) ? (int)(unsigned)_c : ts_lo; ts_hi = (lane == nts) ? (int)(unsigned)(_c >> 32) : ts_hi; ++nts; } } while (0)
    PG8_STAMP();
    unsigned voffA[2], voffB[2];
#pragma unroll
    for (int i = 0; i < 2; ++i) { int R, C; stage_rc(tid * 16 + i * 8192, R, C); const int Rb = Epi::PERM ? ((R & ~31) + perm32(R & 31)) : R;
        voffA[i] = (unsigned)(R * K + C) * 2u; voffB[i] = (unsigned)(Rb * K + C) * 2u; }
    const size_t kstep = (size_t)(BK * 2);
    const size_t hstep = (size_t)HALF * K * 2;
    const size_t tstep = 2 * hstep;
    const unsigned ldsw = (unsigned)wid * 1024u;
    const int aoff = lds_byte(wr * 64 + fr, fq * 8), boff = lds_byte(wc * 32 + fr, fq * 8);
#define PG8_SA(b, h) (((b) * 2 + (h)) * HTB)
#define PG8_SB(b, h) ((4 + (b) * 2 + (h)) * HTB)
#define PG8_STAGE(bufoff, gbase, voff) do { _Pragma("unroll") for (int _i = 0; _i < 2; ++_i) \
        __builtin_amdgcn_global_load_lds((const unsigned*)((const char*)(gbase) + (voff)[_i]), (PG8_LAS unsigned*)(lds + (bufoff) + ldsw + _i * 8192), 16, 0, 0); } while (0)
#define PG8_LDA(dst, b, h) do { _Pragma("unroll") for (int m = 0; m < 4; ++m) _Pragma("unroll") for (int k = 0; k < 2; ++k) dst[m][k] = *(const PG8_LAS bf16x8*)(lds + PG8_SA(b, h) + aoff + m * 2048 + k * 1024); } while (0)
#define PG8_LDB(dst, b, h) do { _Pragma("unroll") for (int n = 0; n < 2; ++n) _Pragma("unroll") for (int k = 0; k < 2; ++k) dst[n][k] = *(const PG8_LAS bf16x8*)(lds + PG8_SB(b, h) + boff + n * 2048 + k * 1024); } while (0)
#define PG8_MMA(ai, bj, At, Bt) do { __builtin_amdgcn_s_setprio(1); _Pragma("unroll") for (int m = 0; m < 4; ++m) _Pragma("unroll") for (int n = 0; n < 2; ++n) _Pragma("unroll") for (int k = 0; k < 2; ++k) \
        acc[ai][bj][m][n] = __builtin_amdgcn_mfma_f32_16x16x32_bf16(Bt[n][k], At[m][k], acc[ai][bj][m][n], 0, 0, 0); __builtin_amdgcn_s_setprio(0); } while (0)
#define PG8_WAIT_V(n) asm volatile("s_waitcnt vmcnt(" #n ")" ::: "memory")
#define PG8_WAIT_L(n) asm volatile("s_waitcnt lgkmcnt(" #n ")" ::: "memory")
#define PG8_BAR __builtin_amdgcn_s_barrier()
#define PG8_SCHED __builtin_amdgcn_sched_barrier(0)
    Unit cur, nxt; int ui = 0;
    if (!S.next(0, cur)) return;
    f32x4 acc[2][2][4][2];
#pragma unroll
    for (int a = 0; a < 2; ++a)
#pragma unroll
        for (int b = 0; b < 2; ++b)
#pragma unroll
            for (int m = 0; m < 4; ++m)
#pragma unroll
                for (int n = 0; n < 2; ++n) acc[a][b][m][n] = (f32x4){0.f, 0.f, 0.f, 0.f};
    bf16x8 At[4][2], B0[2][2], B1[2][2];
    const char* cA = (const char*)g.A + (size_t)cur.pm * tstep; const char* cB = (const char*)g.Bt + (size_t)cur.pn * tstep;
    S.a_ready(cur);
    PG8_STAGE(PG8_SB(0, 0), cB, voffB); PG8_STAGE(PG8_SA(0, 0), cA, voffA); PG8_STAGE(PG8_SB(0, 1), cB + hstep, voffB); PG8_STAGE(PG8_SA(0, 1), cA + hstep, voffA);
    if (wr == 1) PG8_BAR;
    PG8_WAIT_V(4); PG8_BAR;
    PG8_STAGE(PG8_SB(1, 0), cB + kstep, voffB); PG8_STAGE(PG8_SA(1, 0), cA + kstep, voffA); PG8_STAGE(PG8_SB(1, 1), cB + hstep + kstep, voffB);
    PG8_WAIT_V(6); PG8_BAR;
    PG8_STAMP();
    for (;;) {
        const bool has_next = S.next(ui + 1, nxt);
        const char* nA = has_next ? (const char*)g.A + (size_t)nxt.pm * tstep : cA; const char* nB = has_next ? (const char*)g.Bt + (size_t)nxt.pn * tstep : cB;
        for (int t = 0; t < nt; t += 2) {
            const bool last = (t == nt - 2);
            const char* a1 = cA + (size_t)(t + 1) * kstep;
            const char* a2 = last ? nA : cA + (size_t)(t + 2) * kstep; const char* b2 = last ? nB : cB + (size_t)(t + 2) * kstep;
            const char* a3 = a2 + kstep; const char* b3 = b2 + kstep;
            if (last && has_next) S.a_ready(nxt);
            PG8_LDB(B0, 0, 0); PG8_SCHED; PG8_LDA(At, 0, 0); PG8_STAGE(PG8_SA(1, 1), a1 + hstep, voffA);
            PG8_WAIT_L(8); PG8_BAR; PG8_WAIT_L(0); PG8_MMA(0, 0, At, B0); PG8_BAR; PG8_SCHED;
            PG8_LDB(B1, 0, 1); PG8_STAGE(PG8_SB(0, 0), b2, voffB);
            PG8_BAR; PG8_WAIT_L(0); PG8_MMA(0, 1, At, B1); PG8_BAR;
            PG8_LDA(At, 0, 1); PG8_STAGE(PG8_SA(0, 0), a2, voffA);
            PG8_BAR; PG8_WAIT_L(0); PG8_MMA(1, 0, At, B0); PG8_BAR; PG8_SCHED;
            PG8_STAGE(PG8_SB(0, 1), b2 + hstep, voffB);
            PG8_WAIT_V(6); PG8_BAR; PG8_MMA(1, 1, At, B1); PG8_BAR;
            PG8_LDB(B0, 1, 0); PG8_SCHED; PG8_LDA(At, 1, 0); PG8_STAGE(PG8_SA(0, 1), a2 + hstep, voffA);
            PG8_WAIT_L(8); PG8_BAR; PG8_WAIT_L(0); PG8_MMA(0, 0, At, B0); PG8_BAR; PG8_SCHED;
            PG8_LDB(B1, 1, 1); PG8_STAGE(PG8_SB(1, 0), b3, voffB);
            PG8_BAR; PG8_WAIT_L(0); PG8_MMA(0, 1, At, B1); PG8_BAR;
            PG8_LDA(At, 1, 1); PG8_STAGE(PG8_SA(1, 0), a3, voffA);
            PG8_BAR; PG8_WAIT_L(0); PG8_MMA(1, 0, At, B0); PG8_BAR; PG8_SCHED;
            PG8_STAGE(PG8_SB(1, 1), b3 + hstep, voffB);
            PG8_WAIT_V(6); PG8_BAR; PG8_MMA(1, 1, At, B1); PG8_BAR;
        }
        PG8_STAMP();
        if constexpr (!Epi::AFTER_DRAIN) { E(acc, cur, wr, wc, fr, fq); S.done(cur); }
        PG8_STAMP();
        if (!has_next) break;
#pragma unroll
        for (int a = 0; a < 2; ++a)
#pragma unroll
            for (int b = 0; b < 2; ++b)
#pragma unroll
                for (int m = 0; m < 4; ++m)
#pragma unroll
                    for (int n = 0; n < 2; ++n) acc[a][b][m][n] = (f32x4){0.f, 0.f, 0.f, 0.f};
        cur = nxt; cA = nA; cB = nB; ++ui;
    }
    PG8_WAIT_V(0);
    if (wr == 0) PG8_BAR;
    PG8_BAR;
    if constexpr (Epi::AFTER_DRAIN) { E.fused(acc, cur, wr, wc, fr, fq, lds, wid, lane); S.done(cur); }
    PG8_STAMP();
    if (STAMP && wid == 0) { stamps[lane] = lane < nts ? (((unsigned long long)(unsigned)ts_hi << 32) | (unsigned)ts_lo) : 0ull;
        if (lane == 62) stamps[62] = rt_entry; if (lane == 63) stamps[63] = (unsigned long long)wall_clock64(); }
#undef PG8_STAMP
#undef PG8_SA
#undef PG8_SB
#undef PG8_STAGE
#undef PG8_LDA
#undef PG8_LDB
#undef PG8_MMA
#undef PG8_WAIT_V
#undef PG8_WAIT_L
#undef PG8_BAR
#undef PG8_SCHED
}
}

struct EpiProjPG {
    static constexpr bool PERM = true, AFTER_DRAIN = false;
    bf16_t* O;
    DEVI void operator()(const pg8::f32x4 (&acc)[2][2][4][2], const pg8::Unit& u, int wr, int wc, int fr, int fq) const {
        const int row0 = u.pm * 256 + wr * 64 + fr, col0 = u.pn * 256 + wc * 32 + 8 * fq;
#pragma unroll
        for (int ai = 0; ai < 2; ++ai)
#pragma unroll
            for (int m = 0; m < 4; ++m) {
                bf16_t* rowp = O + (size_t)(row0 + ai * 128 + m * 16) * LDP + col0;
#pragma unroll
                for (int bj = 0; bj < 2; ++bj) {
                    const pg8::f32x4 v0 = acc[ai][bj][m][0], v1 = acc[ai][bj][m][1];
                    u32x4 w = {pk2(v0[0], v0[1]), pk2(v0[2], v0[3]), pk2(v1[0], v1[1]), pk2(v1[2], v1[3])};
                    *(u32x4*)(rowp + bj * 128) = w;
                }
            }
    }
};
struct EpiOutPG {
    static constexpr bool PERM = false, AFTER_DRAIN = false;
    float* x; const float* xin; const float* mod;
    DEVI void operator()(const pg8::f32x4 (&acc)[2][2][4][2], const pg8::Unit& u, int wr, int wc, int fr, int fq) const {
        const int row0 = u.pm * 256 + wr * 64 + fr, col0 = u.pn * 256 + wc * 32 + 4 * fq;
        const float* gp = mod + (size_t)(u.pm >> 3) * 3072 + 2048 + col0;
        pg8::f32x4 gv[2][2];
#pragma unroll
        for (int bj = 0; bj < 2; ++bj)
#pragma unroll
            for (int n = 0; n < 2; ++n) gv[bj][n] = *(const pg8::f32x4*)(gp + bj * 128 + n * 16);
#pragma unroll
        for (int ai = 0; ai < 2; ++ai)
#pragma unroll
            for (int m = 0; m < 4; ++m) {
                const size_t ro = (size_t)(row0 + ai * 128 + m * 16) * 1024 + col0;
#pragma unroll
                for (int bj = 0; bj < 2; ++bj)
#pragma unroll
                    for (int n = 0; n < 2; ++n)
                        *(pg8::f32x4*)(x + ro + bj * 128 + n * 16) = *(const pg8::f32x4*)(xin + ro + bj * 128 + n * 16) + gv[bj][n] * acc[ai][bj][m][n];
            }
    }
};
DEVI void out_gemm_sample(KP p_, int l) {
    KP p = launder(p_);
    const int nt = bidx();
    if (nt >= 64) return;
    const int lane = tidx() & 63, wid = tidx() >> 6, q = lane >> 4, c = lane & 15;
    const bf16_t* a = p->obf + (size_t)(NPR + wid * 16 + c) * 1536 + 8 * q;
    const bf16_t* b = p->WoutT + (size_t)l * 1024 * 1536 + (size_t)(nt * 16 + c) * 1536 + 8 * q;
    f32x4 acc0 = {0.f, 0.f, 0.f, 0.f}, acc1 = {0.f, 0.f, 0.f, 0.f};
#pragma unroll 8
    for (int ks = 0; ks < 48; ks += 2) {
        acc0 = MFMA16(*(const bf16x8*)(b + ks * 32), *(const bf16x8*)(a + ks * 32), acc0);
        acc1 = MFMA16(*(const bf16x8*)(b + ks * 32 + 32), *(const bf16x8*)(a + ks * 32 + 32), acc1);
    }
    const int m = NPR + wid * 16 + c, n = nt * 16 + 4 * q;
    const f32x4 g = *(const f32x4*)(p->mod + ((size_t)l * NSEQ + mod_row(m)) * 3072 + 2048 + n);
    const float* xi = l == 0 ? p->x_sample + (size_t)(m - NPR) * 1024 + n : p->x + (size_t)m * 1024 + n;
    *(f32x4*)(p->x + (size_t)m * 1024 + n) = *(const f32x4*)xi + g * (acc0 + acc1);
}
DEVI float dn_full(KP p, int l, int s, int row0, int f, int col) {
    if (f < 3) { if (s < 8) return 0.f; return p->st_conv[((size_t)(l * 128 + (s - 8)) * 3 + f) * 1536 + col]; }
    return bf2f(p->proj[(size_t)(row0 + f - 3) * LDP + col]);
}
DEVI void seq_of_row(int row, int& s, int& t, int& T, int& row0) {
    if (row < NPR) { s = row >> 11; t = row & 2047; T = 2048; row0 = s * 2048; }
    else { s = 8 + row - NPR; t = 0; T = 1; row0 = row; }
}

DEVI void phase_prep(KP p_, int l, unsigned char* smem) {
    KP p = launder(p_);
    const int tid = tidx(), lane = tid & 63, wid = tid >> 6;
    for (int it = NPR * 4 + bidx() * 8 + wid; it < NR * 4; it += gdim() * 8) {
        const int row = it >> 2, h = it & 3, b = row - NPR;
        const float* st = p->st_conv + (size_t)(l * 128 + b) * 3 * 1536;
        float* cdst = p->out + O_SCONV + (size_t)(l * 128 + b) * 3 * 1536;
        float val[3][2];
#pragma unroll
        for (int seg = 0; seg < 3; ++seg) {
            const int col = seg * 512 + h * 128 + lane * 2;
            const float2 s0 = *(const float2*)(st + col), s1 = *(const float2*)(st + 1536 + col), s2 = *(const float2*)(st + 3072 + col);
            const unsigned cu = *(const unsigned*)(p->proj + (size_t)row * LDP + col);
            const float2 cur = make_float2(__uint_as_float(cu << 16), __uint_as_float(cu & 0xffff0000u));
            const float2 w0 = *(const float2*)(p->conv_w + (l * 4 + 0) * 1536 + col), w1 = *(const float2*)(p->conv_w + (l * 4 + 1) * 1536 + col);
            const float2 w2 = *(const float2*)(p->conv_w + (l * 4 + 2) * 1536 + col), w3 = *(const float2*)(p->conv_w + (l * 4 + 3) * 1536 + col);
            val[seg][0] = siluf(s0.x * w0.x + s1.x * w1.x + s2.x * w2.x + cur.x * w3.x);
            val[seg][1] = siluf(s0.y * w0.y + s1.y * w1.y + s2.y * w2.y + cur.y * w3.y);
            *(float2*)(cdst + col) = s1; *(float2*)(cdst + 1536 + col) = s2; *(float2*)(cdst + 3072 + col) = cur;
        }
        float sq = wsum(val[0][0] * val[0][0] + val[0][1] * val[0][1]);
        float sk = wsum(val[1][0] * val[1][0] + val[1][1] * val[1][1]);
        const float rq = rsqrtf(sq + 1e-6f) * 0.08838834764831845f, rk = rsqrtf(sk + 1e-6f);
        const size_t o = (size_t)row * 512 + h * 128 + lane * 2;
        *(float2*)(p->dnq + o) = make_float2(val[0][0] * rq, val[0][1] * rq);
        *(float2*)(p->dnk + o) = make_float2(val[1][0] * rk, val[1][1] * rk);
        *(float2*)(p->dnv + o) = make_float2(val[2][0], val[2][1]);
        if (lane == 0) {
            float braw = bf2f(p->proj[(size_t)row * LDP + C_DNB + h]), araw = bf2f(p->proj[(size_t)row * LDP + C_DNA + h]);
            p->dnbeta[row * 4 + h] = sigmf(braw);
            float g = -fexp(p->a_log[l * 4 + h]) * softplusf(araw + p->dt_bias[l * 4 + h]);
            p->dna[row * 4 + h] = fexp(g);
        }
    }
    for (int row = NPR + ((bidx() + gdim() - 64) % gdim()) * 8 + wid; row < NR; row += gdim() * 8) {
        float glo[16];
#pragma unroll
        for (int j = 0; j < 16; ++j) glo[j] = bf2f(p->proj[(size_t)row * LDP + C_GLO + j]);
#pragma unroll
        for (int i = 0; i < 4; ++i) {
            const int c = lane + i * 64;
            float z = p->gla_bf[l * 256 + c];
#pragma unroll
            for (int j = 0; j < 16; ++j) z += glo[j] * p->gla_wf[(l * 16 + j) * 256 + c];
            p->glf[(size_t)row * 256 + c] = -softplusf(-z) * (1.f / 16.f);
        }
    }
    constexpr int RT = 2;
    float* twT = (float*)smem;
    float* alT = twT + 64 * RT;
    for (int tile = NPR / RT + (bidx() + gdim() - 128) % gdim(); tile < NR / RT; tile += gdim()) {
        const int c = tid;
        const int rbase = tile * RT;
        const float mur = p->rw_mu[l * 1664 + c], muk = p->rw_mu[l * 1664 + 512 + c], muv = p->rw_mu[l * 1664 + 1024 + c];
        float xr[RT], xk[RT], xv[RT];
#pragma unroll
        for (int r = 0; r < RT; ++r) {
            const int row = rbase + r;
            const bf16_t* pp = p->proj + (size_t)row * LDP + C_RX;
            const float cr = bf2f(pp[c]), ck = bf2f(pp[512 + c]), cv = bf2f(pp[1024 + c]);
            const float* st = p->st_rs + (size_t)(l * 128 + row - NPR) * 1664;
            const float pr = st[c], pk = st[512 + c], pv = st[1024 + c];
            xr[r] = cr + (pr - cr) * mur; xk[r] = ck + (pk - ck) * muk; xv[r] = cv + (pv - cv) * muv;
            float* dst = p->out + O_SRS + (size_t)(l * 128 + row - NPR) * 1664;
            dst[c] = cr; dst[512 + c] = ck; dst[1024 + c] = cv;
            if (c < 128) dst[1536 + c] = bf2f(pp[1536 + c]);
        }
        if (c < 128) {
            const int col = 1536 + c, j = c & 63;
            const float mu = p->rw_mu[l * 1664 + col];
#pragma unroll
            for (int r = 0; r < RT; ++r) {
                const int row = rbase + r;
                const float cw = bf2f(p->proj[(size_t)row * LDP + C_RX + col]);
                const float pw = p->st_rs[(size_t)(l * 128 + row - NPR) * 1664 + col];
                const float xm = cw + (pw - cw) * mu;
                if (c < 64) twT[j * RT + r] = ftanh(xm); else alT[j * RT + r] = xm;
            }
        }
        __syncthreads();
        float aw[RT], aa[RT];
#pragma unroll
        for (int r = 0; r < RT; ++r) { aw[r] = 0.f; aa[r] = 0.f; }
#pragma unroll 32
        for (int j = 0; j < 64; ++j) {
            const float w2v = p->rw_w2[((size_t)l * 64 + j) * 512 + c], a2v = p->rw_a2[((size_t)l * 64 + j) * 512 + c];
            const float2 t2 = ((const float2*)twT)[j], a2 = ((const float2*)alT)[j];
            aw[0] += t2.x * w2v; aw[1] += t2.y * w2v;
            aa[0] += a2.x * a2v; aa[1] += a2.y * a2v;
        }
        const float w0 = p->rw_w0[l * 512 + c], a0 = p->rw_a0[l * 512 + c], kkc = p->rw_k_k[l * 512 + c], kac = p->rw_k_a[l * 512 + c], rkc = p->rw_r_k[l * 512 + c];
#pragma unroll
        for (int r = 0; r < RT; ++r) {
            const size_t o = (size_t)(rbase + r) * 512 + c;
            const float wl = -softplusf(-(w0 + aw[r])) - 0.5f;
            const float decay = fexp(-fexp(wl));
            const float a = sigmf(a0 + aa[r]);
            const float kr = xk[r] * kkc;
            const float ss = wsum(kr * kr);
            const float kk = kr * rsqrtf(ss + 1e-6f);
            const float k2 = xk[r] * (1.f + (a - 1.f) * kac);
            const float bon = wsum(xr[r] * k2 * rkc) * xv[r];
            p->rr[o] = xr[r]; p->rk[o] = k2; p->rv[o] = xv[r]; p->rw[o] = decay; p->rkk[o] = kk; p->rb[o] = kk * a; p->rbonus[o] = bon;
        }
        __syncthreads();
    }
}

DEVI void dn_scan_item(KP p, int l, int s, int h, int quarter, float* wl) {
    const int lane = tidx() & 63, kh = lane & 1;
    const int row = NPR + s - 8;
    const float* Sin = p->st_dn + (size_t)((l * 128 + s - 8) * 4 + h) * 16384;
    float* Sout = p->out + O_SDN + (size_t)((l * 128 + s - 8) * 4 + h) * 16384;
    const int col = quarter * 32 + (lane >> 1);
    float S[64];
#pragma unroll
    for (int k = 0; k < 64; ++k) S[k] = Sin[(kh * 64 + k) * 128 + col];
    const size_t o = (size_t)row * 512 + h * 128;
    wave_sync();
    wl[lane] = p->dnq[o + lane]; wl[64 + lane] = p->dnq[o + 64 + lane]; wl[128 + lane] = p->dnk[o + lane]; wl[192 + lane] = p->dnk[o + 64 + lane];
    const float v = p->dnv[o + col], beta = p->dnbeta[row * 4 + h], a = p->dna[row * 4 + h];
    wave_sync();
    const float4* kp = (const float4*)(wl + 128 + kh * 64);
    const float4* qp = (const float4*)(wl + kh * 64);
    float x0 = 0.f, x1 = 0.f, x2 = 0.f, x3 = 0.f;
#pragma unroll
    for (int k4 = 0; k4 < 16; ++k4) {
        const float4 kv = kp[k4];
        x0 += S[k4 * 4 + 0] * kv.x; x1 += S[k4 * 4 + 1] * kv.y; x2 += S[k4 * 4 + 2] * kv.z; x3 += S[k4 * 4 + 3] * kv.w;
    }
    float x = (x0 + x1) + (x2 + x3);
    x += __shfl_xor(x, 1);
    const float coef = beta * (v - a * x);
    float o0 = 0.f, o1 = 0.f, o2 = 0.f, o3 = 0.f;
#pragma unroll
    for (int k4 = 0; k4 < 16; ++k4) {
        const float4 kv = kp[k4];
        const float4 qv = qp[k4];
        S[k4 * 4 + 0] = a * S[k4 * 4 + 0] + coef * kv.x; o0 += S[k4 * 4 + 0] * qv.x;
        S[k4 * 4 + 1] = a * S[k4 * 4 + 1] + coef * kv.y; o1 += S[k4 * 4 + 1] * qv.y;
        S[k4 * 4 + 2] = a * S[k4 * 4 + 2] + coef * kv.z; o2 += S[k4 * 4 + 2] * qv.z;
        S[k4 * 4 + 3] = a * S[k4 * 4 + 3] + coef * kv.w; o3 += S[k4 * 4 + 3] * qv.w;
    }
    float ov = (o0 + o1) + (o2 + o3);
    ov += __shfl_xor(ov, 1);
    if (kh == 0) p->oraw[(size_t)row * 1536 + h * 128 + col] = ov;
#pragma unroll
    for (int k = 0; k < 64; ++k) Sout[(kh * 64 + k) * 128 + col] = S[k];
}

DEVI void gla_scan_item(KP p, int l, int s, int h, int quarter, float* wl) {
    const int lane = tidx() & 63, kh = lane & 1;
    const int row = NPR + s - 8;
    const float* Sin = p->st_gla + (size_t)((l * 128 + s - 8) * 4 + h) * 8192;
    float* Sout = p->out + O_SGLA + (size_t)((l * 128 + s - 8) * 4 + h) * 8192;
    const int col = quarter * 32 + (lane >> 1);
    float S[32];
#pragma unroll
    for (int k = 0; k < 32; ++k) S[k] = Sin[(kh * 32 + k) * 128 + col];
    const bf16_t* pp = p->proj + (size_t)row * LDP;
    wave_sync();
    wl[lane] = bf2f(pp[C_GQ + h * 64 + lane]) * 0.125f; wl[64 + lane] = bf2f(pp[C_GK + h * 64 + lane]);
    wl[128 + lane] = fexp(p->glf[(size_t)row * 256 + h * 64 + lane]);
    const float v = bf2f(pp[C_GV + h * 128 + col]);
    wave_sync();
    float o0 = 0.f, o1 = 0.f, o2 = 0.f, o3 = 0.f;
#pragma unroll
    for (int k4 = 0; k4 < 8; ++k4) {
        const float4 qv = ((const float4*)(wl + kh * 32))[k4], kv = ((const float4*)(wl + 64 + kh * 32))[k4], fv = ((const float4*)(wl + 128 + kh * 32))[k4];
        S[k4 * 4 + 0] = fv.x * S[k4 * 4 + 0] + kv.x * v; o0 += S[k4 * 4 + 0] * qv.x;
        S[k4 * 4 + 1] = fv.y * S[k4 * 4 + 1] + kv.y * v; o1 += S[k4 * 4 + 1] * qv.y;
        S[k4 * 4 + 2] = fv.z * S[k4 * 4 + 2] + kv.z * v; o2 += S[k4 * 4 + 2] * qv.z;
        S[k4 * 4 + 3] = fv.w * S[k4 * 4 + 3] + kv.w * v; o3 += S[k4 * 4 + 3] * qv.w;
    }
    float ov = (o0 + o1) + (o2 + o3);
    ov += __shfl_xor(ov, 1);
    if (kh == 0) p->oraw[(size_t)row * 1536 + 512 + h * 128 + col] = ov;
#pragma unroll
    for (int k = 0; k < 32; ++k) Sout[(kh * 32 + k) * 128 + col] = S[k];
}

DEVI void rw_scan_item(KP p, int l, int s, int h, int half, float* wl) {
    const int lane = tidx() & 63, kh = lane & 1;
    const int row = NPR + s - 8;
    const float* Sin = p->st_rw + (size_t)((l * 128 + s - 8) * 8 + h) * 4096;
    float* Sout = p->out + O_SRW + (size_t)((l * 128 + s - 8) * 8 + h) * 4096;
    const int vr = half * 32 + (lane >> 1);
    float S[32];
#pragma unroll
    for (int k4 = 0; k4 < 8; ++k4) {
        const float4 v4 = ((const float4*)(Sin + vr * 64 + kh * 32))[k4];
        S[k4 * 4 + 0] = v4.x; S[k4 * 4 + 1] = v4.y; S[k4 * 4 + 2] = v4.z; S[k4 * 4 + 3] = v4.w;
    }
    const size_t o = (size_t)row * 512 + h * 64;
    wave_sync();
    wl[lane] = p->rr[o + lane]; wl[64 + lane] = p->rw[o + lane]; wl[128 + lane] = p->rk[o + lane]; wl[192 + lane] = p->rkk[o + lane]; wl[256 + lane] = p->rb[o + lane];
    const float v = p->rv[o + vr];
    wave_sync();
    float x0 = 0.f, x1 = 0.f, x2 = 0.f, x3 = 0.f;
#pragma unroll
    for (int k4 = 0; k4 < 8; ++k4) {
        const float4 kv = ((const float4*)(wl + 192 + kh * 32))[k4];
        x0 += S[k4 * 4 + 0] * kv.x; x1 += S[k4 * 4 + 1] * kv.y; x2 += S[k4 * 4 + 2] * kv.z; x3 += S[k4 * 4 + 3] * kv.w;
    }
    float x = (x0 + x1) + (x2 + x3);
    x += __shfl_xor(x, 1);
    float o0 = 0.f, o1 = 0.f, o2 = 0.f, o3 = 0.f;
#pragma unroll
    for (int k4 = 0; k4 < 8; ++k4) {
        const float4 rv = ((const float4*)(wl + kh * 32))[k4], wv = ((const float4*)(wl + 64 + kh * 32))[k4], kv = ((const float4*)(wl + 128 + kh * 32))[k4], bv = ((const float4*)(wl + 256 + kh * 32))[k4];
        S[k4 * 4 + 0] = S[k4 * 4 + 0] * wv.x - x * bv.x + v * kv.x; o0 += S[k4 * 4 + 0] * rv.x;
        S[k4 * 4 + 1] = S[k4 * 4 + 1] * wv.y - x * bv.y + v * kv.y; o1 += S[k4 * 4 + 1] * rv.y;
        S[k4 * 4 + 2] = S[k4 * 4 + 2] * wv.z - x * bv.z + v * kv.z; o2 += S[k4 * 4 + 2] * rv.z;
        S[k4 * 4 + 3] = S[k4 * 4 + 3] * wv.w - x * bv.w + v * kv.w; o3 += S[k4 * 4 + 3] * rv.w;
    }
    float ov = (o0 + o1) + (o2 + o3);
    ov += __shfl_xor(ov, 1);
    if (kh == 0) p->oraw[(size_t)row * 1536 + 1024 + h * 64 + vr] = ov;
#pragma unroll
    for (int k4 = 0; k4 < 8; ++k4)
        ((float4*)(Sout + vr * 64 + kh * 32))[k4] = make_float4(S[k4 * 4 + 0], S[k4 * 4 + 1], S[k4 * 4 + 2], S[k4 * 4 + 3]);
}

DEVI bf16_t bfr(float a) { return (bf16_t)(pk2(a, 0.f) & 0xffffu); }
DEVI int permpos(int i) { return (i & ~31) | ((i & 12) << 1) | ((i & 16) >> 2) | (i & 3); }
DEVI float expc(float x) { return fexp(fminf(x, 80.f)); }

template <class F>
DEVI void lds_mm(const bf16_t* A, int lda, const bf16_t* Bt, int ldb, int MT, int NTl, int KS, F epi) {
    const int tid = tidx(), lane = tid & 63, wid = tid >> 6, r = lane & 15, q = lane >> 4;
    const int ntile = MT * NTl;
    for (int t = wid; t < ntile; t += 16) {
        const int t2 = t + 8;
        const bool two = t2 < ntile;
        const int mt = t / NTl, nt = t % NTl, mt2 = two ? t2 / NTl : mt, nt2 = two ? t2 % NTl : nt;
        f32x4 acc = {0.f, 0.f, 0.f, 0.f}, acc2 = {0.f, 0.f, 0.f, 0.f};
        for (int ks = 0; ks < KS; ++ks) {
            const bf16x8 a = *(const bf16x8*)(A + (mt * 16 + r) * lda + ks * 32 + q * 8);
            const bf16x8 b = *(const bf16x8*)(Bt + (nt * 16 + r) * ldb + ks * 32 + q * 8);
            const bf16x8 a2 = *(const bf16x8*)(A + (mt2 * 16 + r) * lda + ks * 32 + q * 8);
            const bf16x8 b2 = *(const bf16x8*)(Bt + (nt2 * 16 + r) * ldb + ks * 32 + q * 8);
            acc = MFMA16(a, b, acc);
            acc2 = MFMA16(a2, b2, acc2);
        }
#pragma unroll
        for (int jj = 0; jj < 4; ++jj) epi(mt * 16 + q * 4 + jj, nt * 16 + r, acc[jj]);
        if (two) {
#pragma unroll
            for (int jj = 0; jj < 4; ++jj) epi(mt2 * 16 + q * 4 + jj, nt2 * 16 + r, acc2[jj]);
        }
    }
}

template <int NPAR, class F>
DEVI void lds_mm4(const bf16_t* A, int lda, const bf16_t* Bt, int ldb, int MT, int NTl, int KS, F epi4) {
    const int tid = tidx(), lane = tid & 63, wid = tid >> 6, r = lane & 15, q = lane >> 4;
    f32x4 acc[NPAR];
    const bf16_t* ap[NPAR]; const bf16_t* bp[NPAR];
#pragma unroll
    for (int u = 0; u < NPAR; ++u) {
        const int t = wid + 8 * u, mt = t / NTl, nt = t % NTl;
        acc[u] = (f32x4){0.f, 0.f, 0.f, 0.f};
        ap[u] = A + (mt * 16 + r) * lda + q * 8; bp[u] = Bt + (nt * 16 + r) * ldb + q * 8;
    }
    for (int ks = 0; ks < KS; ++ks) {
        bf16x8 a[NPAR], b[NPAR];
#pragma unroll
        for (int u = 0; u < NPAR; ++u) { a[u] = *(const bf16x8*)(ap[u] + ks * 32); b[u] = *(const bf16x8*)(bp[u] + ks * 32); }
#pragma unroll
        for (int u = 0; u < NPAR; ++u) acc[u] = MFMA16(a[u], b[u], acc[u]);
    }
#pragma unroll
    for (int u = 0; u < NPAR; ++u) { const int t = wid + 8 * u, mt = t / NTl, nt = t % NTl; epi4(mt * 16 + q * 4, nt * 16 + r, acc[u]); }
}

DEVI void tri_inverse(const float* Mab, bf16_t* bT, int lane) {
    float Tc[64];
#pragma unroll
    for (int i = 0; i < 64; ++i) {
        float a0 = (lane == i) ? 1.f : 0.f, a1 = 0.f, a2 = 0.f, a3 = 0.f;
#pragma unroll
        for (int j4 = 0; j4 < (i + 3) / 4; ++j4) {
            const float4 m = *(const float4*)(Mab + i * 68 + j4 * 4);
            if (j4 * 4 + 0 < i) a0 += m.x * Tc[j4 * 4 + 0];
            if (j4 * 4 + 1 < i) a1 += m.y * Tc[j4 * 4 + 1];
            if (j4 * 4 + 2 < i) a2 += m.z * Tc[j4 * 4 + 2];
            if (j4 * 4 + 3 < i) a3 += m.w * Tc[j4 * 4 + 3];
        }
        Tc[i] = (a0 + a1) + (a2 + a3);
        bT[i * 72 + lane] = bfr(Tc[i]);
    }
}

DEVI void tri_inverse8(const float* Mab, bf16_t* bT) {
    const int tid = tidx(), lane = tid & 63, wid = tid >> 6, jl = lane & 7, col = wid * 8 + (lane >> 3);
    float s[8];
#pragma unroll
    for (int k = 0; k < 8; ++k) s[k] = 0.f;
    float mc[2][8][8];
#pragma unroll
    for (int r = 0; r < 8; ++r)
#pragma unroll
        for (int kk = 0; kk < 8; ++kk) mc[0][r][kk] = Mab[(kk * 8 + jl) * 68 + r];
#pragma unroll
    for (int b = 0; b < 8; ++b) {
        if (b + 1 < 8) {
#pragma unroll
            for (int r = 0; r < 8; ++r)
#pragma unroll
                for (int kk = b + 1; kk < 8; ++kk) mc[(b + 1) & 1][r][kk] = Mab[(kk * 8 + jl) * 68 + (b + 1) * 8 + r];
        }
#pragma unroll
        for (int r = 0; r < 8; ++r) {
            const int i = b * 8 + r;
            const float own = s[b] + (col == i ? 1.f : 0.f);
            const float q1 = (r & 3) == 0 ? dppf<0x00>(own) : ((r & 3) == 1 ? dppf<0x55>(own) : ((r & 3) == 2 ? dppf<0xAA>(own) : dppf<0xFF>(own)));
            const float q2 = dppf<0x141>(q1);
            const float Ti = ((jl >> 2) == (r >> 2)) ? q1 : q2;
            if (jl == r) bT[i * 72 + col] = bfr(Ti);
#pragma unroll
            for (int kk = b; kk < 8; ++kk) s[kk] += mc[b & 1][r][kk] * Ti;
        }
    }
}

template <int DK, int DV>
DEVI void prepass_core(const float* Mab, const bf16_t* bMak, const bf16_t* bMrk, bf16_t* bT, bf16_t* bYT, const bf16_t* bAST, const bf16_t* bVT,
                       bf16_t* gW, bf16_t* gUT, bf16_t* gO1, const float* rs) {
    lds_mm4<DV / 32>(bMak, 72, bVT, 72, 4, DV / 16, 2, [&](int i0, int dv, f32x4 y) { *(u32x2*)(bYT + dv * 72 + i0) = (u32x2){pk2(y[0], y[1]), pk2(y[2], y[3])}; });
    lds_mm4<DV / 32>(bVT, 72, bMrk, 72, DV / 16, 4, 2, [&](int dv0, int i, f32x4 o) { *(u32x2*)(gO1 + i * DV + dv0) = (u32x2){pk2(o[0], o[1]), pk2(o[2], o[3])}; });
    tri_inverse8(Mab, bT);
    __syncthreads();
    lds_mm4<DV / 32>(bT, 72, bYT, 72, 4, DV / 16, 2, [&](int i0, int dv, f32x4 u) {
        if (rs) { u[0] *= rs[i0]; u[1] *= rs[i0 + 1]; u[2] *= rs[i0 + 2]; u[3] *= rs[i0 + 3]; }
        *(u32x2*)(gUT + dv * 64 + i0) = (u32x2){pk2(u[0], u[1]), pk2(u[2], u[3])};
    });
    lds_mm4<DK / 32>(bAST, 72, bT, 72, DK / 16, 4, 2, [&](int dk0, int i, f32x4 w) {
        if (rs) w = w * rs[i];
        *(u32x2*)(gW + i * DK + permpos(dk0)) = (u32x2){pk2(w[0], w[1]), pk2(w[2], w[3])};
    });
}

constexpr int PP_F = 0;
constexpr int PP_BK = 35840;
constexpr int PP_BQ = PP_BK + 17408;
constexpr int PP_AST = PP_BQ + 17408;
constexpr int PP_VT = PP_AST + 18432;
constexpr int PP_MAK = PP_VT + 18432;
constexpr int PP_MRK = PP_MAK + 9216;
constexpr int PP_T = PP_MRK + 9216;
constexpr int PP_SC = PP_T + 9216;
constexpr int PP_BYTES = PP_SC + 4096;

DEVI void prepass_dn(KP p, int l, int s, int h, int c, unsigned char* smem) {
    const int tid = tidx(), lane = tid & 63, wid = tid >> 6;
    float* F = (float*)(smem + PP_F);
    float* Mab = (float*)(smem + PP_F);
    bf16_t* bYT = (bf16_t*)(smem + PP_F + 17408);
    bf16_t* bK = (bf16_t*)(smem + PP_BK); bf16_t* bQ = (bf16_t*)(smem + PP_BQ);
    bf16_t* bAST = (bf16_t*)(smem + PP_AST); bf16_t* bVT = (bf16_t*)(smem + PP_VT);
    bf16_t* bMak = (bf16_t*)(smem + PP_MAK); bf16_t* bMrk = (bf16_t*)(smem + PP_MRK); bf16_t* bT = (bf16_t*)(smem + PP_T);
    float* Lam = (float*)(smem + PP_SC); float* Lm1 = Lam + 64; float* bb = Lam + 128; float* aa = Lam + 192;
    const int item = (s * 4 + h) * 32 + c;
    const int rowbase = s * 2048 + c * 64;
    bf16_t* gW = p->dnW + (size_t)item * 8192; bf16_t* gR = p->dnR + (size_t)item * 8192; bf16_t* gKT = p->dnKT + (size_t)item * 8192;
    bf16_t* gM = p->dnM + (size_t)item * 4096; bf16_t* gUT = p->dnUT + (size_t)item * 8192; bf16_t* gO1 = p->dnO1 + (size_t)item * 8192;
    bf16_t* gVT = p->dnVT + (size_t)item * 8192;
    if (wid == 0) {
        const int row = rowbase + lane;
        const float braw = bf2f(p->proj[(size_t)row * LDP + C_DNB + h]), araw = bf2f(p->proj[(size_t)row * LDP + C_DNA + h]);
        const float g = -fexp(p->a_log[l * 4 + h]) * softplusf(araw + p->dt_bias[l * 4 + h]);
        float L = g;
#pragma unroll
        for (int o = 1; o < 64; o <<= 1) { const float t = __shfl_up(L, o); if (lane >= o) L += t; }
        Lam[lane] = L; Lm1[lane] = L - g; bb[lane] = sigmf(braw); aa[lane] = fexp(g);
        p->dnav[(size_t)item * 64 + lane] = fexp(g);
        const float LC = __shfl(L, 63);
        p->dnpc[(size_t)item * 128 + lane] = fexp(LC); p->dnpc[(size_t)item * 128 + 64 + lane] = fexp(LC);
    }
    const int col = tid & 127, rg = tid >> 7;
    float raw[3][19];
    {
        const int t0 = c * 64 + rg * 16;
#pragma unroll
        for (int seg = 0; seg < 3; ++seg) {
            const bf16_t* pp = p->proj + (size_t)(s * 2048) * LDP + seg * 512 + h * 128 + col;
#pragma unroll
            for (int ii = 0; ii < 19; ++ii) {
                const int t = t0 - 3 + ii, tc = t < 0 ? 0 : t;
                const float v = bf2f(pp[(size_t)tc * LDP]);
                raw[seg][ii] = (ii < 3 && t < 0) ? 0.f : v;
            }
        }
    }
    auto conv_seg = [&](int seg, float (&outv)[16]) {
        const int pc = seg * 512 + h * 128 + col;
        const float cw0 = p->conv_w[(l * 4 + 0) * 1536 + pc], cw1 = p->conv_w[(l * 4 + 1) * 1536 + pc], cw2 = p->conv_w[(l * 4 + 2) * 1536 + pc], cw3 = p->conv_w[(l * 4 + 3) * 1536 + pc];
#pragma unroll
        for (int ii = 0; ii < 16; ++ii)
            outv[ii] = siluf(raw[seg][ii] * cw0 + raw[seg][ii + 1] * cw1 + raw[seg][ii + 2] * cw2 + raw[seg][ii + 3] * cw3);
    };
    float cv[16];
    conv_seg(1, cv);
#pragma unroll
    for (int ii = 0; ii < 16; ++ii) F[(rg * 16 + ii) * 129 + col] = cv[ii];
    __syncthreads();
    {
        const float LC = Lam[63];
        const int i0 = wid * 8;
        float kt0[8], kt1[8];
#pragma unroll
        for (int r = 0; r < 8; ++r) {
            const int i = i0 + r;
            const float v0 = F[i * 129 + lane], v1 = F[i * 129 + 64 + lane];
            const float rn = rsqrtf(wsum(v0 * v0 + v1 * v1) + 1e-6f);
            const float k0 = v0 * rn, k1 = v1 * rn;
            const float e1 = fexp(Lm1[i]), e2 = bb[i] * fexp(LC - Lam[i]);
            bK[i * 136 + lane] = bfr(k0); bK[i * 136 + 64 + lane] = bfr(k1);
            bAST[lane * 72 + i] = bfr(k0 * e1); bAST[(64 + lane) * 72 + i] = bfr(k1 * e1);
            kt0[r] = k0 * e2; kt1[r] = k1 * e2;
        }
        const int pb = (i0 & 32) + ((i0 & 8) << 1) + ((i0 & 16) >> 2);
        *(u32x2*)(gKT + lane * 64 + pb) = (u32x2){pk2(kt0[0], kt0[1]), pk2(kt0[2], kt0[3])}; *(u32x2*)(gKT + lane * 64 + pb + 8) = (u32x2){pk2(kt0[4], kt0[5]), pk2(kt0[6], kt0[7])};
        *(u32x2*)(gKT + (64 + lane) * 64 + pb) = (u32x2){pk2(kt1[0], kt1[1]), pk2(kt1[2], kt1[3])}; *(u32x2*)(gKT + (64 + lane) * 64 + pb + 8) = (u32x2){pk2(kt1[4], kt1[5]), pk2(kt1[6], kt1[7])};
    }
    __syncthreads();
    conv_seg(0, cv);
#pragma unroll
    for (int ii = 0; ii < 16; ++ii) F[(rg * 16 + ii) * 129 + col] = cv[ii];
    __syncthreads();
    for (int i = wid * 8; i < wid * 8 + 8; ++i) {
        const float v0 = F[i * 129 + lane], v1 = F[i * 129 + 64 + lane];
        const float rn = rsqrtf(wsum(v0 * v0 + v1 * v1) + 1e-6f) * 0.08838834764831845f;
        const float q0 = v0 * rn, q1 = v1 * rn, e = fexp(Lam[i]);
        bQ[i * 136 + lane] = bfr(q0); bQ[i * 136 + 64 + lane] = bfr(q1);
        gR[i * 128 + permpos(lane)] = bfr(q0 * e); gR[i * 128 + permpos(64 + lane)] = bfr(q1 * e);
    }
    conv_seg(2, cv);
#pragma unroll
    for (int ii = 0; ii < 16; ++ii) bVT[col * 72 + rg * 16 + ii] = bfr(cv[ii]);
#pragma unroll
    for (int g = 0; g < 4; ++g)
        *(u32x2*)(gVT + col * 64 + (rg >> 1) * 32 + 8 * g + 4 * (rg & 1)) = (u32x2){pk2(cv[4 * g], cv[4 * g + 1]), pk2(cv[4 * g + 2], cv[4 * g + 3])};
    if (c == 31) {
        for (int idx = tid; idx < 3 * 384; idx += NT) {
            const int j = idx / 384, cc = idx % 384, pc = (cc >> 7) * 512 + h * 128 + (cc & 127);
            p->out[O_PCONV + (size_t)((l * 8 + s) * 3 + j) * 1536 + pc] = bf2f(p->proj[(size_t)(s * 2048 + 2045 + j) * LDP + pc]);
        }
    }
    __syncthreads();
    lds_mm(bK, 136, bK, 136, 4, 4, 4, [&](int i, int j, float g) {
        float mak = 0.f;
        if (i > j) mak = bb[j] * g * fexp(Lm1[i] - Lam[j]);
        Mab[i * 68 + j] = -aa[j] * mak; bMak[i * 72 + j] = bfr(mak);
    });
    lds_mm(bQ, 136, bK, 136, 4, 4, 4, [&](int i, int j, float g) {
        float mrk = 0.f;
        if (i >= j) mrk = bb[j] * g * fexp(Lam[i] - Lam[j]);
        bMrk[i * 72 + j] = bfr(mrk); gM[i * 64 + permpos(j)] = bfr(-mrk);
    });
    __syncthreads();
    prepass_core<128, 128>(Mab, bMak, bMrk, bT, bYT, bAST, bVT, gW, gUT, gO1, aa);
    __syncthreads();
}

DEVI void prepass_rw(KP p, int l, int s, int h, int c, unsigned char* smem) {
    const int tid = tidx(), lane = tid & 63, wid = tid >> 6;
    bf16_t* bTW = (bf16_t*)(smem + PP_F); bf16_t* bAL = bTW + 64 * 72;
    float* awL = (float*)(smem + PP_F + 18432); float* aaL = (float*)(smem + PP_BK);
    bf16_t* bW2T = (bf16_t*)(smem + PP_MAK); bf16_t* bA2T = (bf16_t*)(smem + PP_MRK);
    float* Mab = (float*)(smem + PP_F); bf16_t* bYT = (bf16_t*)(smem + PP_F + 17408);
    bf16_t* bAS = (bf16_t*)(smem + PP_BK); bf16_t* bRS = (bf16_t*)(smem + PP_BQ);
    bf16_t* bAST = (bf16_t*)(smem + PP_AST); bf16_t* bBH = (bf16_t*)(smem + PP_AST + 9216);
    bf16_t* bVT = (bf16_t*)(smem + PP_VT); bf16_t* bKH = (bf16_t*)(smem + PP_VT + 9216);
    bf16_t* bMak = (bf16_t*)(smem + PP_MAK); bf16_t* bMrk = (bf16_t*)(smem + PP_MRK); bf16_t* bT = (bf16_t*)(smem + PP_T);
    float* tot = (float*)(smem + PP_SC);
    const int item = (s * 8 + h) * 32 + c;
    const int rowbase = s * 2048 + c * 64;
    bf16_t* gW = p->rwW + (size_t)item * 4096; bf16_t* gR = p->rwR + (size_t)item * 4096; bf16_t* gKT = p->rwKT + (size_t)item * 4096;
    bf16_t* gBT = p->rwBT + (size_t)item * 4096; bf16_t* gM = p->rwM + (size_t)item * 4096; bf16_t* gUT = p->rwUT + (size_t)item * 4096;
    bf16_t* gO1 = p->rwO1 + (size_t)item * 4096; bf16_t* gVT = p->rwVT + (size_t)item * 4096;
    const int colA = tid & 127, g4 = tid >> 7, iA = g4 * 16;
    const int ch = lane, hc = h * 64 + ch, i0 = wid * 8;
    const bool firstA = (c * 64 + iA == 0), firstB = (c * 64 + i0 == 0);
    float rawA[17], rawR[9], rawK[9], rawV[9], w2r[8], a2r[8];
    {
        const bf16_t* ppA = p->proj + (size_t)rowbase * LDP + C_RX + 1536 + colA;
#pragma unroll
        for (int ii = 0; ii < 17; ++ii) { const int r = iA - 1 + ii; rawA[ii] = bf2f(ppA[(ptrdiff_t)((firstA && ii == 0) ? 0 : r) * LDP]); }
        const bf16_t* ppB = p->proj + (size_t)rowbase * LDP + C_RX + hc;
#pragma unroll
        for (int ii = 0; ii < 9; ++ii) {
            const bf16_t* q = ppB + (ptrdiff_t)((firstB && ii == 0) ? 0 : (i0 - 1 + ii)) * LDP;
            rawR[ii] = bf2f(q[0]); rawK[ii] = bf2f(q[512]); rawV[ii] = bf2f(q[1024]);
        }
#pragma unroll
        for (int jj = 0; jj < 8; ++jj) { const int j = wid * 8 + jj; w2r[jj] = p->rw_w2[((size_t)l * 64 + j) * 512 + hc]; a2r[jj] = p->rw_a2[((size_t)l * 64 + j) * 512 + hc]; }
    }
    const float muA = p->rw_mu[l * 1664 + 1536 + colA];
    const float mur = p->rw_mu[l * 1664 + hc], muk = p->rw_mu[l * 1664 + 512 + hc], muv = p->rw_mu[l * 1664 + 1024 + hc];
    if (firstA) rawA[0] = 0.f;
    if (firstB) { rawR[0] = 0.f; rawK[0] = 0.f; rawV[0] = 0.f; }
#pragma unroll
    for (int ii = 0; ii < 16; ++ii) {
        const float cur = rawA[ii + 1], xm = cur + (rawA[ii] - cur) * muA;
        if (colA < 64) bTW[(iA + ii) * 72 + colA] = bfr(ftanh(xm)); else bAL[(iA + ii) * 72 + colA - 64] = bfr(xm);
    }
#pragma unroll
    for (int jj = 0; jj < 8; ++jj) { const int j = wid * 8 + jj; bW2T[ch * 72 + j] = bfr(w2r[jj]); bA2T[ch * 72 + j] = bfr(a2r[jj]); }
    float xr[8], xk[8], xv[8];
#pragma unroll
    for (int r = 0; r < 8; ++r) {
        xr[r] = rawR[r + 1] + (rawR[r] - rawR[r + 1]) * mur; xk[r] = rawK[r + 1] + (rawK[r] - rawK[r + 1]) * muk; xv[r] = rawV[r + 1] + (rawV[r] - rawV[r + 1]) * muv;
    }
    __syncthreads();
    lds_mm(bTW, 72, bW2T, 72, 4, 4, 2, [&](int i, int c2, float v) { awL[i * 65 + c2] = v; });
    lds_mm(bAL, 72, bA2T, 72, 4, 4, 2, [&](int i, int c2, float v) { aaL[i * 65 + c2] = v; });
    __syncthreads();
    float aw[8], aa[8];
#pragma unroll
    for (int r = 0; r < 8; ++r) { aw[r] = awL[(i0 + r) * 65 + ch]; aa[r] = aaL[(i0 + r) * 65 + ch]; }
    const float w0 = p->rw_w0[l * 512 + hc], a0 = p->rw_a0[l * 512 + hc], kkc = p->rw_k_k[l * 512 + hc], kac = p->rw_k_a[l * 512 + hc], rkc = p->rw_r_k[l * 512 + hc];
    float lw[8], Ll[8], kkv[8], k2v[8], bv[8];
    float run = 0.f;
#pragma unroll
    for (int r = 0; r < 8; ++r) {
        const float wl = -softplusf(-(w0 + aw[r])) - 0.5f;
        lw[r] = -fexp(wl);
        run += lw[r]; Ll[r] = run;
        const float a = sigmf(a0 + aa[r]);
        const float kr = xk[r] * kkc;
        const float kk = kr * rsqrtf(wsum(kr * kr) + 1e-6f);
        const float k2 = xk[r] * (1.f + (a - 1.f) * kac);
        const float bon = wsum(xr[r] * k2 * rkc) * xv[r];
        p->rbonus[(size_t)(rowbase + i0 + r) * 512 + hc] = bon;
        kkv[r] = kk; k2v[r] = k2; bv[r] = -(kk * a);
    }
    tot[wid * 64 + ch] = run;
    __syncthreads();
    {
        float off = 0.f, LC = 0.f;
#pragma unroll
        for (int g = 0; g < 8; ++g) { const float t = tot[g * 64 + ch]; LC += t; if (g < wid) off += t; }
        if (wid == 0) p->rwpc[(size_t)item * 64 + ch] = expc(LC);
        float kt8[8], bt8[8];
#pragma unroll
        for (int r = 0; r < 8; ++r) {
            const int i = i0 + r;
            const float L = off + Ll[r], Lm = L - lw[r];
            const float AS = kkv[r] * expc(Lm), RS = xr[r] * expc(L), em = expc(-L), eC = expc(LC - L);
            bAS[i * 72 + ch] = bfr(AS); bRS[i * 72 + ch] = bfr(RS); bBH[i * 72 + ch] = bfr(bv[r] * em); bKH[i * 72 + ch] = bfr(k2v[r] * em);
            bAST[ch * 72 + i] = bfr(AS); bVT[ch * 72 + i] = bfr(xv[r]);
            gR[i * 64 + permpos(ch)] = bfr(RS);
            kt8[r] = k2v[r] * eC; bt8[r] = bv[r] * eC;
        }
        const int pb = ch * 64 + (i0 & 32) + ((i0 & 8) << 1) + ((i0 & 16) >> 2);
        *(u32x2*)(gKT + pb) = (u32x2){pk2(kt8[0], kt8[1]), pk2(kt8[2], kt8[3])}; *(u32x2*)(gKT + pb + 8) = (u32x2){pk2(kt8[4], kt8[5]), pk2(kt8[6], kt8[7])};
        *(u32x2*)(gBT + pb) = (u32x2){pk2(bt8[0], bt8[1]), pk2(bt8[2], bt8[3])}; *(u32x2*)(gBT + pb + 8) = (u32x2){pk2(bt8[4], bt8[5]), pk2(bt8[6], bt8[7])};
        *(u32x2*)(gVT + pb) = (u32x2){pk2(xv[0], xv[1]), pk2(xv[2], xv[3])}; *(u32x2*)(gVT + pb + 8) = (u32x2){pk2(xv[4], xv[5]), pk2(xv[6], xv[7])};
    }
    if (c == 31 && h == 0) {
        for (int idx = tid; idx < 1664; idx += NT)
            p->out[O_PRS + (size_t)(l * 8 + s) * 1664 + idx] = bf2f(p->proj[(size_t)(s * 2048 + 2047) * LDP + C_RX + idx]);
    }
    __syncthreads();
    lds_mm(bAS, 72, bBH, 72, 4, 4, 2, [&](int i, int j, float g) { Mab[i * 68 + j] = i > j ? g : 0.f; });
    lds_mm(bAS, 72, bKH, 72, 4, 4, 2, [&](int i, int j, float g) { bMak[i * 72 + j] = bfr(i > j ? g : 0.f); });
    lds_mm(bRS, 72, bBH, 72, 4, 4, 2, [&](int i, int j, float g) { gM[i * 64 + permpos(j)] = bfr(i >= j ? g : 0.f); });
    lds_mm(bRS, 72, bKH, 72, 4, 4, 2, [&](int i, int j, float g) { bMrk[i * 72 + j] = bfr(i >= j ? g : 0.f); });
    __syncthreads();
    prepass_core<64, 64>(Mab, bMak, bMrk, bT, bYT, bAST, bVT, gW, gUT, gO1, nullptr);
    __syncthreads();
}

DEVI void prepass_gla(KP p, int l, int s, int h, int c, unsigned char* smem) {
    const int tid = tidx(), lane = tid & 63, wid = tid >> 6;
    float* glo = (float*)(smem + PP_F);
    bf16_t* bRS = (bf16_t*)(smem + PP_BK); bf16_t* bKH = bRS + 64 * 72;
    bf16_t* bVT = (bf16_t*)(smem + PP_VT); bf16_t* bMrk = (bf16_t*)(smem + PP_MRK);
    float* tot = (float*)(smem + PP_SC);
    const int item = (s * 4 + h) * 32 + c;
    const int rowbase = s * 2048 + c * 64;
    bf16_t* gR = p->glR + (size_t)item * 4096; bf16_t* gKT = p->glKT + (size_t)item * 4096;
    bf16_t* gO1 = p->glO1 + (size_t)item * 8192; bf16_t* gVT = p->glVT + (size_t)item * 8192;
    const int ch = lane, hc = h * 64 + ch, i0 = wid * 8;
    const int dv = tid & 127, g4v = tid >> 7;
    float glo0, glo1; bf16_t vv[16]; float qv[8], kv[8], wf[16];
    {
        glo0 = bf2f(p->proj[(size_t)(rowbase + (tid >> 4)) * LDP + C_GLO + (tid & 15)]);
        glo1 = bf2f(p->proj[(size_t)(rowbase + 32 + (tid >> 4)) * LDP + C_GLO + (tid & 15)]);
        const bf16_t* pv = p->proj + (size_t)rowbase * LDP + C_GV + h * 128 + dv;
#pragma unroll
        for (int ii = 0; ii < 16; ++ii) vv[ii] = pv[(size_t)(g4v * 16 + ii) * LDP];
#pragma unroll
        for (int r = 0; r < 8; ++r) {
            const bf16_t* pp = p->proj + (size_t)(rowbase + i0 + r) * LDP;
            qv[r] = bf2f(pp[C_GQ + hc]) * 0.125f; kv[r] = bf2f(pp[C_GK + hc]);
        }
#pragma unroll
        for (int j = 0; j < 16; ++j) wf[j] = p->gla_wf[(l * 16 + j) * 256 + hc];
    }
    const float bfv = p->gla_bf[l * 256 + hc];
    glo[tid] = glo0; glo[512 + tid] = glo1;
#pragma unroll
    for (int ii = 0; ii < 16; ++ii) bVT[dv * 72 + g4v * 16 + ii] = vv[ii];
#pragma unroll
    for (int g = 0; g < 4; ++g)
        *(u32x2*)(gVT + dv * 64 + (g4v >> 1) * 32 + 8 * g + 4 * (g4v & 1)) = (u32x2){(unsigned)vv[4 * g] | ((unsigned)vv[4 * g + 1] << 16), (unsigned)vv[4 * g + 2] | ((unsigned)vv[4 * g + 3] << 16)};
    __syncthreads();
    float Ll[8];
    float run = 0.f;
#pragma unroll
    for (int r = 0; r < 8; ++r) {
        const int i = i0 + r;
        float z = bfv;
#pragma unroll
        for (int j4 = 0; j4 < 4; ++j4) {
            const float4 g4 = *(const float4*)(glo + i * 16 + j4 * 4);
            z += g4.x * wf[j4 * 4 + 0] + g4.y * wf[j4 * 4 + 1] + g4.z * wf[j4 * 4 + 2] + g4.w * wf[j4 * 4 + 3];
        }
        run += -softplusf(-z) * (1.f / 16.f); Ll[r] = run;
    }
    tot[wid * 64 + ch] = run;
    __syncthreads();
    {
        float off = 0.f, LC = 0.f;
#pragma unroll
        for (int g = 0; g < 8; ++g) { const float t = tot[g * 64 + ch]; LC += t; if (g < wid) off += t; }
        if (wid == 0) p->glpc[(size_t)item * 64 + ch] = expc(LC);
        float kt8[8];
#pragma unroll
        for (int r = 0; r < 8; ++r) {
            const int i = i0 + r;
            const float L = off + Ll[r];
            const float RS = qv[r] * expc(L);
            bRS[i * 72 + ch] = bfr(RS); bKH[i * 72 + ch] = bfr(kv[r] * expc(-L));
            gR[i * 64 + permpos(ch)] = bfr(RS); kt8[r] = kv[r] * expc(LC - L);
        }
        const int pb = ch * 64 + (i0 & 32) + ((i0 & 8) << 1) + ((i0 & 16) >> 2);
        *(u32x2*)(gKT + pb) = (u32x2){pk2(kt8[0], kt8[1]), pk2(kt8[2], kt8[3])}; *(u32x2*)(gKT + pb + 8) = (u32x2){pk2(kt8[4], kt8[5]), pk2(kt8[6], kt8[7])};
    }
    __syncthreads();
    lds_mm(bRS, 72, bKH, 72, 4, 4, 2, [&](int i, int j, float g) { bMrk[i * 72 + j] = bfr(i >= j ? g : 0.f); });
    __syncthreads();
    lds_mm(bMrk, 72, bVT, 72, 4, 8, 2, [&](int i, int dv, float o) { gO1[i * 128 + dv] = bfr(o); });
    __syncthreads();
}

DEVI void phase_prepass(KP p_, int l, unsigned char* smem) {
    KP p = launder(p_);
    for (int it = bidx(); it < 4096; it += gdim()) {
#ifdef NO_PRE
        continue;
#endif
        if (it < 2048) prepass_rw(p, l, it >> 8, (it >> 5) & 7, it & 31, smem);
        else if (it < 3072) { const int i = it - 2048; prepass_dn(p, l, i >> 7, (i >> 5) & 3, i & 31, smem); }
        else { const int i = it - 3072; prepass_gla(p, l, i >> 7, (i >> 5) & 3, i & 31, smem); }
    }
}

DEVI f32x4 unpack4(u32x2 u) { return (f32x4){__uint_as_float(u.x << 16), __uint_as_float(u.x & 0xffff0000u), __uint_as_float(u.y << 16), __uint_as_float(u.y & 0xffff0000u)}; }
DEVI bf16x8 pack8(f32x4 a, f32x4 b) { u32x4 r = {pk2(a[0], a[1]), pk2(a[2], a[3]), pk2(b[0], b[1]), pk2(b[2], b[3])}; return __builtin_bit_cast(bf16x8, r); }

template <int TYPE> struct SeqCfg {
    static constexpr int DK = TYPE == 0 ? 128 : 64, DV = TYPE == 2 ? 64 : 128, NDT = DK / 16, NKS = DK / 32, H = TYPE == 2 ? 8 : 4, NSL = DV / 16;
    static constexpr int NCP = TYPE == 0 ? 7 : (TYPE == 1 ? 2 : 5);
    static constexpr int SW = TYPE == 0 ? 272 : 144;
    static constexpr int OFF_W = 0, OFF_R = TYPE == 0 ? 17408 : (TYPE == 1 ? 0 : 9216), OFF_KT = TYPE == 0 ? 34816 : (TYPE == 1 ? 9216 : 18432);
    static constexpr int OFF_BT = 27648, OFF_M = TYPE == 0 ? 53248 : 36864;
    static constexpr int BUFB = TYPE == 0 ? 62464 : (TYPE == 1 ? 18432 : 46080);
};

template <int TYPE>
DEVI void chunk_seq_block(KP p, int l, int s, int h, int part, unsigned char* smem) {
    typedef SeqCfg<TYPE> C;
    constexpr int DK = C::DK, DV = C::DV, NDT = C::NDT, NKS = C::NKS, H = C::H, NSL = C::NSL, NCP = C::NCP, SW = C::SW;
    const int tid = tidx(), lane = tid & 63, wid = tid >> 6, q = lane >> 4, c = lane & 15;
    const int slice = TYPE == 0 ? part * 4 + wid : wid;
    const bool active = TYPE == 0 ? wid < 4 : wid < NSL;
    const bf16_t* cbase[NCP]; int cstride[NCP]; int soff[NCP], doff[NCP];
    if (TYPE == 0) {
#pragma unroll
        for (int i = 0; i < NCP; ++i) {
            if (i < 4) { const int j = tid + (i & 1) * 512, row = j >> 4, cc = j & 15; cbase[i] = i < 2 ? p->dnW : p->dnR; cstride[i] = 8192; soff[i] = row * 128 + cc * 8; doff[i] = (i < 2 ? C::OFF_W : C::OFF_R) + row * 272 + cc * 16; }
            else if (i < 6) { const int j = tid + (i & 1) * 512, row = j >> 3, cc = j & 7; cbase[i] = p->dnKT; cstride[i] = 8192; soff[i] = row * 64 + cc * 8; doff[i] = C::OFF_KT + row * 144 + cc * 16; }
            else { const int row = tid >> 3, cc = tid & 7; cbase[i] = p->dnM; cstride[i] = 4096; soff[i] = row * 64 + cc * 8; doff[i] = C::OFF_M + row * 144 + cc * 16; }
        }
    } else {
#pragma unroll
        for (int i = 0; i < NCP; ++i) {
            const int row = tid >> 3, cc = tid & 7;
            if (TYPE == 1) cbase[i] = i == 0 ? p->glR : p->glKT;
            else cbase[i] = i == 0 ? p->rwW : (i == 1 ? p->rwR : (i == 2 ? p->rwKT : (i == 3 ? p->rwBT : p->rwM)));
            cstride[i] = 4096; soff[i] = row * 64 + cc * 8; doff[i] = i * 9216 + row * 144 + cc * 16;
        }
    }
    const bf16_t* bUT = TYPE == 0 ? p->dnUT : p->rwUT;
    const bf16_t* bO1 = TYPE == 0 ? p->dnO1 : (TYPE == 1 ? p->glO1 : p->rwO1);
    const bf16_t* bVT = TYPE == 0 ? p->dnVT : (TYPE == 1 ? p->glVT : p->rwVT);
    const float* bpc = TYPE == 0 ? p->dnpc : (TYPE == 1 ? p->glpc : p->rwpc);
    const float* bav = p->dnav;
    float* oraw = p->oraw;
    const int ocol = (TYPE == 0 ? 0 : (TYPE == 1 ? 512 : 1024)) + h * DV + slice * 16 + 4 * q;
    const size_t item0 = (size_t)(s * H + h) * 32;
    u32x4 cr[NCP];
    u32x2 ut[4], o1[4], vtd[4]; u32x4 vtb[2]; f32x4 pcv[4]; float pcs = 1.f; f32x4 avv[4];
    auto load_priv_a = [&](size_t item) {
        if (!active) return;
        if (TYPE != 1) {
#pragma unroll
            for (int mt = 0; mt < 4; ++mt) ut[mt] = *(const u32x2*)(bUT + item * (64 * DV) + (slice * 16 + c) * 64 + mt * 16 + 4 * q);
        }
#pragma unroll
        for (int mt = 0; mt < 4; ++mt) o1[mt] = *(const u32x2*)(bO1 + item * (64 * DV) + (mt * 16 + c) * DV + slice * 16 + 4 * q);
    };
    auto load_priv_b = [&](size_t item) {
        if (!active) return;
        if (TYPE == 0) {
#pragma unroll
            for (int mt = 0; mt < 4; ++mt) {
                vtd[mt] = *(const u32x2*)(bVT + item * (64 * DV) + (slice * 16 + c) * 64 + (mt >> 1) * 32 + 8 * q + (mt & 1) * 4);
            }
        } else {
            vtb[0] = *(const u32x4*)(bVT + item * (64 * DV) + (slice * 16 + c) * 64 + 8 * q);
            vtb[1] = *(const u32x4*)(bVT + item * (64 * DV) + (slice * 16 + c) * 64 + 32 + 8 * q);
        }
        if (TYPE == 0) pcs = bpc[item * DK];
        else {
#pragma unroll
            for (int dt = 0; dt < 4; ++dt) pcv[dt] = *(const f32x4*)(bpc + item * DK + dt * 16 + 4 * q);
        }
    };
    f32x4 S[NDT];
#pragma unroll
    for (int dt = 0; dt < NDT; ++dt) S[dt] = (f32x4){0.f, 0.f, 0.f, 0.f};
#pragma unroll
    for (int i = 0; i < NCP; ++i) cr[i] = *(const u32x4*)(cbase[i] + item0 * cstride[i] + soff[i]);
#pragma unroll
    for (int i = 0; i < NCP; ++i) *(u32x4*)(smem + doff[i]) = cr[i];
    load_priv_a(item0); load_priv_b(item0);
    __syncthreads();
    for (int ch = 0; ch < 32; ++ch) {
        const unsigned char* lb = smem + (ch & 1) * C::BUFB;
        if (ch + 1 < 32) {
#pragma unroll
            for (int i = 0; i < NCP; ++i) cr[i] = *(const u32x4*)(cbase[i] + (item0 + ch + 1) * cstride[i] + soff[i]);
        }
        if (active) {
            bf16x8 Sb[NKS];
#pragma unroll
            for (int ks = 0; ks < NKS; ++ks) Sb[ks] = pack8(S[2 * ks], S[2 * ks + 1]);
            f32x4 X[4]; bf16x8 Xb[2];
            if (TYPE != 1) {
#pragma unroll
                for (int mt = 0; mt < 4; ++mt) X[mt] = (f32x4){0.f, 0.f, 0.f, 0.f};
#pragma unroll
                for (int ks = 0; ks < NKS; ++ks) {
                    bf16x8 fr[4];
#pragma unroll
                    for (int mt = 0; mt < 4; ++mt) fr[mt] = *(const bf16x8*)(lb + C::OFF_W + (mt * 16 + c) * SW + ks * 64 + 16 * q);
#pragma unroll
                    for (int mt = 0; mt < 4; ++mt) X[mt] = MFMA16(fr[mt], Sb[ks], X[mt]);
                }
#pragma unroll
                for (int mt = 0; mt < 4; ++mt) X[mt] = X[mt] + unpack4(ut[mt]);
                Xb[0] = pack8(X[0], X[1]); Xb[1] = pack8(X[2], X[3]);
            }
            {
                f32x4 O[4];
#pragma unroll
                for (int mt = 0; mt < 4; ++mt) O[mt] = (f32x4){0.f, 0.f, 0.f, 0.f};
#pragma unroll
                for (int ks = 0; ks < NKS; ++ks) {
                    bf16x8 fr[4];
#pragma unroll
                    for (int mt = 0; mt < 4; ++mt) fr[mt] = *(const bf16x8*)(lb + C::OFF_R + (mt * 16 + c) * SW + ks * 64 + 16 * q);
#pragma unroll
                    for (int mt = 0; mt < 4; ++mt) O[mt] = MFMA16(Sb[ks], fr[mt], O[mt]);
                }
                if (TYPE != 1) {
#pragma unroll
                    for (int k2 = 0; k2 < 2; ++k2) {
                        bf16x8 fr[4];
#pragma unroll
                        for (int mt = 0; mt < 4; ++mt) fr[mt] = *(const bf16x8*)(lb + C::OFF_M + (mt * 16 + c) * 144 + k2 * 64 + 16 * q);
#pragma unroll
                        for (int mt = 0; mt < 4; ++mt) O[mt] = MFMA16(Xb[k2], fr[mt], O[mt]);
                    }
                }
#pragma unroll
                for (int mt = 0; mt < 4; ++mt) {
                    O[mt] = O[mt] + unpack4(o1[mt]);
                    *(f32x4*)(oraw + (size_t)(s * 2048 + ch * 64 + mt * 16 + c) * 1536 + ocol) = O[mt];
                }
            }
            if (ch + 1 < 32) load_priv_a(item0 + ch + 1);
            bf16x8 Vb[2];
            if (TYPE == 0) {
                f32x4 Vn[4];
#pragma unroll
                for (int mt = 0; mt < 4; ++mt) Vn[mt] = unpack4(vtd[mt]) - X[mt];
                Vb[0] = pack8(Vn[0], Vn[1]); Vb[1] = pack8(Vn[2], Vn[3]);
            } else {
                Vb[0] = __builtin_bit_cast(bf16x8, vtb[0]); Vb[1] = __builtin_bit_cast(bf16x8, vtb[1]);
            }
#pragma unroll
            for (int dt = 0; dt < NDT; ++dt) { if (TYPE == 0) S[dt] = S[dt] * pcs; else S[dt] = S[dt] * pcv[dt & 3]; }
#pragma unroll
            for (int k2 = 0; k2 < 2; ++k2) {
#pragma unroll
                for (int d4 = 0; d4 < NDT; d4 += 4) {
                    bf16x8 fr[4];
#pragma unroll
                    for (int j = 0; j < 4; ++j) fr[j] = *(const bf16x8*)(lb + C::OFF_KT + ((d4 + j) * 16 + c) * 144 + k2 * 64 + 16 * q);
#pragma unroll
                    for (int j = 0; j < 4; ++j) S[d4 + j] = MFMA16(fr[j], Vb[k2], S[d4 + j]);
                    if (TYPE == 2) {
#pragma unroll
                        for (int j = 0; j < 4; ++j) fr[j] = *(const bf16x8*)(lb + C::OFF_BT + ((d4 + j) * 16 + c) * 144 + k2 * 64 + 16 * q);
#pragma unroll
                        for (int j = 0; j < 4; ++j) S[d4 + j] = MFMA16(fr[j], Xb[k2], S[d4 + j]);
                    }
                }
            }
            if (ch + 1 < 32) load_priv_b(item0 + ch + 1);
        }
        if (ch + 1 < 32) {
            unsigned char* nb = smem + ((ch + 1) & 1) * C::BUFB;
#pragma unroll
            for (int i = 0; i < NCP; ++i) *(u32x4*)(nb + doff[i]) = cr[i];
        }
        __syncthreads();
    }
    if (!active) return;
    if (TYPE == 2) {
        float* So = p->out + O_PRW + (size_t)((l * 8 + s) * 8 + h) * 4096;
#pragma unroll
        for (int dt = 0; dt < NDT; ++dt) *(f32x4*)(So + (slice * 16 + c) * 64 + dt * 16 + 4 * q) = S[dt];
    } else {
        float* So = p->out + (TYPE == 0 ? O_PDN + (size_t)((l * 8 + s) * 4 + h) * 16384 : O_PGLA + (size_t)((l * 8 + s) * 4 + h) * 8192);
#pragma unroll
        for (int dt = 0; dt < NDT; ++dt)
#pragma unroll
            for (int jj = 0; jj < 4; ++jj) So[(dt * 16 + 4 * q + jj) * 128 + slice * 16 + c] = S[dt][jj];
    }
}

DEVI void phase_scan(KP p_, int l, unsigned char* smem) {
    KP p = launder(p_);
    const int wid = tidx() >> 6, bid = bidx();
    if (bid < 160) {
        if (bid < 64) chunk_seq_block<0>(p, l, bid >> 3, (bid >> 1) & 3, bid & 1, smem);
        else if (bid < 96) chunk_seq_block<1>(p, l, (bid - 64) >> 2, bid & 3, 0, smem);
        else chunk_seq_block<2>(p, l, (bid - 96) >> 3, bid & 7, 0, smem);
    } else {
        float* wl = (float*)smem + wid * 512;
        for (int it = (bid - 160) * 8 + wid; it < 6144; it += (gdim() - 160) * 8) {
            if (it < 2048) dn_scan_item(p, l, 8 + (it >> 4), (it >> 2) & 3, it & 3, wl);
            else if (it < 4096) { const int i = it - 2048; gla_scan_item(p, l, 8 + (i >> 4), (i >> 2) & 3, i & 3, wl); }
            else { const int i = it - 4096; rw_scan_item(p, l, 8 + (i >> 4), (i >> 1) & 7, i & 1, wl); }
        }
    }
}

struct PostRow { f32x2 odn[4], ogl[4]; unsigned zdn[4], zgl[4]; float orw[8], bon[8]; unsigned zrw[8]; };
DEVI void post_load(KP p, int row, int lane, PostRow& R) {
    const float* orow = p->oraw + (size_t)row * 1536;
    const bf16_t* pr = p->proj + (size_t)row * LDP;
#pragma unroll
    for (int h = 0; h < 4; ++h) {
        R.odn[h] = *(const f32x2*)(orow + h * 128 + lane * 2); R.ogl[h] = *(const f32x2*)(orow + 512 + h * 128 + lane * 2);
        R.zdn[h] = *(const unsigned*)(pr + C_DNZ + h * 128 + lane * 2); R.zgl[h] = *(const unsigned*)(pr + C_GZ + h * 128 + lane * 2);
    }
#pragma unroll
    for (int h = 0; h < 8; ++h) { const int c = h * 64 + lane; R.orw[h] = orow[1024 + c]; R.bon[h] = p->rbonus[(size_t)row * 512 + c]; R.zrw[h] = pr[C_RZ + c]; }
}
DEVI void post_compute(KP p, int row, int lane, const PostRow& R, f32x2 gdn, f32x2 ggl, const float (&lnw)[8], const float (&lnb)[8]) {
    bf16_t* ob = p->obf + (size_t)row * 1536;
#pragma unroll
    for (int h = 0; h < 4; ++h) {
        {
            const f32x2 o = R.odn[h];
            const float rs = rsqrtf(wsum(o[0] * o[0] + o[1] * o[1]) * (1.f / 128.f) + 1e-6f);
            const float z0 = __uint_as_float(R.zdn[h] << 16), z1 = __uint_as_float(R.zdn[h] & 0xffff0000u);
            ushort2 w; w.x = f2bf(o[0] * rs * gdn[0] * siluf(z0)); w.y = f2bf(o[1] * rs * gdn[1] * siluf(z1));
            *(ushort2*)(ob + h * 128 + lane * 2) = w;
        }
        {
            const f32x2 o = R.ogl[h];
            const float rs = rsqrtf(wsum(o[0] * o[0] + o[1] * o[1]) * (1.f / 128.f) + 1e-6f);
            const float z0 = __uint_as_float(R.zgl[h] << 16), z1 = __uint_as_float(R.zgl[h] & 0xffff0000u);
            ushort2 w; w.x = f2bf(o[0] * rs * ggl[0] * siluf(z0)); w.y = f2bf(o[1] * rs * ggl[1] * siluf(z1));
            *(ushort2*)(ob + 512 + h * 128 + lane * 2) = w;
        }
    }
#pragma unroll
    for (int h = 0; h < 8; ++h) {
        const int c = h * 64 + lane;
        const float o = R.orw[h];
        const float mu = wsum(o) * (1.f / 64.f);
        const float d = o - mu;
        const float var = wsum(d * d) * (1.f / 64.f);
        float y = d * rsqrtf(var + 64e-5f) * lnw[h] + lnb[h];
        y += R.bon[h];
        y *= siluf(__uint_as_float(R.zrw[h] << 16));
        ob[1024 + c] = f2bf(y);
    }
}
DEVI void phase_post(KP p_, int l) {
    KP p = launder(p_);
    const int lane = tidx() & 63, wid = tidx() >> 6;
    const f32x2 gdn = *(const f32x2*)(p->dn_norm_g + l * 128 + lane * 2), ggl = *(const f32x2*)(p->gla_norm_g + l * 128 + lane * 2);
    float lnw[8], lnb[8];
#pragma unroll
    for (int h = 0; h < 8; ++h) { lnw[h] = p->rw_ln_w[l * 512 + h * 64 + lane]; lnb[h] = p->rw_ln_b[l * 512 + h * 64 + lane]; }
    const int stride = gdim() * 8;
    int row = bidx() * 8 + wid;
    PostRow A, B;
    post_load(p, row < NR ? row : NR - 1, lane, A);
    while (row < NR) {
        const int rowB = row + stride;
        post_load(p, rowB < NR ? rowB : NR - 1, lane, B);
        post_compute(p, row, lane, A, gdn, ggl, lnw, lnb);
        if (rowB >= NR) break;
        const int rowC = rowB + stride;
        post_load(p, rowC < NR ? rowC : NR - 1, lane, A);
        post_compute(p, rowB, lane, B, gdn, ggl, lnw, lnb);
        row = rowC;
    }
}

DEVI void phase_final(KP p_) {
    KP p = launder(p_);
    const int lane = tidx() & 63, wid = tidx() >> 6;
    for (int row = bidx() * 8 + wid; row < NR; row += gdim() * 8) {
        const float4* xr = (const float4*)(p->x + (size_t)row * 1024);
        float4 v[4], g[4]; float ss = 0.f;
#pragma unroll
        for (int i = 0; i < 4; ++i) { v[i] = xr[lane + i * 64]; g[i] = ((const float4*)p->final_g)[lane + i * 64]; }
#pragma unroll
        for (int i = 0; i < 4; ++i) ss += v[i].x * v[i].x + v[i].y * v[i].y + v[i].z * v[i].z + v[i].w * v[i].w;
        ss = wsum(ss);
        const float rstd = rsqrtf(ss * (1.f / 1024.f) + 1e-6f);
        float4* yo = (float4*)(p->out + (size_t)row * 1024);
#pragma unroll
        for (int i = 0; i < 4; ++i)
            yo[lane + i * 64] = make_float4(v[i].x * rstd * g[i].x, v[i].y * rstd * g[i].y, v[i].z * rstd * g[i].z, v[i].w * rstd * g[i].w);
    }
}

constexpr int SMEM_BYTES = PP_BYTES;
#define XB_TMO      128
#define XB_XCNT(j)  (256  + 64 * (j))
#define XB_XSUB(j)  (1280 + 64 * (j))
#define XB_XGEN(j)  (2304 + 64 * (j))
#define XB_TOP      3328
#define XB_TOPGEN   3392
#define XCD_BAR_WORDS 3456
#define XB_SPIN_CAP (1u << 18)
#ifndef LAS
#define LAS __attribute__((address_space(3)))
#endif

__device__ __forceinline__ unsigned xb_ld(unsigned* p)              { return __hip_atomic_load(p, __ATOMIC_RELAXED, __HIP_MEMORY_SCOPE_AGENT); }
__device__ __forceinline__ unsigned xb_add(unsigned* p, unsigned v) { return __hip_atomic_fetch_add(p, v, __ATOMIC_RELAXED, __HIP_MEMORY_SCOPE_AGENT); }
__device__ __forceinline__ unsigned xb_xcc_id() { return (unsigned)__builtin_amdgcn_s_getreg((3 << 11) | 20) & 0xFu; }
#define XB_SPIN(cond, bar) do { unsigned _sp = 0; while (cond) { __builtin_amdgcn_s_sleep(1); \
    if ((++_sp & 255u) == 0u) { if (xb_ld(&(bar)[XB_TMO])) break; if (_sp > XB_SPIN_CAP) { atomicAdd(&(bar)[XB_TMO], 1u); break; } } } } while (0)

struct XcdBarrier {
    unsigned* bar; unsigned x;
    volatile LAS unsigned* st;
};

__device__ __forceinline__ XcdBarrier xcd_barrier_post(unsigned* bar, volatile LAS unsigned* st) {
    XcdBarrier b; b.bar = bar; b.x = xb_xcc_id(); b.st = st;
    if (threadIdx.x == 0) (void)xb_add(&bar[XB_XCNT(b.x)], 1u);
    return b;
}
__device__ __forceinline__ void xcd_barrier_complete(unsigned* bar, unsigned x, unsigned& nloc, unsigned& nx) {
    const unsigned G = gridDim.x * gridDim.y * gridDim.z;
    unsigned sum, cnt, mine, sp = 0u;
    for (;;) {
        sum = 0u; cnt = 0u; mine = 0u;
#pragma unroll
        for (unsigned j = 0; j < 16; ++j) { const unsigned c = xb_ld(&bar[XB_XCNT(j)]); sum += c; cnt += (c > 0u) ? 1u : 0u; mine = (j == x) ? c : mine; }
        if (sum == G) break;
        __builtin_amdgcn_s_sleep(1);
        if ((++sp & 255u) == 0u) { if (xb_ld(&bar[XB_TMO])) break; if (sp > XB_SPIN_CAP) { atomicAdd(&bar[XB_TMO], 1u); break; } }
    }
    nloc = mine > 0u ? mine : 1u; nx = cnt > 0u ? cnt : 1u;
}

__device__ __forceinline__ void xcd_barrier(const XcdBarrier& b) {
    asm volatile("s_waitcnt vmcnt(0)" ::: "memory");
    __syncthreads();
    if (threadIdx.x == 0) {
        unsigned* bar = b.bar;
        __builtin_amdgcn_s_waitcnt(0);
        unsigned nloc = b.st[0], nx = b.st[1];
        if (nloc == 0u) { xcd_barrier_complete(bar, b.x, nloc, nx); b.st[0] = nloc; b.st[1] = nx; }
        const unsigned old = xb_add(&bar[XB_XSUB(b.x)], 1u);
        const unsigned gen = old / nloc;
        if (old + 1u == (gen + 1u) * nloc) {
            __builtin_amdgcn_fence(__ATOMIC_RELEASE, "agent");
            asm volatile("s_waitcnt vmcnt(0)" ::: "memory");
            const unsigned og = xb_add(&bar[XB_TOP], 1u);
            const unsigned tg = og / nx;
            if (og + 1u == (tg + 1u) * nx) xb_add(&bar[XB_TOPGEN], 1u);
            else XB_SPIN(xb_ld(&bar[XB_TOPGEN]) == tg, bar);
            __builtin_amdgcn_fence(__ATOMIC_ACQUIRE, "agent");
            xb_add(&bar[XB_XGEN(b.x)], 1u);
            asm volatile("s_waitcnt vmcnt(0)" ::: "memory");
        } else {
            XB_SPIN(xb_ld(&bar[XB_XGEN(b.x)]) == gen, bar);
            __builtin_amdgcn_fence(__ATOMIC_ACQUIRE, "agent");
            asm volatile("s_waitcnt vmcnt(0)" ::: "memory");
        }
    }
    __syncthreads();
}


DEVI void run_sub(KP p, int l, int sub, unsigned char* smem) {
    if (sub == 0) phase_norm(p, l);
    else if (sub == 1) {
        KP q = launder(p);
        {
            pg8::Gemm g{q->h, q->WinT + (size_t)l * LDP * 1024, NPR, LDP, 1024}; pg8::StaticOrder S; S.init(NPR, LDP, gdim(), bidx());
            EpiProjPG E{q->proj};
            pg8::gemm_phase<EpiProjPG, pg8::StaticOrder, false>((PG8_LAS unsigned char*)smem, g, S, E, nullptr);
        }
        __syncthreads();
        EpiProj e{q->proj}; gemm_phase(smem, q->h, 1024, q->WinT + (size_t)l * LDP * 1024, 1024, 1, LDP / G_BN, 1024, e, 192, 64);
    }
    else if (sub == 2) { phase_prepass(p, l, smem); phase_prep(p, l, smem); }
    else if (sub == 3) phase_scan(p, l, smem);
    else if (sub == 4) phase_post(p, l);
    else {
        KP q = launder(p);
        {
            pg8::Gemm g{q->obf, q->WoutT + (size_t)l * 1024 * 1536, NPR, 1024, 1536}; pg8::StaticOrder S; S.init(NPR, 1024, gdim(), bidx());
            EpiOutPG E{q->x, l == 0 ? q->x_prompt : q->x, q->mod + (size_t)l * NSEQ * 3072};
            pg8::gemm_phase<EpiOutPG, pg8::StaticOrder, false>((PG8_LAS unsigned char*)smem, g, S, E, nullptr);
        }
        out_gemm_sample(p, l);
    }
}
template <bool kCoop>
__global__ void __launch_bounds__(NT) fwd_kernel(Params p_arg) {
    KP p = (KP)__builtin_amdgcn_kernarg_segment_ptr();
    __shared__ __attribute__((aligned(16))) unsigned char smem[SMEM_BYTES];
    if (kCoop) {
        cg::grid_group grid = cg::this_grid();
        volatile LAS unsigned* xbst = (volatile LAS unsigned*)(LAS unsigned char*)(smem + SMEM_BYTES - 16);
        if (threadIdx.x < 4) xbst[threadIdx.x] = 0u;
        __syncthreads();
        const XcdBarrier xb = xcd_barrier_post(launder(p)->bar, xbst);
        phase_setup(p, smem);
        xcd_barrier(xb);
        if (launder(p)->p0 == 0x7fffffff) grid.sync();
#pragma unroll 1
        for (int l = 0; l < 2; ++l) {
            phase_norm(p, l); xcd_barrier(xb);
            for (int rep = 0; rep < REP_GEMM; ++rep) { run_sub(p, l, 1, smem); xcd_barrier(xb); }
            for (int rep = 0; rep < REP_PRE; ++rep) { phase_prepass(p, l, smem); phase_prep(p, l, smem); xcd_barrier(xb); }
            for (int rep = 0; rep < REP_SCAN; ++rep) { phase_scan(p, l, smem); xcd_barrier(xb); }
            phase_post(p, l); xcd_barrier(xb);
            run_sub(p, l, 5, smem); xcd_barrier(xb);
        }
        phase_final(p);
    } else {
        const int ph = launder(p)->p0;
        if (ph == 0) phase_setup(p, smem);
        else if (ph == 13) phase_final(p);
        else run_sub(p, (ph - 1) / 6, (ph - 1) % 6, smem);
    }
}

extern "C" void kernel_launch(void* const* d_in, const int* in_sizes, int n_in, void* d_out, int out_size, void* d_ws, size_t ws_size, hipStream_t stream) {
    Params hp{};
    const float** pf = (const float**)&hp;
    for (int i = 0; i < 32; ++i) pf[i] = (const float*)d_in[i];
    hp.out = (float*)d_out;
    char* w = (char*)d_ws;
    auto take = [&](size_t bytes) { char* r = w; w += (bytes + 255) & ~(size_t)255; return r; };
    hp.WinT = (bf16_t*)take((size_t)2 * LDP * 1024 * 2);
    hp.WoutT = (bf16_t*)take((size_t)2 * 1024 * 1536 * 2);
    hp.h = (bf16_t*)take((size_t)NRP * 1024 * 2);
    hp.proj = (bf16_t*)take((size_t)NRP * LDP * 2);
    hp.obf = (bf16_t*)take((size_t)NRP * 1536 * 2);
    hp.mod = (float*)take((size_t)2 * NSEQ * 3072 * 4);
    hp.x = (float*)d_out;
    const size_t soff = (size_t)NPR;
    hp.dnq = (float*)take((size_t)128 * 512 * 4) - soff * 512;
    hp.dnk = (float*)take((size_t)128 * 512 * 4) - soff * 512;
    hp.dnv = (float*)take((size_t)128 * 512 * 4) - soff * 512;
    hp.dnbeta = (float*)take((size_t)128 * 4 * 4) - soff * 4;
    hp.dna = (float*)take((size_t)128 * 4 * 4) - soff * 4;
    hp.glf = (float*)take((size_t)128 * 256 * 4) - soff * 256;
    hp.rr = (float*)take((size_t)128 * 512 * 4) - soff * 512;
    hp.rk = (float*)take((size_t)128 * 512 * 4) - soff * 512;
    hp.rv = (float*)take((size_t)128 * 512 * 4) - soff * 512;
    hp.rw = (float*)take((size_t)128 * 512 * 4) - soff * 512;
    hp.rkk = (float*)take((size_t)128 * 512 * 4) - soff * 512;
    hp.rb = (float*)take((size_t)128 * 512 * 4) - soff * 512;
    hp.rbonus = (float*)take((size_t)NR * 512 * 4);
    hp.oraw = (float*)take((size_t)NR * 1536 * 4);
    hp.dnW = (bf16_t*)take((size_t)1024 * 8192 * 2); hp.dnR = (bf16_t*)take((size_t)1024 * 8192 * 2); hp.dnKT = (bf16_t*)take((size_t)1024 * 8192 * 2);
    hp.dnM = (bf16_t*)take((size_t)1024 * 4096 * 2); hp.dnUT = (bf16_t*)take((size_t)1024 * 8192 * 2); hp.dnO1 = (bf16_t*)take((size_t)1024 * 8192 * 2);
    hp.dnVT = (bf16_t*)take((size_t)1024 * 8192 * 2);
    hp.rwW = (bf16_t*)take((size_t)2048 * 4096 * 2); hp.rwR = (bf16_t*)take((size_t)2048 * 4096 * 2); hp.rwKT = (bf16_t*)take((size_t)2048 * 4096 * 2);
    hp.rwBT = (bf16_t*)take((size_t)2048 * 4096 * 2); hp.rwM = (bf16_t*)take((size_t)2048 * 4096 * 2); hp.rwUT = (bf16_t*)take((size_t)2048 * 4096 * 2);
    hp.rwO1 = (bf16_t*)take((size_t)2048 * 4096 * 2); hp.rwVT = (bf16_t*)take((size_t)2048 * 4096 * 2);
    hp.glR = (bf16_t*)take((size_t)1024 * 4096 * 2); hp.glKT = (bf16_t*)take((size_t)1024 * 4096 * 2);
    hp.glO1 = (bf16_t*)take((size_t)1024 * 8192 * 2); hp.glVT = (bf16_t*)take((size_t)1024 * 8192 * 2);
    hp.dnpc = (float*)take((size_t)1024 * 128 * 4); hp.dnav = (float*)take((size_t)1024 * 64 * 4);
    hp.rwpc = (float*)take((size_t)2048 * 64 * 4); hp.glpc = (float*)take((size_t)1024 * 64 * 4);
    hp.bar = (unsigned*)take((size_t)XCD_BAR_WORDS * 4);
    if ((size_t)(w - (char*)d_ws) > ws_size) fprintf(stderr, "workspace too small: need %zu have %zu\n", (size_t)(w - (char*)d_ws), ws_size);
    static int grid_blocks = 0;
    if (!grid_blocks) {
        int dev = 0, cus = 0, per_cu = 0;
        hipGetDevice(&dev);
        hipDeviceGetAttribute(&cus, hipDeviceAttributeMultiprocessorCount, dev);
        hipOccupancyMaxActiveBlocksPerMultiprocessor(&per_cu, fwd_kernel<COOP != 0>, NT, 0);
        if (per_cu < 1) fprintf(stderr, "occupancy query returned %d\n", per_cu);
        grid_blocks = cus;
    }
#if COOP
    hp.p0 = 0; hp.p1 = 14;
    hipMemsetAsync(hp.bar, 0, (size_t)XCD_BAR_WORDS * 4, stream);
    void* args[] = {&hp};
    hipError_t e = hipLaunchCooperativeKernel((void*)fwd_kernel<true>, dim3(grid_blocks), dim3(NT), args, 0, stream);
    if (e != hipSuccess) fprintf(stderr, "cooperative launch failed: %s (grid %d)\n", hipGetErrorString(e), grid_blocks);
#else
    for (int ph = 0; ph < 14; ++ph) {
        hp.p0 = ph; hp.p1 = ph + 1;
        fwd_kernel<false><<<grid_blocks, NT, 0, stream>>>(hp);
    }
#endif
}
```

```cpp
#include <hip/hip_runtime.h>
#include <hip/hip_cooperative_groups.h>
#include <cstdio>
namespace cg = cooperative_groups;

#ifndef REP_PRE
#define REP_PRE 1
#endif
#ifndef REP_SCAN
#define REP_SCAN 1
#endif
#ifndef REP_GEMM
#define REP_GEMM 1
#endif
#ifndef COOP
#define COOP 1
#endif

#define DEVI __device__ __forceinline__
typedef unsigned short bf16_t;
typedef short bf16x8 __attribute__((ext_vector_type(8)));
typedef float f32x4 __attribute__((ext_vector_type(4)));

constexpr int NT = 512;
constexpr int DM = 1024;
constexpr int NPR = 16384;
constexpr int NR = 16512;
constexpr int NRP = 16640;
constexpr int LDP = 5888;
constexpr int DPROJ = 5784;
constexpr int NSEQ = 136;
constexpr int C_DNQ = 0, C_DNK = 512, C_DNV = 1024, C_DNZ = 1536, C_DNB = 2048, C_DNA = 2052;
constexpr int C_GQ = 2056, C_GK = 2312, C_GV = 2568, C_GZ = 3080, C_GLO = 3592;
constexpr int C_RX = 3608, C_RZ = 5272;
constexpr size_t O_YP = 0;
constexpr size_t O_YS = O_YP + (size_t)16384 * 1024;
constexpr size_t O_PCONV = O_YS + (size_t)128 * 1024;
constexpr size_t O_PDN = O_PCONV + (size_t)2 * 8 * 3 * 1536;
constexpr size_t O_PGLA = O_PDN + (size_t)2 * 8 * 4 * 128 * 128;
constexpr size_t O_PRS = O_PGLA + (size_t)2 * 8 * 4 * 64 * 128;
constexpr size_t O_PRW = O_PRS + (size_t)2 * 8 * 1664;
constexpr size_t O_SCONV = O_PRW + (size_t)2 * 8 * 8 * 64 * 64;
constexpr size_t O_SDN = O_SCONV + (size_t)2 * 128 * 3 * 1536;
constexpr size_t O_SGLA = O_SDN + (size_t)2 * 128 * 4 * 128 * 128;
constexpr size_t O_SRS = O_SGLA + (size_t)2 * 128 * 4 * 64 * 128;
constexpr size_t O_SRW = O_SRS + (size_t)2 * 128 * 1664;

struct Params {
    const float *x_prompt, *x_sample, *c_prompt, *c_sample, *st_conv, *st_dn, *st_gla, *st_rs, *st_rw;
    const float *norm_g, *ada_w, *ada_b, *w_in, *conv_w, *a_log, *dt_bias, *dn_norm_g, *gla_wf, *gla_bf, *gla_norm_g;
    const float *rw_mu, *rw_w0, *rw_w2, *rw_a0, *rw_a2, *rw_k_k, *rw_k_a, *rw_r_k, *rw_ln_w, *rw_ln_b, *w_out, *final_g;
    float* out;
    bf16_t *WinT, *WoutT, *h, *proj, *obf;
    float *mod, *x, *dnq, *dnk, *dnv, *dnbeta, *dna, *glf, *rr, *rk, *rv, *rw, *rkk, *rb, *rbonus, *oraw;
    bf16_t *dnW, *dnR, *dnKT, *dnM, *dnUT, *dnO1, *dnVT, *rwW, *rwR, *rwKT, *rwBT, *rwM, *rwUT, *rwO1, *rwVT, *glR, *glKT, *glO1, *glVT;
    float *dnpc, *dnav, *rwpc, *glpc;
    unsigned* bar;
    int p0, p1;
};

typedef const __attribute__((address_space(4))) Params* KP;
DEVI KP launder(KP q) { asm volatile("" : "+s"(q)); return q; }
DEVI int tidx() { int v = threadIdx.x; asm volatile("" : "+v"(v)); return v; }
DEVI int bidx() { int v = blockIdx.x; asm volatile("" : "+s"(v)); return v; }
DEVI int gdim() { int v = gridDim.x; asm volatile("" : "+s"(v)); return v; }
DEVI bf16_t f2bf(float f) { unsigned u = __float_as_uint(f); u += 0x7fffu + ((u >> 16) & 1u); return (bf16_t)(u >> 16); }
DEVI float bf2f(bf16_t b) { return __uint_as_float(((unsigned)b) << 16); }
template <int CTRL> DEVI float dppf(float v) { return __int_as_float(__builtin_amdgcn_update_dpp(0, __float_as_int(v), CTRL, 0xF, 0xF, true)); }
DEVI float rdlane(float v, int l) { return __int_as_float(__builtin_amdgcn_readlane(__float_as_int(v), l)); }
DEVI float wsum(float v) {
    v += dppf<0xB1>(v);
    v += dppf<0x4E>(v);
    v += dppf<0x141>(v);
    v += dppf<0x140>(v);
    return (rdlane(v, 0) + rdlane(v, 16)) + (rdlane(v, 32) + rdlane(v, 48));
}
DEVI float fexp(float x) { return __expf(x); }
DEVI float frcp(float x) { return __builtin_amdgcn_rcpf(x); }
DEVI float siluf(float x) { return x * frcp(1.f + fexp(-x)); }
DEVI float sigmf(float x) { return frcp(1.f + fexp(-x)); }
DEVI float softplusf(float x) { return x > 20.f ? x : __logf(1.f + fexp(x)); }
DEVI float ftanh(float x) { return 1.f - 2.f * frcp(1.f + fexp(2.f * x)); }
DEVI void wave_sync() {
    __builtin_amdgcn_fence(__ATOMIC_RELEASE, "wavefront");
    __builtin_amdgcn_wave_barrier();
    __builtin_amdgcn_fence(__ATOMIC_ACQUIRE, "wavefront");
}
DEVI int mod_row(int row) { return row < NPR ? (row >> 11) : (8 + row - NPR); }

typedef float f32x2 __attribute__((ext_vector_type(2)));
typedef __bf16 bf16x2_t __attribute__((ext_vector_type(2)));
typedef unsigned u32x2 __attribute__((ext_vector_type(2)));
typedef unsigned u32x4 __attribute__((ext_vector_type(4)));
DEVI unsigned pk2(float a, float b) { f32x2 v = {a, b}; bf16x2_t r = __builtin_convertvector(v, bf16x2_t); return __builtin_bit_cast(unsigned, r); }
#define MFMA16(a, b, c) __builtin_amdgcn_mfma_f32_16x16x32_bf16((a), (b), (c), 0, 0, 0)
DEVI void transpose_tile4(const float* src, bf16_t* dst, int K, int N, int k0, int n0, float* tl) {
    const int tid = tidx();
    float v[4][8];
#pragma unroll
    for (int t = 0; t < 4; ++t)
#pragma unroll
        for (int i = 0; i < 8; ++i) {
            const int kk = (tid >> 6) + i * 8, nn = n0 + t * 64 + (tid & 63);
            v[t][i] = nn < N ? src[(size_t)(k0 + kk) * N + nn] : 0.f;
        }
#pragma unroll
    for (int t = 0; t < 4; ++t)
#pragma unroll
        for (int i = 0; i < 8; ++i) tl[t * 4160 + ((tid >> 6) + i * 8) * 65 + (tid & 63)] = v[t][i];
    __syncthreads();
#pragma unroll
    for (int t = 0; t < 4; ++t)
#pragma unroll
        for (int i = 0; i < 4; ++i) {
            const int nn = (tid >> 5) + i * 16, kk = (tid & 31) * 2;
            *(unsigned*)(dst + (size_t)(n0 + t * 64 + nn) * K + k0 + kk) = pk2(tl[t * 4160 + kk * 65 + nn], tl[t * 4160 + (kk + 1) * 65 + nn]);
        }
    __syncthreads();
}

DEVI void phase_setup(KP p_, unsigned char* smem) {
    KP p = launder(p_);
    const int tid = tidx();
    float* tl = (float*)smem;
    for (int it = bidx(); it < 2 * 16 * 23; it += gdim()) {
        int l = it / (16 * 23), r = it % (16 * 23), kt = r / 23, ng = r % 23;
        transpose_tile4(p->w_in + (size_t)l * 1024 * DPROJ, p->WinT + (size_t)l * LDP * 1024, 1024, DPROJ, kt * 64, ng * 256, tl);
    }
    for (int it = bidx(); it < 2 * 24 * 4; it += gdim()) {
        int l = it / (24 * 4), r = it % (24 * 4), kt = r / 4, ng = r % 4;
        transpose_tile4(p->w_out + (size_t)l * 1536 * 1024, p->WoutT + (size_t)l * 1024 * 1536, 1536, 1024, kt * 64, ng * 256, tl);
    }
    {
        for (size_t i = (size_t)bidx() * NT + tid; i < (size_t)(NRP - NR) * 1024; i += (size_t)gdim() * NT) p->h[(size_t)NR * 1024 + i] = 0;
        for (size_t i = (size_t)bidx() * NT + tid; i < (size_t)(NRP - NR) * 1536; i += (size_t)gdim() * NT) p->obf[(size_t)NR * 1536 + i] = 0;
    }
    float* sc = (float*)smem;
    for (int it = bidx(); it < 2 * 6 * 17; it += gdim()) {
        int l = it / 102, r = it % 102, jt = r / 17, rg = r % 17;
        for (int idx = tid; idx < 8192; idx += NT) {
            int rr = idx >> 10, k = idx & 1023, mb = rg * 8 + rr;
            float c = mb < 8 ? p->c_prompt[mb * 1024 + k] : p->c_sample[(mb - 8) * 1024 + k];
            sc[k * 8 + rr] = siluf(c);
        }
        __syncthreads();
        const int col = jt * 512 + tid;
        f32x2 acc2[4];
#pragma unroll
        for (int i = 0; i < 4; ++i) acc2[i] = (f32x2){0.f, 0.f};
        const float* aw = p->ada_w + (size_t)l * 1024 * 3072 + col;
#pragma unroll 16
        for (int k = 0; k < 1024; ++k) {
            const float a = aw[(size_t)k * 3072];
            const f32x2 av = {a, a};
            const f32x4 s0 = ((const f32x4*)sc)[k * 2], s1 = ((const f32x4*)sc)[k * 2 + 1];
            acc2[0] = __builtin_elementwise_fma((f32x2){s0[0], s0[1]}, av, acc2[0]); acc2[1] = __builtin_elementwise_fma((f32x2){s0[2], s0[3]}, av, acc2[1]);
            acc2[2] = __builtin_elementwise_fma((f32x2){s1[0], s1[1]}, av, acc2[2]); acc2[3] = __builtin_elementwise_fma((f32x2){s1[2], s1[3]}, av, acc2[3]);
        }
        float bb = p->ada_b[l * 3072 + col];
#pragma unroll
        for (int i = 0; i < 8; ++i) p->mod[((size_t)l * NSEQ + rg * 8 + i) * 3072 + col] = acc2[i >> 1][i & 1] + bb;
        __syncthreads();
    }
}

DEVI void phase_norm(KP p_, int l) {
    KP p = launder(p_);
    const int lane = tidx() & 63, wid = tidx() >> 6;
    for (int row = bidx() * 8 + wid; row < NR; row += gdim() * 8) {
        const float4* xr = l == 0 ? (row < NPR ? (const float4*)(p->x_prompt + (size_t)row * 1024) : (const float4*)(p->x_sample + (size_t)(row - NPR) * 1024))
                                  : (const float4*)(p->x + (size_t)row * 1024);
        const float* md = p->mod + ((size_t)l * NSEQ + mod_row(row)) * 3072;
        float4 v[4], g[4], sh[4], sc[4];
#pragma unroll
        for (int i = 0; i < 4; ++i) {
            const int c = (lane + i * 64) * 4;
            v[i] = xr[lane + i * 64]; g[i] = *(const float4*)(p->norm_g + l * 1024 + c); sh[i] = *(const float4*)(md + c); sc[i] = *(const float4*)(md + 1024 + c);
        }
        float ss = 0.f;
#pragma unroll
        for (int i = 0; i < 4; ++i) ss += v[i].x * v[i].x + v[i].y * v[i].y + v[i].z * v[i].z + v[i].w * v[i].w;
        ss = wsum(ss);
        const float rstd = rsqrtf(ss * (1.f / 1024.f) + 1e-6f);
#pragma unroll
        for (int i = 0; i < 4; ++i) {
            const int c = (lane + i * 64) * 4;
            ushort4 o;
            o.x = f2bf(v[i].x * rstd * g[i].x * (1.f + sc[i].x) + sh[i].x);
            o.y = f2bf(v[i].y * rstd * g[i].y * (1.f + sc[i].y) + sh[i].y);
            o.z = f2bf(v[i].z * rstd * g[i].z * (1.f + sc[i].z) + sh[i].z);
            o.w = f2bf(v[i].w * rstd * g[i].w * (1.f + sc[i].w) + sh[i].w);
            *(ushort4*)(p->h + (size_t)row * 1024 + c) = o;
        }
    }
}

constexpr int G_BM = 256, G_BN = 128, G_BK = 64, G_LDS = 72;
template <class Epi>
DEVI void gemm_phase(unsigned char* smem, const bf16_t* A, int lda, const bf16_t* Bt, int ldb, int Mtiles, int Ntiles, int K, const Epi& epi, int first_block, int mt0) {
    bf16_t* As = (bf16_t*)smem;
    bf16_t* Bs = As + G_BM * G_LDS;
    const int tid = tidx(), lane = tid & 63, wid = tid >> 6, wm = wid >> 1, wn = wid & 1;
    const int fr = lane & 15, fq = lane >> 4;
    const int nk = K / G_BK;
    for (int t = bidx() - first_block; t < Mtiles * Ntiles; t += gdim()) {
        if (t < 0) continue;
        const int mt = mt0 + t / Ntiles, nt = t % Ntiles;
        const bf16_t* Ag = A + (size_t)mt * G_BM * lda;
        const bf16_t* Bg = Bt + (size_t)nt * G_BN * ldb;
        f32x4 acc[4][4];
#pragma unroll
        for (int i = 0; i < 4; ++i)
#pragma unroll
            for (int j = 0; j < 4; ++j) acc[i][j] = (f32x4){0.f, 0.f, 0.f, 0.f};
        const int sr = tid >> 3, scol = (tid & 7) * 8;
        const bf16_t* Ap = Ag + (size_t)sr * lda + scol;
        const bf16_t* Bp = Bg + (size_t)sr * ldb + scol;
        uint4 ra0 = *(const uint4*)(Ap), ra1 = *(const uint4*)(Ap + (size_t)64 * lda), ra2 = *(const uint4*)(Ap + (size_t)128 * lda), ra3 = *(const uint4*)(Ap + (size_t)192 * lda);
        uint4 rb0 = *(const uint4*)(Bp), rb1 = *(const uint4*)(Bp + (size_t)64 * ldb);
        for (int kt = 0; kt < nk; ++kt) {
            *(uint4*)(As + sr * G_LDS + scol) = ra0; *(uint4*)(As + (sr + 64) * G_LDS + scol) = ra1;
            *(uint4*)(As + (sr + 128) * G_LDS + scol) = ra2; *(uint4*)(As + (sr + 192) * G_LDS + scol) = ra3;
            *(uint4*)(Bs + sr * G_LDS + scol) = rb0; *(uint4*)(Bs + (sr + 64) * G_LDS + scol) = rb1;
            __syncthreads();
            if (kt + 1 < nk) {
                const int k0 = (kt + 1) * G_BK;
                ra0 = *(const uint4*)(Ap + k0); ra1 = *(const uint4*)(Ap + (size_t)64 * lda + k0); ra2 = *(const uint4*)(Ap + (size_t)128 * lda + k0); ra3 = *(const uint4*)(Ap + (size_t)192 * lda + k0);
                rb0 = *(const uint4*)(Bp + k0); rb1 = *(const uint4*)(Bp + (size_t)64 * ldb + k0);
            }
#pragma unroll
            for (int ks = 0; ks < 2; ++ks) {
                bf16x8 af[4], bfr[4];
#pragma unroll
                for (int i = 0; i < 4; ++i) af[i] = *(const bf16x8*)(As + (wm * 64 + i * 16 + fr) * G_LDS + ks * 32 + fq * 8);
#pragma unroll
                for (int j = 0; j < 4; ++j) bfr[j] = *(const bf16x8*)(Bs + (wn * 64 + j * 16 + fr) * G_LDS + ks * 32 + fq * 8);
#pragma unroll
                for (int i = 0; i < 4; ++i)
#pragma unroll
                    for (int j = 0; j < 4; ++j) acc[i][j] = __builtin_amdgcn_mfma_f32_16x16x32_bf16(bfr[j], af[i], acc[i][j], 0, 0, 0);
            }
            __syncthreads();
        }
#pragma unroll
        for (int i = 0; i < 4; ++i)
#pragma unroll
            for (int j = 0; j < 4; ++j) epi(mt * G_BM + wm * 64 + i * 16 + fr, nt * G_BN + wn * 64 + j * 16 + fq * 4, acc[i][j]);
    }
}
struct EpiProj {
    bf16_t* proj;
    DEVI void operator()(int m, int n, f32x4 v) const {
        ushort4 o; o.x = f2bf(v[0]); o.y = f2bf(v[1]); o.z = f2bf(v[2]); o.w = f2bf(v[3]);
        *(ushort4*)(proj + (size_t)m * LDP + n) = o;
    }
};
struct EpiOut {
    float* x; const float* mod;
    DEVI void operator()(int m, int n, f32x4 v) const {
        if (m >= NR) return;
        const float4 g = *(const float4*)(mod + (size_t)mod_row(m) * 3072 + 2048 + n);
        float4* xp = (float4*)(x + (size_t)m * 1024 + n);
        float4 xv = *xp;
        xv.x += g.x * v[0]; xv.y += g.y * v[1]; xv.z += g.z * v[2]; xv.w += g.w * v[3];
        *xp = xv;
    }
};

namespace pg8 {
#define PG8_LAS __attribute__((address_space(3)))
typedef unsigned short bf16_t;
typedef short bf16x8 __attribute__((ext_vector_type(8)));
typedef float f32x4 __attribute__((ext_vector_type(4)));
typedef unsigned u32x4 __attribute__((ext_vector_type(4)));
constexpr int BM = 256, BK = 64, HALF = 128, HTB = HALF * BK * 2  , STAGE_BYTES = 8 * HTB, NXCD = 8, WGM = 8;

__host__ __device__ __forceinline__ int lds_byte(int r, int c) { const int st = (r >> 4) * 2 + (c >> 5), rr = r & 15, cc = c & 31, ob = rr * 64 + cc * 2; return st * 1024 + (ob ^ (((ob >> 9) & 1) << 5)); }
__host__ __device__ __forceinline__ void stage_rc(int b, int& R, int& C) { const int st = b / 1024, sb = b % 1024, swz = sb ^ (((sb >> 9) & 1) << 5); R = (st >> 1) * 16 + swz / 64; C = (st & 1) * 32 + (swz % 64) / 2; }
__host__ __device__ __forceinline__ int perm32(int rho) { const int n = rho >> 4, i = rho & 15; return 8 * (i >> 2) + 4 * n + (i & 3); }

struct Unit { int pm, pn; };
struct Gemm { const bf16_t* A; const bf16_t* Bt; int M, N, K; };

struct StaticOrder {
    int nM, nN, nwg, G, c;
    __host__ __device__ void init(int M, int N, int G_, int c_) { nM = M / BM; nN = N / BM; nwg = nM * nN; G = G_; c = c_; }
    __host__ __device__ bool next(int i, Unit& u) const {
        const long L = (long)i * G + c; if (L >= nwg) return false;
        int wgid = (int)L; { const int q = nwg / NXCD, r = nwg % NXCD, xcd = wgid % NXCD, off = wgid / NXCD; wgid = (xcd < r ? xcd * (q + 1) : r * (q + 1) + (xcd - r) * q) + off; }
        const int nig = WGM * nN, gid = wgid / nig, fm = gid * WGM, gsz = (nM - fm) < WGM ? (nM - fm) : WGM;
        u.pm = fm + ((wgid % nig) % gsz); u.pn = (wgid % nig) / gsz; return true;
    }
    __device__ __forceinline__ void a_ready(const Unit&) const {}
    __device__ __forceinline__ void done(const Unit&) const {}
};
template <class Epi, class Sched, bool STAMP = false>
__device__ __forceinline__ void gemm_phase(PG8_LAS unsigned char* lds, const Gemm g, const Sched& S, const Epi& E, unsigned long long* stamps) {
    const int tid = tidx(), wid = __builtin_amdgcn_readfirstlane(tid >> 6), lane = tid & 63, wr = wid >> 2, wc = wid & 3, fr = lane & 15, fq = lane >> 4;
    const int K = g.K, nt = K / BK;
    int ts_lo = 0, ts_hi = 0, nts = 0; const unsigned long long rt_entry = STAMP ? (unsigned long long)wall_clock64() : 0ull;
#define PG8_STAMP() do { if (STAMP && wid == 0 && nts < 64) { const unsigned long long _c = (unsigned long long)clock64(); \
        ts_lo = (lane == nts) ? (int)(unsigned)_c : ts_lo; ts_hi = (lane == nts) ? (int)(unsigned)(_c >> 32) : ts_hi; ++nts; } } while (0)
    PG8_STAMP();
    unsigned voffA[2], voffB[2];
#pragma unroll
    for (int i = 0; i < 2; ++i) { int R, C; stage_rc(tid * 16 + i * 8192, R, C); const int Rb = Epi::PERM ? ((R & ~31) + perm32(R & 31)) : R;
        voffA[i] = (unsigned)(R * K + C) * 2u; voffB[i] = (unsigned)(Rb * K + C) * 2u; }
    const size_t kstep = (size_t)(BK * 2);
    const size_t hstep = (size_t)HALF * K * 2;
    const size_t tstep = 2 * hstep;
    const unsigned ldsw = (unsigned)wid * 1024u;
    const int aoff = lds_byte(wr * 64 + fr, fq * 8), boff = lds_byte(wc * 32 + fr, fq * 8);
#define PG8_SA(b, h) (((b) * 2 + (h)) * HTB)
#define PG8_SB(b, h) ((4 + (b) * 2 + (h)) * HTB)
#define PG8_STAGE(bufoff, gbase, voff) do { _Pragma("unroll") for (int _i = 0; _i < 2; ++_i) \
        __builtin_amdgcn_global_load_lds((const unsigned*)((const char*)(gbase) + (voff)[_i]), (PG8_LAS unsigned*)(lds + (bufoff) + ldsw + _i * 8192), 16, 0, 0); } while (0)
#define PG8_LDA(dst, b, h) do { _Pragma("unroll") for (int m = 0; m < 4; ++m) _Pragma("unroll") for (int k = 0; k < 2; ++k) dst[m][k] = *(const PG8_LAS bf16x8*)(lds + PG8_SA(b, h) + aoff + m * 2048 + k * 1024); } while (0)
#define PG8_LDB(dst, b, h) do { _Pragma("unroll") for (int n = 0; n < 2; ++n) _Pragma("unroll") for (int k = 0; k < 2; ++k) dst[n][k] = *(const PG8_LAS bf16x8*)(lds + PG8_SB(b, h) + boff + n * 2048 + k * 1024); } while (0)
#define PG8_MMA(ai, bj, At, Bt) do { __builtin_amdgcn_s_setprio(1); _Pragma("unroll") for (int m = 0; m < 4; ++m) _Pragma("unroll") for (int n = 0; n < 2; ++n) _Pragma("unroll") for (int k = 0; k < 2; ++k) \
        acc[ai][bj][m][n] = __builtin_amdgcn_mfma_f32_16x16x32_bf16(Bt[n][k], At[m][k], acc[ai][bj][m][n], 0, 0, 0); __builtin_amdgcn_s_setprio(0); } while (0)
#define PG8_WAIT_V(n) asm volatile("s_waitcnt vmcnt(" #n ")" ::: "memory")
#define PG8_WAIT_L(n) asm volatile("s_waitcnt lgkmcnt(" #n ")" ::: "memory")
#define PG8_BAR __builtin_amdgcn_s_barrier()
#define PG8_SCHED __builtin_amdgcn_sched_barrier(0)
    Unit cur, nxt; int ui = 0;
    if (!S.next(0, cur)) return;
    f32x4 acc[2][2][4][2];
#pragma unroll
    for (int a = 0; a < 2; ++a)
#pragma unroll
        for (int b = 0; b < 2; ++b)
#pragma unroll
            for (int m = 0; m < 4; ++m)
#pragma unroll
                for (int n = 0; n < 2; ++n) acc[a][b][m][n] = (f32x4){0.f, 0.f, 0.f, 0.f};
    bf16x8 At[4][2], B0[2][2], B1[2][2];
    const char* cA = (const char*)g.A + (size_t)cur.pm * tstep; const char* cB = (const char*)g.Bt + (size_t)cur.pn * tstep;
    S.a_ready(cur);
    PG8_STAGE(PG8_SB(0, 0), cB, voffB); PG8_STAGE(PG8_SA(0, 0), cA, voffA); PG8_STAGE(PG8_SB(0, 1), cB + hstep, voffB); PG8_STAGE(PG8_SA(0, 1), cA + hstep, voffA);
    if (wr == 1) PG8_BAR;
    PG8_WAIT_V(4); PG8_BAR;
    PG8_STAGE(PG8_SB(1, 0), cB + kstep, voffB); PG8_STAGE(PG8_SA(1, 0), cA + kstep, voffA); PG8_STAGE(PG8_SB(1, 1), cB + hstep + kstep, voffB);
    PG8_WAIT_V(6); PG8_BAR;
    PG8_STAMP();
    for (;;) {
        const bool has_next = S.next(ui + 1, nxt);
        const char* nA = has_next ? (const char*)g.A + (size_t)nxt.pm * tstep : cA; const char* nB = has_next ? (const char*)g.Bt + (size_t)nxt.pn * tstep : cB;
        for (int t = 0; t < nt; t += 2) {
            const bool last = (t == nt - 2);
            const char* a1 = cA + (size_t)(t + 1) * kstep;
            const char* a2 = last ? nA : cA + (size_t)(t + 2) * kstep; const char* b2 = last ? nB : cB + (size_t)(t + 2) * kstep;
            const char* a3 = a2 + kstep; const char* b3 = b2 + kstep;
            if (last && has_next) S.a_ready(nxt);
            PG8_LDB(B0, 0, 0); PG8_SCHED; PG8_LDA(At, 0, 0); PG8_STAGE(PG8_SA(1, 1), a1 + hstep, voffA);
            PG8_WAIT_L(8); PG8_BAR; PG8_WAIT_L(0); PG8_MMA(0, 0, At, B0); PG8_BAR; PG8_SCHED;
            PG8_LDB(B1, 0, 1); PG8_STAGE(PG8_SB(0, 0), b2, voffB);
            PG8_BAR; PG8_WAIT_L(0); PG8_MMA(0, 1, At, B1); PG8_BAR;
            PG8_LDA(At, 0, 1); PG8_STAGE(PG8_SA(0, 0), a2, voffA);
            PG8_BAR; PG8_WAIT_L(0); PG8_MMA(1, 0, At, B0); PG8_BAR; PG8_SCHED;
            PG8_STAGE(PG8_SB(0, 1), b2 + hstep, voffB);
            PG8_WAIT_V(6); PG8_BAR; PG8_MMA(1, 1, At, B1); PG8_BAR;
            PG8_LDB(B0, 1, 0); PG8_SCHED; PG8_LDA(At, 1, 0); PG8_STAGE(PG8_SA(0, 1), a2 + hstep, voffA);
            PG8_WAIT_L(8); PG8_BAR; PG8_WAIT_L(0); PG8_MMA(0, 0, At, B0); PG8_BAR; PG8_SCHED;
            PG8_LDB(B1, 1, 1); PG8_STAGE(PG8_SB(1, 0), b3, voffB);
            PG8_BAR; PG8_WAIT_L(0); PG8_MMA(0, 1, At, B1); PG8_BAR;
            PG8_LDA(At, 1, 1); PG8_STAGE(PG8_SA(1, 0), a3, voffA);
            PG8_BAR; PG8_WAIT_L(0); PG8_MMA(1, 0, At, B0); PG8_BAR; PG8_SCHED;
            PG8_STAGE(PG8_SB(1, 1), b3 + hstep, voffB);
            PG8_WAIT_V(6); PG8_BAR; PG8_MMA(1, 1, At, B1); PG8_BAR;
        }
        PG8_STAMP();
        if constexpr (!Epi::AFTER_DRAIN) { E(acc, cur, wr, wc, fr, fq); S.done(cur); }
        PG8_STAMP();
        if (!has_next) break;
#pragma unroll
        for (int a = 0; a < 2; ++a)
#pragma unroll
            for (int b = 0; b < 2; ++b)
#pragma unroll
                for (int m = 0; m < 4; ++m)
#pragma unroll
                    for (int n = 0; n < 2; ++n) acc[a][b][m][n] = (f32x4){0.f, 0.f, 0.f, 0.f};
        cur = nxt; cA = nA; cB = nB; ++ui;
    }
    PG8_WAIT_V(0);
    if (wr == 0) PG8_BAR;
    PG8_BAR;
    if constexpr (Epi::AFTER_DRAIN) { E.fused(acc, cur, wr, wc, fr, fq, lds, wid, lane); S.done(cur); }
    PG8_STAMP();
    if (STAMP && wid == 0) { stamps[lane] = lane < nts ? (((unsigned long long)(unsigned)ts_hi << 32) | (unsigned)ts_lo) : 0ull;
        if (lane == 62) stamps[62] = rt_entry; if (lane == 63) stamps[63] = (unsigned long long)wall_clock64(); }
#undef PG8_STAMP
#undef PG8_SA
#undef PG8_SB
#undef PG8_STAGE
#undef PG8_LDA
#undef PG8_LDB
#undef PG8_MMA
#undef PG8_WAIT_V
#undef PG8_WAIT_L
#undef PG8_BAR
#undef PG8_SCHED
}
}

struct EpiProjPG {
    static constexpr bool PERM = true, AFTER_DRAIN = false;
    bf16_t* O;
    DEVI void operator()(const pg8::f32x4 (&acc)[2][2][4][2], const pg8::Unit& u, int wr, int wc, int fr, int fq) const {
        const int row0 = u.pm * 256 + wr * 64 + fr, col0 = u.pn * 256 + wc * 32 + 8 * fq;
#pragma unroll
        for (int ai = 0; ai < 2; ++ai)
#pragma unroll
            for (int m = 0; m < 4; ++m) {
                bf16_t* rowp = O + (size_t)(row0 + ai * 128 + m * 16) * LDP + col0;
#pragma unroll
                for (int bj = 0; bj < 2; ++bj) {
                    const pg8::f32x4 v0 = acc[ai][bj][m][0], v1 = acc[ai][bj][m][1];
                    u32x4 w = {pk2(v0[0], v0[1]), pk2(v0[2], v0[3]), pk2(v1[0], v1[1]), pk2(v1[2], v1[3])};
                    *(u32x4*)(rowp + bj * 128) = w;
                }
            }
    }
};
struct EpiOutPG {
    static constexpr bool PERM = false, AFTER_DRAIN = false;
    float* x; const float* xin; const float* mod;
    DEVI void operator()(const pg8::f32x4 (&acc)[2][2][4][2], const pg8::Unit& u, int wr, int wc, int fr, int fq) const {
        const int row0 = u.pm * 256 + wr * 64 + fr, col0 = u.pn * 256 + wc * 32 + 4 * fq;
        const float* gp = mod + (size_t)(u.pm >> 3) * 3072 + 2048 + col0;
        pg8::f32x4 gv[2][2];
#pragma unroll
        for (int bj = 0; bj < 2; ++bj)
#pragma unroll
            for (int n = 0; n < 2; ++n) gv[bj][n] = *(const pg8::f32x4*)(gp + bj * 128 + n * 16);
#pragma unroll
        for (int ai = 0; ai < 2; ++ai)
#pragma unroll
            for (int m = 0; m < 4; ++m) {
                const size_t ro = (size_t)(row0 + ai * 128 + m * 16) * 1024 + col0;
#pragma unroll
                for (int bj = 0; bj < 2; ++bj)
#pragma unroll
                    for (int n = 0; n < 2; ++n)
                        *(pg8::f32x4*)(x + ro + bj * 128 + n * 16) = *(const pg8::f32x4*)(xin + ro + bj * 128 + n * 16) + gv[bj][n] * acc[ai][bj][m][n];
            }
    }
};
DEVI void out_gemm_sample(KP p_, int l) {
    KP p = launder(p_);
    const int nt = bidx();
    if (nt >= 64) return;
    const int lane = tidx() & 63, wid = tidx() >> 6, q = lane >> 4, c = lane & 15;
    const bf16_t* a = p->obf + (size_t)(NPR + wid * 16 + c) * 1536 + 8 * q;
    const bf16_t* b = p->WoutT + (size_t)l * 1024 * 1536 + (size_t)(nt * 16 + c) * 1536 + 8 * q;
    f32x4 acc0 = {0.f, 0.f, 0.f, 0.f}, acc1 = {0.f, 0.f, 0.f, 0.f};
#pragma unroll 8
    for (int ks = 0; ks < 48; ks += 2) {
        acc0 = MFMA16(*(const bf16x8*)(b + ks * 32), *(const bf16x8*)(a + ks * 32), acc0);
        acc1 = MFMA16(*(const bf16x8*)(b + ks * 32 + 32), *(const bf16x8*)(a + ks * 32 + 32), acc1);
    }
    const int m = NPR + wid * 16 + c, n = nt * 16 + 4 * q;
    const f32x4 g = *(const f32x4*)(p->mod + ((size_t)l * NSEQ + mod_row(m)) * 3072 + 2048 + n);
    const float* xi = l == 0 ? p->x_sample + (size_t)(m - NPR) * 1024 + n : p->x + (size_t)m * 1024 + n;
    *(f32x4*)(p->x + (size_t)m * 1024 + n) = *(const f32x4*)xi + g * (acc0 + acc1);
}
DEVI float dn_full(KP p, int l, int s, int row0, int f, int col) {
    if (f < 3) { if (s < 8) return 0.f; return p->st_conv[((size_t)(l * 128 + (s - 8)) * 3 + f) * 1536 + col]; }
    return bf2f(p->proj[(size_t)(row0 + f - 3) * LDP + col]);
}
DEVI void seq_of_row(int row, int& s, int& t, int& T, int& row0) {
    if (row < NPR) { s = row >> 11; t = row & 2047; T = 2048; row0 = s * 2048; }
    else { s = 8 + row - NPR; t = 0; T = 1; row0 = row; }
}

DEVI void phase_prep(KP p_, int l, unsigned char* smem) {
    KP p = launder(p_);
    const int tid = tidx(), lane = tid & 63, wid = tid >> 6;
    for (int it = NPR * 4 + bidx() * 8 + wid; it < NR * 4; it += gdim() * 8) {
        const int row = it >> 2, h = it & 3, b = row - NPR;
        const float* st = p->st_conv + (size_t)(l * 128 + b) * 3 * 1536;
        float* cdst = p->out + O_SCONV + (size_t)(l * 128 + b) * 3 * 1536;
        float val[3][2];
#pragma unroll
        for (int seg = 0; seg < 3; ++seg) {
            const int col = seg * 512 + h * 128 + lane * 2;
            const float2 s0 = *(const float2*)(st + col), s1 = *(const float2*)(st + 1536 + col), s2 = *(const float2*)(st + 3072 + col);
            const unsigned cu = *(const unsigned*)(p->proj + (size_t)row * LDP + col);
            const float2 cur = make_float2(__uint_as_float(cu << 16), __uint_as_float(cu & 0xffff0000u));
            const float2 w0 = *(const float2*)(p->conv_w + (l * 4 + 0) * 1536 + col), w1 = *(const float2*)(p->conv_w + (l * 4 + 1) * 1536 + col);
            const float2 w2 = *(const float2*)(p->conv_w + (l * 4 + 2) * 1536 + col), w3 = *(const float2*)(p->conv_w + (l * 4 + 3) * 1536 + col);
            val[seg][0] = siluf(s0.x * w0.x + s1.x * w1.x + s2.x * w2.x + cur.x * w3.x);
            val[seg][1] = siluf(s0.y * w0.y + s1.y * w1.y + s2.y * w2.y + cur.y * w3.y);
            *(float2*)(cdst + col) = s1; *(float2*)(cdst + 1536 + col) = s2; *(float2*)(cdst + 3072 + col) = cur;
        }
        float sq = wsum(val[0][0] * val[0][0] + val[0][1] * val[0][1]);
        float sk = wsum(val[1][0] * val[1][0] + val[1][1] * val[1][1]);
        const float rq = rsqrtf(sq + 1e-6f) * 0.08838834764831845f, rk = rsqrtf(sk + 1e-6f);
        const size_t o = (size_t)row * 512 + h * 128 + lane * 2;
        *(float2*)(p->dnq + o) = make_float2(val[0][0] * rq, val[0][1] * rq);
        *(float2*)(p->dnk + o) = make_float2(val[1][0] * rk, val[1][1] * rk);
        *(float2*)(p->dnv + o) = make_float2(val[2][0], val[2][1]);
        if (lane == 0) {
            float braw = bf2f(p->proj[(size_t)row * LDP + C_DNB + h]), araw = bf2f(p->proj[(size_t)row * LDP + C_DNA + h]);
            p->dnbeta[row * 4 + h] = sigmf(braw);
            float g = -fexp(p->a_log[l * 4 + h]) * softplusf(araw + p->dt_bias[l * 4 + h]);
            p->dna[row * 4 + h] = fexp(g);
        }
    }
    for (int row = NPR + ((bidx() + gdim() - 64) % gdim()) * 8 + wid; row < NR; row += gdim() * 8) {
        float glo[16];
#pragma unroll
        for (int j = 0; j < 16; ++j) glo[j] = bf2f(p->proj[(size_t)row * LDP + C_GLO + j]);
#pragma unroll
        for (int i = 0; i < 4; ++i) {
            const int c = lane + i * 64;
            float z = p->gla_bf[l * 256 + c];
#pragma unroll
            for (int j = 0; j < 16; ++j) z += glo[j] * p->gla_wf[(l * 16 + j) * 256 + c];
            p->glf[(size_t)row * 256 + c] = -softplusf(-z) * (1.f / 16.f);
        }
    }
    constexpr int RT = 2;
    float* twT = (float*)smem;
    float* alT = twT + 64 * RT;
    for (int tile = NPR / RT + (bidx() + gdim() - 128) % gdim(); tile < NR / RT; tile += gdim()) {
        const int c = tid;
        const int rbase = tile * RT;
        const float mur = p->rw_mu[l * 1664 + c], muk = p->rw_mu[l * 1664 + 512 + c], muv = p->rw_mu[l * 1664 + 1024 + c];
        float xr[RT], xk[RT], xv[RT];
#pragma unroll
        for (int r = 0; r < RT; ++r) {
            const int row = rbase + r;
            const bf16_t* pp = p->proj + (size_t)row * LDP + C_RX;
            const float cr = bf2f(pp[c]), ck = bf2f(pp[512 + c]), cv = bf2f(pp[1024 + c]);
            const float* st = p->st_rs + (size_t)(l * 128 + row - NPR) * 1664;
            const float pr = st[c], pk = st[512 + c], pv = st[1024 + c];
            xr[r] = cr + (pr - cr) * mur; xk[r] = ck + (pk - ck) * muk; xv[r] = cv + (pv - cv) * muv;
            float* dst = p->out + O_SRS + (size_t)(l * 128 + row - NPR) * 1664;
            dst[c] = cr; dst[512 + c] = ck; dst[1024 + c] = cv;
            if (c < 128) dst[1536 + c] = bf2f(pp[1536 + c]);
        }
        if (c < 128) {
            const int col = 1536 + c, j = c & 63;
            const float mu = p->rw_mu[l * 1664 + col];
#pragma unroll
            for (int r = 0; r < RT; ++r) {
                const int row = rbase + r;
                const float cw = bf2f(p->proj[(size_t)row * LDP + C_RX + col]);
                const float pw = p->st_rs[(size_t)(l * 128 + row - NPR) * 1664 + col];
                const float xm = cw + (pw - cw) * mu;
                if (c < 64) twT[j * RT + r] = ftanh(xm); else alT[j * RT + r] = xm;
            }
        }
        __syncthreads();
        float aw[RT], aa[RT];
#pragma unroll
        for (int r = 0; r < RT; ++r) { aw[r] = 0.f; aa[r] = 0.f; }
#pragma unroll 32
        for (int j = 0; j < 64; ++j) {
            const float w2v = p->rw_w2[((size_t)l * 64 + j) * 512 + c], a2v = p->rw_a2[((size_t)l * 64 + j) * 512 + c];
            const float2 t2 = ((const float2*)twT)[j], a2 = ((const float2*)alT)[j];
            aw[0] += t2.x * w2v; aw[1] += t2.y * w2v;
            aa[0] += a2.x * a2v; aa[1] += a2.y * a2v;
        }
        const float w0 = p->rw_w0[l * 512 + c], a0 = p->rw_a0[l * 512 + c], kkc = p->rw_k_k[l * 512 + c], kac = p->rw_k_a[l * 512 + c], rkc = p->rw_r_k[l * 512 + c];
#pragma unroll
        for (int r = 0; r < RT; ++r) {
            const size_t o = (size_t)(rbase + r) * 512 + c;
            const float wl = -softplusf(-(w0 + aw[r])) - 0.5f;
            const float decay = fexp(-fexp(wl));
            const float a = sigmf(a0 + aa[r]);
            const float kr = xk[r] * kkc;
            const float ss = wsum(kr * kr);
            const float kk = kr * rsqrtf(ss + 1e-6f);
            const float k2 = xk[r] * (1.f + (a - 1.f) * kac);
            const float bon = wsum(xr[r] * k2 * rkc) * xv[r];
            p->rr[o] = xr[r]; p->rk[o] = k2; p->rv[o] = xv[r]; p->rw[o] = decay; p->rkk[o] = kk; p->rb[o] = kk * a; p->rbonus[o] = bon;
        }
        __syncthreads();
    }
}

DEVI void dn_scan_item(KP p, int l, int s, int h, int quarter, float* wl) {
    const int lane = tidx() & 63, kh = lane & 1;
    const int row = NPR + s - 8;
    const float* Sin = p->st_dn + (size_t)((l * 128 + s - 8) * 4 + h) * 16384;
    float* Sout = p->out + O_SDN + (size_t)((l * 128 + s - 8) * 4 + h) * 16384;
    const int col = quarter * 32 + (lane >> 1);
    float S[64];
#pragma unroll
    for (int k = 0; k < 64; ++k) S[k] = __builtin_nontemporal_load(Sin + (kh * 64 + k) * 128 + col);
    const size_t o = (size_t)row * 512 + h * 128;
    wave_sync();
    wl[lane] = p->dnq[o + lane]; wl[64 + lane] = p->dnq[o + 64 + lane]; wl[128 + lane] = p->dnk[o + lane]; wl[192 + lane] = p->dnk[o + 64 + lane];
    const float v = p->dnv[o + col], beta = p->dnbeta[row * 4 + h], a = p->dna[row * 4 + h];
    wave_sync();
    const float4* kp = (const float4*)(wl + 128 + kh * 64);
    const float4* qp = (const float4*)(wl + kh * 64);
    float x0 = 0.f, x1 = 0.f, x2 = 0.f, x3 = 0.f;
#pragma unroll
    for (int k4 = 0; k4 < 16; ++k4) {
        const float4 kv = kp[k4];
        x0 += S[k4 * 4 + 0] * kv.x; x1 += S[k4 * 4 + 1] * kv.y; x2 += S[k4 * 4 + 2] * kv.z; x3 += S[k4 * 4 + 3] * kv.w;
    }
    float x = (x0 + x1) + (x2 + x3);
    x += __shfl_xor(x, 1);
    const float coef = beta * (v - a * x);
    float o0 = 0.f, o1 = 0.f, o2 = 0.f, o3 = 0.f;
#pragma unroll
    for (int k4 = 0; k4 < 16; ++k4) {
        const float4 kv = kp[k4];
        const float4 qv = qp[k4];
        S[k4 * 4 + 0] = a * S[k4 * 4 + 0] + coef * kv.x; o0 += S[k4 * 4 + 0] * qv.x;
        S[k4 * 4 + 1] = a * S[k4 * 4 + 1] + coef * kv.y; o1 += S[k4 * 4 + 1] * qv.y;
        S[k4 * 4 + 2] = a * S[k4 * 4 + 2] + coef * kv.z; o2 += S[k4 * 4 + 2] * qv.z;
        S[k4 * 4 + 3] = a * S[k4 * 4 + 3] + coef * kv.w; o3 += S[k4 * 4 + 3] * qv.w;
    }
    float ov = (o0 + o1) + (o2 + o3);
    ov += __shfl_xor(ov, 1);
    if (kh == 0) p->oraw[(size_t)row * 1536 + h * 128 + col] = ov;
#pragma unroll
    for (int k = 0; k < 64; ++k) __builtin_nontemporal_store(S[k], Sout + (kh * 64 + k) * 128 + col);
}

DEVI void gla_scan_item(KP p, int l, int s, int h, int quarter, float* wl) {
    const int lane = tidx() & 63, kh = lane & 1;
    const int row = NPR + s - 8;
    const float* Sin = p->st_gla + (size_t)((l * 128 + s - 8) * 4 + h) * 8192;
    float* Sout = p->out + O_SGLA + (size_t)((l * 128 + s - 8) * 4 + h) * 8192;
    const int col = quarter * 32 + (lane >> 1);
    float S[32];
#pragma unroll
    for (int k = 0; k < 32; ++k) S[k] = __builtin_nontemporal_load(Sin + (kh * 32 + k) * 128 + col);
    const bf16_t* pp = p->proj + (size_t)row * LDP;
    wave_sync();
    wl[lane] = bf2f(pp[C_GQ + h * 64 + lane]) * 0.125f; wl[64 + lane] = bf2f(pp[C_GK + h * 64 + lane]);
    wl[128 + lane] = fexp(p->glf[(size_t)row * 256 + h * 64 + lane]);
    const float v = bf2f(pp[C_GV + h * 128 + col]);
    wave_sync();
    float o0 = 0.f, o1 = 0.f, o2 = 0.f, o3 = 0.f;
#pragma unroll
    for (int k4 = 0; k4 < 8; ++k4) {
        const float4 qv = ((const float4*)(wl + kh * 32))[k4], kv = ((const float4*)(wl + 64 + kh * 32))[k4], fv = ((const float4*)(wl + 128 + kh * 32))[k4];
        S[k4 * 4 + 0] = fv.x * S[k4 * 4 + 0] + kv.x * v; o0 += S[k4 * 4 + 0] * qv.x;
        S[k4 * 4 + 1] = fv.y * S[k4 * 4 + 1] + kv.y * v; o1 += S[k4 * 4 + 1] * qv.y;
        S[k4 * 4 + 2] = fv.z * S[k4 * 4 + 2] + kv.z * v; o2 += S[k4 * 4 + 2] * qv.z;
        S[k4 * 4 + 3] = fv.w * S[k4 * 4 + 3] + kv.w * v; o3 += S[k4 * 4 + 3] * qv.w;
    }
    float ov = (o0 + o1) + (o2 + o3);
    ov += __shfl_xor(ov, 1);
    if (kh == 0) p->oraw[(size_t)row * 1536 + 512 + h * 128 + col] = ov;
#pragma unroll
    for (int k = 0; k < 32; ++k) __builtin_nontemporal_store(S[k], Sout + (kh * 32 + k) * 128 + col);
}

DEVI void rw_scan_item(KP p, int l, int s, int h, int half, float* wl) {
    const int lane = tidx() & 63, kh = lane & 1;
    const int row = NPR + s - 8;
    const float* Sin = p->st_rw + (size_t)((l * 128 + s - 8) * 8 + h) * 4096;
    float* Sout = p->out + O_SRW + (size_t)((l * 128 + s - 8) * 8 + h) * 4096;
    const int vr = half * 32 + (lane >> 1);
    float S[32];
#pragma unroll
    for (int k4 = 0; k4 < 8; ++k4) {
        const f32x4 v4 = __builtin_nontemporal_load((const f32x4*)(Sin + vr * 64 + kh * 32) + k4);
        S[k4 * 4 + 0] = v4[0]; S[k4 * 4 + 1] = v4[1]; S[k4 * 4 + 2] = v4[2]; S[k4 * 4 + 3] = v4[3];
    }
    const size_t o = (size_t)row * 512 + h * 64;
    wave_sync();
    wl[lane] = p->rr[o + lane]; wl[64 + lane] = p->rw[o + lane]; wl[128 + lane] = p->rk[o + lane]; wl[192 + lane] = p->rkk[o + lane]; wl[256 + lane] = p->rb[o + lane];
    const float v = p->rv[o + vr];
    wave_sync();
    float x0 = 0.f, x1 = 0.f, x2 = 0.f, x3 = 0.f;
#pragma unroll
    for (int k4 = 0; k4 < 8; ++k4) {
        const float4 kv = ((const float4*)(wl + 192 + kh * 32))[k4];
        x0 += S[k4 * 4 + 0] * kv.x; x1 += S[k4 * 4 + 1] * kv.y; x2 += S[k4 * 4 + 2] * kv.z; x3 += S[k4 * 4 + 3] * kv.w;
    }
    float x = (x0 + x1) + (x2 + x3);
    x += __shfl_xor(x, 1);
    float o0 = 0.f, o1 = 0.f, o2 = 0.f, o3 = 0.f;
#pragma unroll
    for (int k4 = 0; k4 < 8; ++k4) {
        const float4 rv = ((const float4*)(wl + kh * 32))[k4], wv = ((const float4*)(wl + 64 + kh * 32))[k4], kv = ((const float4*)(wl + 128 + kh * 32))[k4], bv = ((const float4*)(wl + 256 + kh * 32))[k4];
        S[k4 * 4 + 0] = S[k4 * 4 + 0] * wv.x - x * bv.x + v * kv.x; o0 += S[k4 * 4 + 0] * rv.x;
        S[k4 * 4 + 1] = S[k4 * 4 + 1] * wv.y - x * bv.y + v * kv.y; o1 += S[k4 * 4 + 1] * rv.y;
        S[k4 * 4 + 2] = S[k4 * 4 + 2] * wv.z - x * bv.z + v * kv.z; o2 += S[k4 * 4 + 2] * rv.z;
        S[k4 * 4 + 3] = S[k4 * 4 + 3] * wv.w - x * bv.w + v * kv.w; o3 += S[k4 * 4 + 3] * rv.w;
    }
    float ov = (o0 + o1) + (o2 + o3);
    ov += __shfl_xor(ov, 1);
    if (kh == 0) p->oraw[(size_t)row * 1536 + 1024 + h * 64 + vr] = ov;
#pragma unroll
    for (int k4 = 0; k4 < 8; ++k4)
        __builtin_nontemporal_store((f32x4){S[k4 * 4 + 0], S[k4 * 4 + 1], S[k4 * 4 + 2], S[k4 * 4 + 3]}, (f32x4*)(Sout + vr * 64 + kh * 32) + k4);
}

DEVI bf16_t bfr(float a) { return (bf16_t)(pk2(a, 0.f) & 0xffffu); }
DEVI int permpos(int i) { return (i & ~31) | ((i & 12) << 1) | ((i & 16) >> 2) | (i & 3); }
DEVI float expc(float x) { return fexp(fminf(x, 80.f)); }

template <class F>
DEVI void lds_mm(const bf16_t* A, int lda, const bf16_t* Bt, int ldb, int MT, int NTl, int KS, F epi) {
    const int tid = tidx(), lane = tid & 63, wid = tid >> 6, r = lane & 15, q = lane >> 4;
    const int ntile = MT * NTl;
    for (int t = wid; t < ntile; t += 16) {
        const int t2 = t + 8;
        const bool two = t2 < ntile;
        const int mt = t / NTl, nt = t % NTl, mt2 = two ? t2 / NTl : mt, nt2 = two ? t2 % NTl : nt;
        f32x4 acc = {0.f, 0.f, 0.f, 0.f}, acc2 = {0.f, 0.f, 0.f, 0.f};
        for (int ks = 0; ks < KS; ++ks) {
            const bf16x8 a = *(const bf16x8*)(A + (mt * 16 + r) * lda + ks * 32 + q * 8);
            const bf16x8 b = *(const bf16x8*)(Bt + (nt * 16 + r) * ldb + ks * 32 + q * 8);
            const bf16x8 a2 = *(const bf16x8*)(A + (mt2 * 16 + r) * lda + ks * 32 + q * 8);
            const bf16x8 b2 = *(const bf16x8*)(Bt + (nt2 * 16 + r) * ldb + ks * 32 + q * 8);
            acc = MFMA16(a, b, acc);
            acc2 = MFMA16(a2, b2, acc2);
        }
#pragma unroll
        for (int jj = 0; jj < 4; ++jj) epi(mt * 16 + q * 4 + jj, nt * 16 + r, acc[jj]);
        if (two) {
#pragma unroll
            for (int jj = 0; jj < 4; ++jj) epi(mt2 * 16 + q * 4 + jj, nt2 * 16 + r, acc2[jj]);
        }
    }
}

template <int NPAR, class F>
DEVI void lds_mm4(const bf16_t* A, int lda, const bf16_t* Bt, int ldb, int MT, int NTl, int KS, F epi4) {
    const int tid = tidx(), lane = tid & 63, wid = tid >> 6, r = lane & 15, q = lane >> 4;
    f32x4 acc[NPAR];
    const bf16_t* ap[NPAR]; const bf16_t* bp[NPAR];
#pragma unroll
    for (int u = 0; u < NPAR; ++u) {
        const int t = wid + 8 * u, mt = t / NTl, nt = t % NTl;
        acc[u] = (f32x4){0.f, 0.f, 0.f, 0.f};
        ap[u] = A + (mt * 16 + r) * lda + q * 8; bp[u] = Bt + (nt * 16 + r) * ldb + q * 8;
    }
    for (int ks = 0; ks < KS; ++ks) {
        bf16x8 a[NPAR], b[NPAR];
#pragma unroll
        for (int u = 0; u < NPAR; ++u) { a[u] = *(const bf16x8*)(ap[u] + ks * 32); b[u] = *(const bf16x8*)(bp[u] + ks * 32); }
#pragma unroll
        for (int u = 0; u < NPAR; ++u) acc[u] = MFMA16(a[u], b[u], acc[u]);
    }
#pragma unroll
    for (int u = 0; u < NPAR; ++u) { const int t = wid + 8 * u, mt = t / NTl, nt = t % NTl; epi4(mt * 16 + q * 4, nt * 16 + r, acc[u]); }
}

DEVI void tri_inverse(const float* Mab, bf16_t* bT, int lane) {
    float Tc[64];
#pragma unroll
    for (int i = 0; i < 64; ++i) {
        float a0 = (lane == i) ? 1.f : 0.f, a1 = 0.f, a2 = 0.f, a3 = 0.f;
#pragma unroll
        for (int j4 = 0; j4 < (i + 3) / 4; ++j4) {
            const float4 m = *(const float4*)(Mab + i * 68 + j4 * 4);
            if (j4 * 4 + 0 < i) a0 += m.x * Tc[j4 * 4 + 0];
            if (j4 * 4 + 1 < i) a1 += m.y * Tc[j4 * 4 + 1];
            if (j4 * 4 + 2 < i) a2 += m.z * Tc[j4 * 4 + 2];
            if (j4 * 4 + 3 < i) a3 += m.w * Tc[j4 * 4 + 3];
        }
        Tc[i] = (a0 + a1) + (a2 + a3);
        bT[i * 72 + lane] = bfr(Tc[i]);
    }
}

DEVI void tri_inverse8(const float* Mab, bf16_t* bT) {
    const int tid = tidx(), lane = tid & 63, wid = tid >> 6, jl = lane & 7, col = wid * 8 + (lane >> 3);
    float s[8];
#pragma unroll
    for (int k = 0; k < 8; ++k) s[k] = 0.f;
    float mc[2][8][8];
#pragma unroll
    for (int r = 0; r < 8; ++r)
#pragma unroll
        for (int kk = 0; kk < 8; ++kk) mc[0][r][kk] = Mab[(kk * 8 + jl) * 68 + r];
#pragma unroll
    for (int b = 0; b < 8; ++b) {
        if (b + 1 < 8) {
#pragma unroll
            for (int r = 0; r < 8; ++r)
#pragma unroll
                for (int kk = b + 1; kk < 8; ++kk) mc[(b + 1) & 1][r][kk] = Mab[(kk * 8 + jl) * 68 + (b + 1) * 8 + r];
        }
#pragma unroll
        for (int r = 0; r < 8; ++r) {
            const int i = b * 8 + r;
            const float own = s[b] + (col == i ? 1.f : 0.f);
            const float q1 = (r & 3) == 0 ? dppf<0x00>(own) : ((r & 3) == 1 ? dppf<0x55>(own) : ((r & 3) == 2 ? dppf<0xAA>(own) : dppf<0xFF>(own)));
            const float q2 = dppf<0x141>(q1);
            const float Ti = ((jl >> 2) == (r >> 2)) ? q1 : q2;
            if (jl == r) bT[i * 72 + col] = bfr(Ti);
#pragma unroll
            for (int kk = b; kk < 8; ++kk) s[kk] += mc[b & 1][r][kk] * Ti;
        }
    }
}

template <int DK, int DV>
DEVI void prepass_core(const float* Mab, const bf16_t* bMak, const bf16_t* bMrk, bf16_t* bT, bf16_t* bYT, const bf16_t* bAST, const bf16_t* bVT,
                       bf16_t* gW, bf16_t* gUT, bf16_t* gO1, const float* rs) {
    lds_mm4<DV / 32>(bMak, 72, bVT, 72, 4, DV / 16, 2, [&](int i0, int dv, f32x4 y) { *(u32x2*)(bYT + dv * 72 + i0) = (u32x2){pk2(y[0], y[1]), pk2(y[2], y[3])}; });
    lds_mm4<DV / 32>(bVT, 72, bMrk, 72, DV / 16, 4, 2, [&](int dv0, int i, f32x4 o) { *(u32x2*)(gO1 + i * DV + dv0) = (u32x2){pk2(o[0], o[1]), pk2(o[2], o[3])}; });
    tri_inverse8(Mab, bT);
    __syncthreads();
    lds_mm4<DV / 32>(bT, 72, bYT, 72, 4, DV / 16, 2, [&](int i0, int dv, f32x4 u) {
        if (rs) { u[0] *= rs[i0]; u[1] *= rs[i0 + 1]; u[2] *= rs[i0 + 2]; u[3] *= rs[i0 + 3]; }
        *(u32x2*)(gUT + dv * 64 + i0) = (u32x2){pk2(u[0], u[1]), pk2(u[2], u[3])};
    });
    lds_mm4<DK / 32>(bAST, 72, bT, 72, DK / 16, 4, 2, [&](int dk0, int i, f32x4 w) {
        if (rs) w = w * rs[i];
        *(u32x2*)(gW + i * DK + permpos(dk0)) = (u32x2){pk2(w[0], w[1]), pk2(w[2], w[3])};
    });
}

constexpr int PP_F = 0;
constexpr int PP_BK = 35840;
constexpr int PP_BQ = PP_BK + 17408;
constexpr int PP_AST = PP_BQ + 17408;
constexpr int PP_VT = PP_AST + 18432;
constexpr int PP_MAK = PP_VT + 18432;
constexpr int PP_MRK = PP_MAK + 9216;
constexpr int PP_T = PP_MRK + 9216;
constexpr int PP_SC = PP_T + 9216;
constexpr int PP_BYTES = PP_SC + 4096;

DEVI void prepass_dn(KP p, int l, int s, int h, int c, unsigned char* smem) {
    const int tid = tidx(), lane = tid & 63, wid = tid >> 6;
    float* F = (float*)(smem + PP_F);
    float* Mab = (float*)(smem + PP_F);
    bf16_t* bYT = (bf16_t*)(smem + PP_F + 17408);
    bf16_t* bK = (bf16_t*)(smem + PP_BK); bf16_t* bQ = (bf16_t*)(smem + PP_BQ);
    bf16_t* bAST = (bf16_t*)(smem + PP_AST); bf16_t* bVT = (bf16_t*)(smem + PP_VT);
    bf16_t* bMak = (bf16_t*)(smem + PP_MAK); bf16_t* bMrk = (bf16_t*)(smem + PP_MRK); bf16_t* bT = (bf16_t*)(smem + PP_T);
    float* Lam = (float*)(smem + PP_SC); float* Lm1 = Lam + 64; float* bb = Lam + 128; float* aa = Lam + 192;
    const int item = (s * 4 + h) * 32 + c;
    const int rowbase = s * 2048 + c * 64;
    bf16_t* gW = p->dnW + (size_t)item * 8192; bf16_t* gR = p->dnR + (size_t)item * 8192; bf16_t* gKT = p->dnKT + (size_t)item * 8192;
    bf16_t* gM = p->dnM + (size_t)item * 4096; bf16_t* gUT = p->dnUT + (size_t)item * 8192; bf16_t* gO1 = p->dnO1 + (size_t)item * 8192;
    bf16_t* gVT = p->dnVT + (size_t)item * 8192;
    if (wid == 0) {
        const int row = rowbase + lane;
        const float braw = bf2f(p->proj[(size_t)row * LDP + C_DNB + h]), araw = bf2f(p->proj[(size_t)row * LDP + C_DNA + h]);
        const float g = -fexp(p->a_log[l * 4 + h]) * softplusf(araw + p->dt_bias[l * 4 + h]);
        float L = g;
#pragma unroll
        for (int o = 1; o < 64; o <<= 1) { const float t = __shfl_up(L, o); if (lane >= o) L += t; }
        Lam[lane] = L; Lm1[lane] = L - g; bb[lane] = sigmf(braw); aa[lane] = fexp(g);
        p->dnav[(size_t)item * 64 + lane] = fexp(g);
        const float LC = __shfl(L, 63);
        p->dnpc[(size_t)item * 128 + lane] = fexp(LC); p->dnpc[(size_t)item * 128 + 64 + lane] = fexp(LC);
    }
    const int col = tid & 127, rg = tid >> 7;
    float raw[3][19];
    {
        const int t0 = c * 64 + rg * 16;
#pragma unroll
        for (int seg = 0; seg < 3; ++seg) {
            const bf16_t* pp = p->proj + (size_t)(s * 2048) * LDP + seg * 512 + h * 128 + col;
#pragma unroll
            for (int ii = 0; ii < 19; ++ii) {
                const int t = t0 - 3 + ii, tc = t < 0 ? 0 : t;
                const float v = bf2f(pp[(size_t)tc * LDP]);
                raw[seg][ii] = (ii < 3 && t < 0) ? 0.f : v;
            }
        }
    }
    auto conv_seg = [&](int seg, float (&outv)[16]) {
        const int pc = seg * 512 + h * 128 + col;
        const float cw0 = p->conv_w[(l * 4 + 0) * 1536 + pc], cw1 = p->conv_w[(l * 4 + 1) * 1536 + pc], cw2 = p->conv_w[(l * 4 + 2) * 1536 + pc], cw3 = p->conv_w[(l * 4 + 3) * 1536 + pc];
#pragma unroll
        for (int ii = 0; ii < 16; ++ii)
            outv[ii] = siluf(raw[seg][ii] * cw0 + raw[seg][ii + 1] * cw1 + raw[seg][ii + 2] * cw2 + raw[seg][ii + 3] * cw3);
    };
    float cv[16];
    conv_seg(1, cv);
#pragma unroll
    for (int ii = 0; ii < 16; ++ii) F[(rg * 16 + ii) * 129 + col] = cv[ii];
    __syncthreads();
    {
        const float LC = Lam[63];
        const int i0 = wid * 8;
        float kt0[8], kt1[8];
#pragma unroll
        for (int r = 0; r < 8; ++r) {
            const int i = i0 + r;
            const float v0 = F[i * 129 + lane], v1 = F[i * 129 + 64 + lane];
            const float rn = rsqrtf(wsum(v0 * v0 + v1 * v1) + 1e-6f);
            const float k0 = v0 * rn, k1 = v1 * rn;
            const float e1 = fexp(Lm1[i]), e2 = bb[i] * fexp(LC - Lam[i]);
            bK[i * 136 + lane] = bfr(k0); bK[i * 136 + 64 + lane] = bfr(k1);
            bAST[lane * 72 + i] = bfr(k0 * e1); bAST[(64 + lane) * 72 + i] = bfr(k1 * e1);
            kt0[r] = k0 * e2; kt1[r] = k1 * e2;
        }
        const int pb = (i0 & 32) + ((i0 & 8) << 1) + ((i0 & 16) >> 2);
        *(u32x2*)(gKT + lane * 64 + pb) = (u32x2){pk2(kt0[0], kt0[1]), pk2(kt0[2], kt0[3])}; *(u32x2*)(gKT + lane * 64 + pb + 8) = (u32x2){pk2(kt0[4], kt0[5]), pk2(kt0[6], kt0[7])};
        *(u32x2*)(gKT + (64 + lane) * 64 + pb) = (u32x2){pk2(kt1[0], kt1[1]), pk2(kt1[2], kt1[3])}; *(u32x2*)(gKT + (64 + lane) * 64 + pb + 8) = (u32x2){pk2(kt1[4], kt1[5]), pk2(kt1[6], kt1[7])};
    }
    __syncthreads();
    conv_seg(0, cv);
#pragma unroll
    for (int ii = 0; ii < 16; ++ii) F[(rg * 16 + ii) * 129 + col] = cv[ii];
    __syncthreads();
    for (int i = wid * 8; i < wid * 8 + 8; ++i) {
        const float v0 = F[i * 129 + lane], v1 = F[i * 129 + 64 + lane];
        const float rn = rsqrtf(wsum(v0 * v0 + v1 * v1) + 1e-6f) * 0.08838834764831845f;
        const float q0 = v0 * rn, q1 = v1 * rn, e = fexp(Lam[i]);
        bQ[i * 136 + lane] = bfr(q0); bQ[i * 136 + 64 + lane] = bfr(q1);
        gR[i * 128 + permpos(lane)] = bfr(q0 * e); gR[i * 128 + permpos(64 + lane)] = bfr(q1 * e);
    }
    conv_seg(2, cv);
#pragma unroll
    for (int ii = 0; ii < 16; ++ii) bVT[col * 72 + rg * 16 + ii] = bfr(cv[ii]);
#pragma unroll
    for (int g = 0; g < 4; ++g)
        *(u32x2*)(gVT + col * 64 + (rg >> 1) * 32 + 8 * g + 4 * (rg & 1)) = (u32x2){pk2(cv[4 * g], cv[4 * g + 1]), pk2(cv[4 * g + 2], cv[4 * g + 3])};
    if (c == 31) {
        for (int idx = tid; idx < 3 * 384; idx += NT) {
            const int j = idx / 384, cc = idx % 384, pc = (cc >> 7) * 512 + h * 128 + (cc & 127);
            p->out[O_PCONV + (size_t)((l * 8 + s) * 3 + j) * 1536 + pc] = bf2f(p->proj[(size_t)(s * 2048 + 2045 + j) * LDP + pc]);
        }
    }
    __syncthreads();
    lds_mm(bK, 136, bK, 136, 4, 4, 4, [&](int i, int j, float g) {
        float mak = 0.f;
        if (i > j) mak = bb[j] * g * fexp(Lm1[i] - Lam[j]);
        Mab[i * 68 + j] = -aa[j] * mak; bMak[i * 72 + j] = bfr(mak);
    });
    lds_mm(bQ, 136, bK, 136, 4, 4, 4, [&](int i, int j, float g) {
        float mrk = 0.f;
        if (i >= j) mrk = bb[j] * g * fexp(Lam[i] - Lam[j]);
        bMrk[i * 72 + j] = bfr(mrk); gM[i * 64 + permpos(j)] = bfr(-mrk);
    });
    __syncthreads();
    prepass_core<128, 128>(Mab, bMak, bMrk, bT, bYT, bAST, bVT, gW, gUT, gO1, aa);
    __syncthreads();
}

DEVI void prepass_rw(KP p, int l, int s, int h, int c, unsigned char* smem) {
    const int tid = tidx(), lane = tid & 63, wid = tid >> 6;
    bf16_t* bTW = (bf16_t*)(smem + PP_F); bf16_t* bAL = bTW + 64 * 72;
    float* awL = (float*)(smem + PP_F + 18432); float* aaL = (float*)(smem + PP_BK);
    bf16_t* bW2T = (bf16_t*)(smem + PP_MAK); bf16_t* bA2T = (bf16_t*)(smem + PP_MRK);
    float* Mab = (float*)(smem + PP_F); bf16_t* bYT = (bf16_t*)(smem + PP_F + 17408);
    bf16_t* bAS = (bf16_t*)(smem + PP_BK); bf16_t* bRS = (bf16_t*)(smem + PP_BQ);
    bf16_t* bAST = (bf16_t*)(smem + PP_AST); bf16_t* bBH = (bf16_t*)(smem + PP_AST + 9216);
    bf16_t* bVT = (bf16_t*)(smem + PP_VT); bf16_t* bKH = (bf16_t*)(smem + PP_VT + 9216);
    bf16_t* bMak = (bf16_t*)(smem + PP_MAK); bf16_t* bMrk = (bf16_t*)(smem + PP_MRK); bf16_t* bT = (bf16_t*)(smem + PP_T);
    float* tot = (float*)(smem + PP_SC);
    const int item = (s * 8 + h) * 32 + c;
    const int rowbase = s * 2048 + c * 64;
    bf16_t* gW = p->rwW + (size_t)item * 4096; bf16_t* gR = p->rwR + (size_t)item * 4096; bf16_t* gKT = p->rwKT + (size_t)item * 4096;
    bf16_t* gBT = p->rwBT + (size_t)item * 4096; bf16_t* gM = p->rwM + (size_t)item * 4096; bf16_t* gUT = p->rwUT + (size_t)item * 4096;
    bf16_t* gO1 = p->rwO1 + (size_t)item * 4096; bf16_t* gVT = p->rwVT + (size_t)item * 4096;
    const int colA = tid & 127, g4 = tid >> 7, iA = g4 * 16;
    const int ch = lane, hc = h * 64 + ch, i0 = wid * 8;
    const bool firstA = (c * 64 + iA == 0), firstB = (c * 64 + i0 == 0);
    float rawA[17], rawR[9], rawK[9], rawV[9], w2r[8], a2r[8];
    {
        const bf16_t* ppA = p->proj + (size_t)rowbase * LDP + C_RX + 1536 + colA;
#pragma unroll
        for (int ii = 0; ii < 17; ++ii) { const int r = iA - 1 + ii; rawA[ii] = bf2f(ppA[(ptrdiff_t)((firstA && ii == 0) ? 0 : r) * LDP]); }
        const bf16_t* ppB = p->proj + (size_t)rowbase * LDP + C_RX + hc;
#pragma unroll
        for (int ii = 0; ii < 9; ++ii) {
            const bf16_t* q = ppB + (ptrdiff_t)((firstB && ii == 0) ? 0 : (i0 - 1 + ii)) * LDP;
            rawR[ii] = bf2f(q[0]); rawK[ii] = bf2f(q[512]); rawV[ii] = bf2f(q[1024]);
        }
#pragma unroll
        for (int jj = 0; jj < 8; ++jj) { const int j = wid * 8 + jj; w2r[jj] = p->rw_w2[((size_t)l * 64 + j) * 512 + hc]; a2r[jj] = p->rw_a2[((size_t)l * 64 + j) * 512 + hc]; }
    }
    const float muA = p->rw_mu[l * 1664 + 1536 + colA];
    const float mur = p->rw_mu[l * 1664 + hc], muk = p->rw_mu[l * 1664 + 512 + hc], muv = p->rw_mu[l * 1664 + 1024 + hc];
    if (firstA) rawA[0] = 0.f;
    if (firstB) { rawR[0] = 0.f; rawK[0] = 0.f; rawV[0] = 0.f; }
#pragma unroll
    for (int ii = 0; ii < 16; ++ii) {
        const float cur = rawA[ii + 1], xm = cur + (rawA[ii] - cur) * muA;
        if (colA < 64) bTW[(iA + ii) * 72 + colA] = bfr(ftanh(xm)); else bAL[(iA + ii) * 72 + colA - 64] = bfr(xm);
    }
#pragma unroll
    for (int jj = 0; jj < 8; ++jj) { const int j = wid * 8 + jj; bW2T[ch * 72 + j] = bfr(w2r[jj]); bA2T[ch * 72 + j] = bfr(a2r[jj]); }
    float xr[8], xk[8], xv[8];
#pragma unroll
    for (int r = 0; r < 8; ++r) {
        xr[r] = rawR[r + 1] + (rawR[r] - rawR[r + 1]) * mur; xk[r] = rawK[r + 1] + (rawK[r] - rawK[r + 1]) * muk; xv[r] = rawV[r + 1] + (rawV[r] - rawV[r + 1]) * muv;
    }
    __syncthreads();
    lds_mm(bTW, 72, bW2T, 72, 4, 4, 2, [&](int i, int c2, float v) { awL[i * 65 + c2] = v; });
    lds_mm(bAL, 72, bA2T, 72, 4, 4, 2, [&](int i, int c2, float v) { aaL[i * 65 + c2] = v; });
    __syncthreads();
    float aw[8], aa[8];
#pragma unroll
    for (int r = 0; r < 8; ++r) { aw[r] = awL[(i0 + r) * 65 + ch]; aa[r] = aaL[(i0 + r) * 65 + ch]; }
    const float w0 = p->rw_w0[l * 512 + hc], a0 = p->rw_a0[l * 512 + hc], kkc = p->rw_k_k[l * 512 + hc], kac = p->rw_k_a[l * 512 + hc], rkc = p->rw_r_k[l * 512 + hc];
    float lw[8], Ll[8], kkv[8], k2v[8], bv[8];
    float run = 0.f;
#pragma unroll
    for (int r = 0; r < 8; ++r) {
        const float wl = -softplusf(-(w0 + aw[r])) - 0.5f;
        lw[r] = -fexp(wl);
        run += lw[r]; Ll[r] = run;
        const float a = sigmf(a0 + aa[r]);
        const float kr = xk[r] * kkc;
        const float kk = kr * rsqrtf(wsum(kr * kr) + 1e-6f);
        const float k2 = xk[r] * (1.f + (a - 1.f) * kac);
        const float bon = wsum(xr[r] * k2 * rkc) * xv[r];
        p->rbonus[(size_t)(rowbase + i0 + r) * 512 + hc] = bon;
        kkv[r] = kk; k2v[r] = k2; bv[r] = -(kk * a);
    }
    tot[wid * 64 + ch] = run;
    __syncthreads();
    {
        float off = 0.f, LC = 0.f;
#pragma unroll
        for (int g = 0; g < 8; ++g) { const float t = tot[g * 64 + ch]; LC += t; if (g < wid) off += t; }
        if (wid == 0) p->rwpc[(size_t)item * 64 + ch] = expc(LC);
        float kt8[8], bt8[8];
#pragma unroll
        for (int r = 0; r < 8; ++r) {
            const int i = i0 + r;
            const float L = off + Ll[r], Lm = L - lw[r];
            const float AS = kkv[r] * expc(Lm), RS = xr[r] * expc(L), em = expc(-L), eC = expc(LC - L);
            bAS[i * 72 + ch] = bfr(AS); bRS[i * 72 + ch] = bfr(RS); bBH[i * 72 + ch] = bfr(bv[r] * em); bKH[i * 72 + ch] = bfr(k2v[r] * em);
            bAST[ch * 72 + i] = bfr(AS); bVT[ch * 72 + i] = bfr(xv[r]);
            gR[i * 64 + permpos(ch)] = bfr(RS);
            kt8[r] = k2v[r] * eC; bt8[r] = bv[r] * eC;
        }
        const int pb = ch * 64 + (i0 & 32) + ((i0 & 8) << 1) + ((i0 & 16) >> 2);
        *(u32x2*)(gKT + pb) = (u32x2){pk2(kt8[0], kt8[1]), pk2(kt8[2], kt8[3])}; *(u32x2*)(gKT + pb + 8) = (u32x2){pk2(kt8[4], kt8[5]), pk2(kt8[6], kt8[7])};
        *(u32x2*)(gBT + pb) = (u32x2){pk2(bt8[0], bt8[1]), pk2(bt8[2], bt8[3])}; *(u32x2*)(gBT + pb + 8) = (u32x2){pk2(bt8[4], bt8[5]), pk2(bt8[6], bt8[7])};
        *(u32x2*)(gVT + pb) = (u32x2){pk2(xv[0], xv[1]), pk2(xv[2], xv[3])}; *(u32x2*)(gVT + pb + 8) = (u32x2){pk2(xv[4], xv[5]), pk2(xv[6], xv[7])};
    }
    if (c == 31 && h == 0) {
        for (int idx = tid; idx < 1664; idx += NT)
            p->out[O_PRS + (size_t)(l * 8 + s) * 1664 + idx] = bf2f(p->proj[(size_t)(s * 2048 + 2047) * LDP + C_RX + idx]);
    }
    __syncthreads();
    lds_mm(bAS, 72, bBH, 72, 4, 4, 2, [&](int i, int j, float g) { Mab[i * 68 + j] = i > j ? g : 0.f; });
    lds_mm(bAS, 72, bKH, 72, 4, 4, 2, [&](int i, int j, float g) { bMak[i * 72 + j] = bfr(i > j ? g : 0.f); });
    lds_mm(bRS, 72, bBH, 72, 4, 4, 2, [&](int i, int j, float g) { gM[i * 64 + permpos(j)] = bfr(i >= j ? g : 0.f); });
    lds_mm(bRS, 72, bKH, 72, 4, 4, 2, [&](int i, int j, float g) { bMrk[i * 72 + j] = bfr(i >= j ? g : 0.f); });
    __syncthreads();
    prepass_core<64, 64>(Mab, bMak, bMrk, bT, bYT, bAST, bVT, gW, gUT, gO1, nullptr);
    __syncthreads();
}

DEVI void prepass_gla(KP p, int l, int s, int h, int c, unsigned char* smem) {
    const int tid = tidx(), lane = tid & 63, wid = tid >> 6;
    float* glo = (float*)(smem + PP_F);
    bf16_t* bRS = (bf16_t*)(smem + PP_BK); bf16_t* bKH = bRS + 64 * 72;
    bf16_t* bVT = (bf16_t*)(smem + PP_VT); bf16_t* bMrk = (bf16_t*)(smem + PP_MRK);
    float* tot = (float*)(smem + PP_SC);
    const int item = (s * 4 + h) * 32 + c;
    const int rowbase = s * 2048 + c * 64;
    bf16_t* gR = p->glR + (size_t)item * 4096; bf16_t* gKT = p->glKT + (size_t)item * 4096;
    bf16_t* gO1 = p->glO1 + (size_t)item * 8192; bf16_t* gVT = p->glVT + (size_t)item * 8192;
    const int ch = lane, hc = h * 64 + ch, i0 = wid * 8;
    const int dv = tid & 127, g4v = tid >> 7;
    float glo0, glo1; bf16_t vv[16]; float qv[8], kv[8], wf[16];
    {
        glo0 = bf2f(p->proj[(size_t)(rowbase + (tid >> 4)) * LDP + C_GLO + (tid & 15)]);
        glo1 = bf2f(p->proj[(size_t)(rowbase + 32 + (tid >> 4)) * LDP + C_GLO + (tid & 15)]);
        const bf16_t* pv = p->proj + (size_t)rowbase * LDP + C_GV + h * 128 + dv;
#pragma unroll
        for (int ii = 0; ii < 16; ++ii) vv[ii] = pv[(size_t)(g4v * 16 + ii) * LDP];
#pragma unroll
        for (int r = 0; r < 8; ++r) {
            const bf16_t* pp = p->proj + (size_t)(rowbase + i0 + r) * LDP;
            qv[r] = bf2f(pp[C_GQ + hc]) * 0.125f; kv[r] = bf2f(pp[C_GK + hc]);
        }
#pragma unroll
        for (int j = 0; j < 16; ++j) wf[j] = p->gla_wf[(l * 16 + j) * 256 + hc];
    }
    const float bfv = p->gla_bf[l * 256 + hc];
    glo[tid] = glo0; glo[512 + tid] = glo1;
#pragma unroll
    for (int ii = 0; ii < 16; ++ii) bVT[dv * 72 + g4v * 16 + ii] = vv[ii];
#pragma unroll
    for (int g = 0; g < 4; ++g)
        *(u32x2*)(gVT + dv * 64 + (g4v >> 1) * 32 + 8 * g + 4 * (g4v & 1)) = (u32x2){(unsigned)vv[4 * g] | ((unsigned)vv[4 * g + 1] << 16), (unsigned)vv[4 * g + 2] | ((unsigned)vv[4 * g + 3] << 16)};
    __syncthreads();
    float Ll[8];
    float run = 0.f;
#pragma unroll
    for (int r = 0; r < 8; ++r) {
        const int i = i0 + r;
        float z = bfv;
#pragma unroll
        for (int j4 = 0; j4 < 4; ++j4) {
            const float4 g4 = *(const float4*)(glo + i * 16 + j4 * 4);
            z += g4.x * wf[j4 * 4 + 0] + g4.y * wf[j4 * 4 + 1] + g4.z * wf[j4 * 4 + 2] + g4.w * wf[j4 * 4 + 3];
        }
        run += -softplusf(-z) * (1.f / 16.f); Ll[r] = run;
    }
    tot[wid * 64 + ch] = run;
    __syncthreads();
    {
        float off = 0.f, LC = 0.f;
#pragma unroll
        for (int g = 0; g < 8; ++g) { const float t = tot[g * 64 + ch]; LC += t; if (g < wid) off += t; }
        if (wid == 0) p->glpc[(size_t)item * 64 + ch] = expc(LC);
        float kt8[8];
#pragma unroll
        for (int r = 0; r < 8; ++r) {
            const int i = i0 + r;
            const float L = off + Ll[r];
            const float RS = qv[r] * expc(L);
            bRS[i * 72 + ch] = bfr(RS); bKH[i * 72 + ch] = bfr(kv[r] * expc(-L));
            gR[i * 64 + permpos(ch)] = bfr(RS); kt8[r] = kv[r] * expc(LC - L);
        }
        const int pb = ch * 64 + (i0 & 32) + ((i0 & 8) << 1) + ((i0 & 16) >> 2);
        *(u32x2*)(gKT + pb) = (u32x2){pk2(kt8[0], kt8[1]), pk2(kt8[2], kt8[3])}; *(u32x2*)(gKT + pb + 8) = (u32x2){pk2(kt8[4], kt8[5]), pk2(kt8[6], kt8[7])};
    }
    __syncthreads();
    lds_mm(bRS, 72, bKH, 72, 4, 4, 2, [&](int i, int j, float g) { bMrk[i * 72 + j] = bfr(i >= j ? g : 0.f); });
    __syncthreads();
    lds_mm(bMrk, 72, bVT, 72, 4, 8, 2, [&](int i, int dv, float o) { gO1[i * 128 + dv] = bfr(o); });
    __syncthreads();
}

DEVI void phase_prepass(KP p_, int l, unsigned char* smem) {
    KP p = launder(p_);
    for (int it = bidx(); it < 4096; it += gdim()) {
#ifdef NO_PRE
        continue;
#endif
        if (it < 2048) prepass_rw(p, l, it >> 8, (it >> 5) & 7, it & 31, smem);
        else if (it < 3072) { const int i = it - 2048; prepass_dn(p, l, i >> 7, (i >> 5) & 3, i & 31, smem); }
        else { const int i = it - 3072; prepass_gla(p, l, i >> 7, (i >> 5) & 3, i & 31, smem); }
    }
}

DEVI f32x4 unpack4(u32x2 u) { return (f32x4){__uint_as_float(u.x << 16), __uint_as_float(u.x & 0xffff0000u), __uint_as_float(u.y << 16), __uint_as_float(u.y & 0xffff0000u)}; }
DEVI bf16x8 pack8(f32x4 a, f32x4 b) { u32x4 r = {pk2(a[0], a[1]), pk2(a[2], a[3]), pk2(b[0], b[1]), pk2(b[2], b[3])}; return __builtin_bit_cast(bf16x8, r); }

template <int TYPE> struct SeqCfg {
    static constexpr int DK = TYPE == 0 ? 128 : 64, DV = TYPE == 2 ? 64 : 128, NDT = DK / 16, NKS = DK / 32, H = TYPE == 2 ? 8 : 4, NSL = DV / 16;
    static constexpr int NCP = TYPE == 0 ? 7 : (TYPE == 1 ? 2 : 5);
    static constexpr int SW = TYPE == 0 ? 272 : 144;
    static constexpr int OFF_W = 0, OFF_R = TYPE == 0 ? 17408 : (TYPE == 1 ? 0 : 9216), OFF_KT = TYPE == 0 ? 34816 : (TYPE == 1 ? 9216 : 18432);
    static constexpr int OFF_BT = 27648, OFF_M = TYPE == 0 ? 53248 : 36864;
    static constexpr int BUFB = TYPE == 0 ? 62464 : (TYPE == 1 ? 18432 : 46080);
};

template <int TYPE>
DEVI void chunk_seq_block(KP p, int l, int s, int h, int part, unsigned char* smem) {
    typedef SeqCfg<TYPE> C;
    constexpr int DK = C::DK, DV = C::DV, NDT = C::NDT, NKS = C::NKS, H = C::H, NSL = C::NSL, NCP = C::NCP, SW = C::SW;
    const int tid = tidx(), lane = tid & 63, wid = tid >> 6, q = lane >> 4, c = lane & 15;
    const int slice = TYPE == 0 ? part * 4 + wid : wid;
    const bool active = TYPE == 0 ? wid < 4 : wid < NSL;
    const bf16_t* cbase[NCP]; int cstride[NCP]; int soff[NCP], doff[NCP];
    if (TYPE == 0) {
#pragma unroll
        for (int i = 0; i < NCP; ++i) {
            if (i < 4) { const int j = tid + (i & 1) * 512, row = j >> 4, cc = j & 15; cbase[i] = i < 2 ? p->dnW : p->dnR; cstride[i] = 8192; soff[i] = row * 128 + cc * 8; doff[i] = (i < 2 ? C::OFF_W : C::OFF_R) + row * 272 + cc * 16; }
            else if (i < 6) { const int j = tid + (i & 1) * 512, row = j >> 3, cc = j & 7; cbase[i] = p->dnKT; cstride[i] = 8192; soff[i] = row * 64 + cc * 8; doff[i] = C::OFF_KT + row * 144 + cc * 16; }
            else { const int row = tid >> 3, cc = tid & 7; cbase[i] = p->dnM; cstride[i] = 4096; soff[i] = row * 64 + cc * 8; doff[i] = C::OFF_M + row * 144 + cc * 16; }
        }
    } else {
#pragma unroll
        for (int i = 0; i < NCP; ++i) {
            const int row = tid >> 3, cc = tid & 7;
            if (TYPE == 1) cbase[i] = i == 0 ? p->glR : p->glKT;
            else cbase[i] = i == 0 ? p->rwW : (i == 1 ? p->rwR : (i == 2 ? p->rwKT : (i == 3 ? p->rwBT : p->rwM)));
            cstride[i] = 4096; soff[i] = row * 64 + cc * 8; doff[i] = i * 9216 + row * 144 + cc * 16;
        }
    }
    const bf16_t* bUT = TYPE == 0 ? p->dnUT : p->rwUT;
    const bf16_t* bO1 = TYPE == 0 ? p->dnO1 : (TYPE == 1 ? p->glO1 : p->rwO1);
    const bf16_t* bVT = TYPE == 0 ? p->dnVT : (TYPE == 1 ? p->glVT : p->rwVT);
    const float* bpc = TYPE == 0 ? p->dnpc : (TYPE == 1 ? p->glpc : p->rwpc);
    const float* bav = p->dnav;
    float* oraw = p->oraw;
    const int ocol = (TYPE == 0 ? 0 : (TYPE == 1 ? 512 : 1024)) + h * DV + slice * 16 + 4 * q;
    const size_t item0 = (size_t)(s * H + h) * 32;
    u32x4 cr[NCP];
    u32x2 ut[4], o1[4], vtd[4]; u32x4 vtb[2]; f32x4 pcv[4]; float pcs = 1.f; f32x4 avv[4];
    auto load_priv_a = [&](size_t item) {
        if (!active) return;
        if (TYPE != 1) {
#pragma unroll
            for (int mt = 0; mt < 4; ++mt) ut[mt] = *(const u32x2*)(bUT + item * (64 * DV) + (slice * 16 + c) * 64 + mt * 16 + 4 * q);
        }
#pragma unroll
        for (int mt = 0; mt < 4; ++mt) o1[mt] = *(const u32x2*)(bO1 + item * (64 * DV) + (mt * 16 + c) * DV + slice * 16 + 4 * q);
    };
    auto load_priv_b = [&](size_t item) {
        if (!active) return;
        if (TYPE == 0) {
#pragma unroll
            for (int mt = 0; mt < 4; ++mt) {
                vtd[mt] = *(const u32x2*)(bVT + item * (64 * DV) + (slice * 16 + c) * 64 + (mt >> 1) * 32 + 8 * q + (mt & 1) * 4);
            }
        } else {
            vtb[0] = *(const u32x4*)(bVT + item * (64 * DV) + (slice * 16 + c) * 64 + 8 * q);
            vtb[1] = *(const u32x4*)(bVT + item * (64 * DV) + (slice * 16 + c) * 64 + 32 + 8 * q);
        }
        if (TYPE == 0) pcs = bpc[item * DK];
        else {
#pragma unroll
            for (int dt = 0; dt < 4; ++dt) pcv[dt] = *(const f32x4*)(bpc + item * DK + dt * 16 + 4 * q);
        }
    };
    f32x4 S[NDT];
#pragma unroll
    for (int dt = 0; dt < NDT; ++dt) S[dt] = (f32x4){0.f, 0.f, 0.f, 0.f};
#pragma unroll
    for (int i = 0; i < NCP; ++i) cr[i] = *(const u32x4*)(cbase[i] + item0 * cstride[i] + soff[i]);
#pragma unroll
    for (int i = 0; i < NCP; ++i) *(u32x4*)(smem + doff[i]) = cr[i];
    load_priv_a(item0); load_priv_b(item0);
    __syncthreads();
    for (int ch = 0; ch < 32; ++ch) {
        const unsigned char* lb = smem + (ch & 1) * C::BUFB;
        if (ch + 1 < 32) {
#pragma unroll
            for (int i = 0; i < NCP; ++i) cr[i] = *(const u32x4*)(cbase[i] + (item0 + ch + 1) * cstride[i] + soff[i]);
        }
        if (active) {
            bf16x8 Sb[NKS];
#pragma unroll
            for (int ks = 0; ks < NKS; ++ks) Sb[ks] = pack8(S[2 * ks], S[2 * ks + 1]);
            f32x4 X[4]; bf16x8 Xb[2];
            if (TYPE != 1) {
#pragma unroll
                for (int mt = 0; mt < 4; ++mt) X[mt] = (f32x4){0.f, 0.f, 0.f, 0.f};
#pragma unroll
                for (int ks = 0; ks < NKS; ++ks) {
                    bf16x8 fr[4];
#pragma unroll
                    for (int mt = 0; mt < 4; ++mt) fr[mt] = *(const bf16x8*)(lb + C::OFF_W + (mt * 16 + c) * SW + ks * 64 + 16 * q);
#pragma unroll
                    for (int mt = 0; mt < 4; ++mt) X[mt] = MFMA16(fr[mt], Sb[ks], X[mt]);
                }
#pragma unroll
                for (int mt = 0; mt < 4; ++mt) X[mt] = X[mt] + unpack4(ut[mt]);
                Xb[0] = pack8(X[0], X[1]); Xb[1] = pack8(X[2], X[3]);
            }
            {
                f32x4 O[4];
#pragma unroll
                for (int mt = 0; mt < 4; ++mt) O[mt] = (f32x4){0.f, 0.f, 0.f, 0.f};
#pragma unroll
                for (int ks = 0; ks < NKS; ++ks) {
                    bf16x8 fr[4];
#pragma unroll
                    for (int mt = 0; mt < 4; ++mt) fr[mt] = *(const bf16x8*)(lb + C::OFF_R + (mt * 16 + c) * SW + ks * 64 + 16 * q);
#pragma unroll
                    for (int mt = 0; mt < 4; ++mt) O[mt] = MFMA16(Sb[ks], fr[mt], O[mt]);
                }
                if (TYPE != 1) {
#pragma unroll
                    for (int k2 = 0; k2 < 2; ++k2) {
                        bf16x8 fr[4];
#pragma unroll
                        for (int mt = 0; mt < 4; ++mt) fr[mt] = *(const bf16x8*)(lb + C::OFF_M + (mt * 16 + c) * 144 + k2 * 64 + 16 * q);
#pragma unroll
                        for (int mt = 0; mt < 4; ++mt) O[mt] = MFMA16(Xb[k2], fr[mt], O[mt]);
                    }
                }
#pragma unroll
                for (int mt = 0; mt < 4; ++mt) {
                    O[mt] = O[mt] + unpack4(o1[mt]);
                    *(f32x4*)(oraw + (size_t)(s * 2048 + ch * 64 + mt * 16 + c) * 1536 + ocol) = O[mt];
                }
            }
            if (ch + 1 < 32) load_priv_a(item0 + ch + 1);
            bf16x8 Vb[2];
            if (TYPE == 0) {
                f32x4 Vn[4];
#pragma unroll
                for (int mt = 0; mt < 4; ++mt) Vn[mt] = unpack4(vtd[mt]) - X[mt];
                Vb[0] = pack8(Vn[0], Vn[1]); Vb[1] = pack8(Vn[2], Vn[3]);
            } else {
                Vb[0] = __builtin_bit_cast(bf16x8, vtb[0]); Vb[1] = __builtin_bit_cast(bf16x8, vtb[1]);
            }
#pragma unroll
            for (int dt = 0; dt < NDT; ++dt) { if (TYPE == 0) S[dt] = S[dt] * pcs; else S[dt] = S[dt] * pcv[dt & 3]; }
#pragma unroll
            for (int k2 = 0; k2 < 2; ++k2) {
#pragma unroll
                for (int d4 = 0; d4 < NDT; d4 += 4) {
                    bf16x8 fr[4];
#pragma unroll
                    for (int j = 0; j < 4; ++j) fr[j] = *(const bf16x8*)(lb + C::OFF_KT + ((d4 + j) * 16 + c) * 144 + k2 * 64 + 16 * q);
#pragma unroll
                    for (int j = 0; j < 4; ++j) S[d4 + j] = MFMA16(fr[j], Vb[k2], S[d4 + j]);
                    if (TYPE == 2) {
#pragma unroll
                        for (int j = 0; j < 4; ++j) fr[j] = *(const bf16x8*)(lb + C::OFF_BT + ((d4 + j) * 16 + c) * 144 + k2 * 64 + 16 * q);
#pragma unroll
                        for (int j = 0; j < 4; ++j) S[d4 + j] = MFMA16(fr[j], Xb[k2], S[d4 + j]);
                    }
                }
            }
            if (ch + 1 < 32) load_priv_b(item0 + ch + 1);
        }
        if (ch + 1 < 32) {
            unsigned char* nb = smem + ((ch + 1) & 1) * C::BUFB;
#pragma unroll
            for (int i = 0; i < NCP; ++i) *(u32x4*)(nb + doff[i]) = cr[i];
        }
        __syncthreads();
    }
    if (!active) return;
    if (TYPE == 2) {
        float* So = p->out + O_PRW + (size_t)((l * 8 + s) * 8 + h) * 4096;
#pragma unroll
        for (int dt = 0; dt < NDT; ++dt) *(f32x4*)(So + (slice * 16 + c) * 64 + dt * 16 + 4 * q) = S[dt];
    } else {
        float* So = p->out + (TYPE == 0 ? O_PDN + (size_t)((l * 8 + s) * 4 + h) * 16384 : O_PGLA + (size_t)((l * 8 + s) * 4 + h) * 8192);
#pragma unroll
        for (int dt = 0; dt < NDT; ++dt)
#pragma unroll
            for (int jj = 0; jj < 4; ++jj) So[(dt * 16 + 4 * q + jj) * 128 + slice * 16 + c] = S[dt][jj];
    }
}

DEVI void phase_scan(KP p_, int l, unsigned char* smem) {
    KP p = launder(p_);
    const int wid = tidx() >> 6, bid = bidx();
    if (bid < 160) {
        if (bid < 64) chunk_seq_block<0>(p, l, bid >> 3, (bid >> 1) & 3, bid & 1, smem);
        else if (bid < 96) chunk_seq_block<1>(p, l, (bid - 64) >> 2, bid & 3, 0, smem);
        else chunk_seq_block<2>(p, l, (bid - 96) >> 3, bid & 7, 0, smem);
    } else {
        float* wl = (float*)smem + wid * 512;
        for (int it = (bid - 160) * 8 + wid; it < 6144; it += (gdim() - 160) * 8) {
            if (it < 2048) dn_scan_item(p, l, 8 + (it >> 4), (it >> 2) & 3, it & 3, wl);
            else if (it < 4096) { const int i = it - 2048; gla_scan_item(p, l, 8 + (i >> 4), (i >> 2) & 3, i & 3, wl); }
            else { const int i = it - 4096; rw_scan_item(p, l, 8 + (i >> 4), (i >> 1) & 7, i & 1, wl); }
        }
    }
}

struct PostRow { f32x2 odn[4], ogl[4]; unsigned zdn[4], zgl[4]; float orw[8], bon[8]; unsigned zrw[8]; };
DEVI void post_load(KP p, int row, int lane, PostRow& R) {
    const float* orow = p->oraw + (size_t)row * 1536;
    const bf16_t* pr = p->proj + (size_t)row * LDP;
#pragma unroll
    for (int h = 0; h < 4; ++h) {
        R.odn[h] = *(const f32x2*)(orow + h * 128 + lane * 2); R.ogl[h] = *(const f32x2*)(orow + 512 + h * 128 + lane * 2);
        R.zdn[h] = *(const unsigned*)(pr + C_DNZ + h * 128 + lane * 2); R.zgl[h] = *(const unsigned*)(pr + C_GZ + h * 128 + lane * 2);
    }
#pragma unroll
    for (int h = 0; h < 8; ++h) { const int c = h * 64 + lane; R.orw[h] = orow[1024 + c]; R.bon[h] = p->rbonus[(size_t)row * 512 + c]; R.zrw[h] = pr[C_RZ + c]; }
}
DEVI void post_compute(KP p, int row, int lane, const PostRow& R, f32x2 gdn, f32x2 ggl, const float (&lnw)[8], const float (&lnb)[8]) {
    bf16_t* ob = p->obf + (size_t)row * 1536;
#pragma unroll
    for (int h = 0; h < 4; ++h) {
        {
            const f32x2 o = R.odn[h];
            const float rs = rsqrtf(wsum(o[0] * o[0] + o[1] * o[1]) * (1.f / 128.f) + 1e-6f);
            const float z0 = __uint_as_float(R.zdn[h] << 16), z1 = __uint_as_float(R.zdn[h] & 0xffff0000u);
            ushort2 w; w.x = f2bf(o[0] * rs * gdn[0] * siluf(z0)); w.y = f2bf(o[1] * rs * gdn[1] * siluf(z1));
            *(ushort2*)(ob + h * 128 + lane * 2) = w;
        }
        {
            const f32x2 o = R.ogl[h];
            const float rs = rsqrtf(wsum(o[0] * o[0] + o[1] * o[1]) * (1.f / 128.f) + 1e-6f);
            const float z0 = __uint_as_float(R.zgl[h] << 16), z1 = __uint_as_float(R.zgl[h] & 0xffff0000u);
            ushort2 w; w.x = f2bf(o[0] * rs * ggl[0] * siluf(z0)); w.y = f2bf(o[1] * rs * ggl[1] * siluf(z1));
            *(ushort2*)(ob + 512 + h * 128 + lane * 2) = w;
        }
    }
#pragma unroll
    for (int h = 0; h < 8; ++h) {
        const int c = h * 64 + lane;
        const float o = R.orw[h];
        const float mu = wsum(o) * (1.f / 64.f);
        const float d = o - mu;
        const float var = wsum(d * d) * (1.f / 64.f);
        float y = d * rsqrtf(var + 64e-5f) * lnw[h] + lnb[h];
        y += R.bon[h];
        y *= siluf(__uint_as_float(R.zrw[h] << 16));
        ob[1024 + c] = f2bf(y);
    }
}
DEVI void phase_post(KP p_, int l) {
    KP p = launder(p_);
    const int lane = tidx() & 63, wid = tidx() >> 6;
    const f32x2 gdn = *(const f32x2*)(p->dn_norm_g + l * 128 + lane * 2), ggl = *(const f32x2*)(p->gla_norm_g + l * 128 + lane * 2);
    float lnw[8], lnb[8];
#pragma unroll
    for (int h = 0; h < 8; ++h) { lnw[h] = p->rw_ln_w[l * 512 + h * 64 + lane]; lnb[h] = p->rw_ln_b[l * 512 + h * 64 + lane]; }
    const int stride = gdim() * 8;
    int row = bidx() * 8 + wid;
    PostRow A, B;
    post_load(p, row < NR ? row : NR - 1, lane, A);
    while (row < NR) {
        const int rowB = row + stride;
        post_load(p, rowB < NR ? rowB : NR - 1, lane, B);
        post_compute(p, row, lane, A, gdn, ggl, lnw, lnb);
        if (rowB >= NR) break;
        const int rowC = rowB + stride;
        post_load(p, rowC < NR ? rowC : NR - 1, lane, A);
        post_compute(p, rowB, lane, B, gdn, ggl, lnw, lnb);
        row = rowC;
    }
}

DEVI void phase_final(KP p_) {
    KP p = launder(p_);
    const int lane = tidx() & 63, wid = tidx() >> 6;
    for (int row = bidx() * 8 + wid; row < NR; row += gdim() * 8) {
        const float4* xr = (const float4*)(p->x + (size_t)row * 1024);
        float4 v[4], g[4]; float ss = 0.f;
#pragma unroll
        for (int i = 0; i < 4; ++i) { v[i] = xr[lane + i * 64]; g[i] = ((const float4*)p->final_g)[lane + i * 64]; }
#pragma unroll
        for (int i = 0; i < 4; ++i) ss += v[i].x * v[i].x + v[i].y * v[i].y + v[i].z * v[i].z + v[i].w * v[i].w;
        ss = wsum(ss);
        const float rstd = rsqrtf(ss * (1.f / 1024.f) + 1e-6f);
        float4* yo = (float4*)(p->out + (size_t)row * 1024);
#pragma unroll
        for (int i = 0; i < 4; ++i)
            yo[lane + i * 64] = make_float4(v[i].x * rstd * g[i].x, v[i].y * rstd * g[i].y, v[i].z * rstd * g[i].z, v[i].w * rstd * g[i].w);
    }
}

constexpr int SMEM_BYTES = PP_BYTES;
#define XB_TMO      128
#define XB_XCNT(j)  (256  + 64 * (j))
#define XB_XSUB(j)  (1280 + 64 * (j))
#define XB_XGEN(j)  (2304 + 64 * (j))
#define XB_TOP      3328
#define XB_TOPGEN   3392
#define XCD_BAR_WORDS 3456
#define XB_SPIN_CAP (1u << 18)
#ifndef LAS
#define LAS __attribute__((address_space(3)))
#endif

__device__ __forceinline__ unsigned xb_ld(unsigned* p)              { return __hip_atomic_load(p, __ATOMIC_RELAXED, __HIP_MEMORY_SCOPE_AGENT); }
__device__ __forceinline__ unsigned xb_add(unsigned* p, unsigned v) { return __hip_atomic_fetch_add(p, v, __ATOMIC_RELAXED, __HIP_MEMORY_SCOPE_AGENT); }
__device__ __forceinline__ unsigned xb_xcc_id() { return (unsigned)__builtin_amdgcn_s_getreg((3 << 11) | 20) & 0xFu; }
#define XB_SPIN(cond, bar) do { unsigned _sp = 0; while (cond) { __builtin_amdgcn_s_sleep(1); \
    if ((++_sp & 255u) == 0u) { if (xb_ld(&(bar)[XB_TMO])) break; if (_sp > XB_SPIN_CAP) { atomicAdd(&(bar)[XB_TMO], 1u); break; } } } } while (0)

struct XcdBarrier {
    unsigned* bar; unsigned x;
    volatile LAS unsigned* st;
};

__device__ __forceinline__ XcdBarrier xcd_barrier_post(unsigned* bar, volatile LAS unsigned* st) {
    XcdBarrier b; b.bar = bar; b.x = xb_xcc_id(); b.st = st;
    if (threadIdx.x == 0) (void)xb_add(&bar[XB_XCNT(b.x)], 1u);
    return b;
}
__device__ __forceinline__ void xcd_barrier_complete(unsigned* bar, unsigned x, unsigned& nloc, unsigned& nx) {
    const unsigned G = gridDim.x * gridDim.y * gridDim.z;
    unsigned sum, cnt, mine, sp = 0u;
    for (;;) {
        sum = 0u; cnt = 0u; mine = 0u;
#pragma unroll
        for (unsigned j = 0; j < 16; ++j) { const unsigned c = xb_ld(&bar[XB_XCNT(j)]); sum += c; cnt += (c > 0u) ? 1u : 0u; mine = (j == x) ? c : mine; }
        if (sum == G) break;
        __builtin_amdgcn_s_sleep(1);
        if ((++sp & 255u) == 0u) { if (xb_ld(&bar[XB_TMO])) break; if (sp > XB_SPIN_CAP) { atomicAdd(&bar[XB_TMO], 1u); break; } }
    }
    nloc = mine > 0u ? mine : 1u; nx = cnt > 0u ? cnt : 1u;
}

__device__ __forceinline__ void xcd_barrier(const XcdBarrier& b) {
    asm volatile("s_waitcnt vmcnt(0)" ::: "memory");
    __syncthreads();
    if (threadIdx.x == 0) {
        unsigned* bar = b.bar;
        __builtin_amdgcn_s_waitcnt(0);
        unsigned nloc = b.st[0], nx = b.st[1];
        if (nloc == 0u) { xcd_barrier_complete(bar, b.x, nloc, nx); b.st[0] = nloc; b.st[1] = nx; }
        const unsigned old = xb_add(&bar[XB_XSUB(b.x)], 1u);
        const unsigned gen = old / nloc;
        if (old + 1u == (gen + 1u) * nloc) {
            __builtin_amdgcn_fence(__ATOMIC_RELEASE, "agent");
            asm volatile("s_waitcnt vmcnt(0)" ::: "memory");
            const unsigned og = xb_add(&bar[XB_TOP], 1u);
            const unsigned tg = og / nx;
            if (og + 1u == (tg + 1u) * nx) xb_add(&bar[XB_TOPGEN], 1u);
            else XB_SPIN(xb_ld(&bar[XB_TOPGEN]) == tg, bar);
            __builtin_amdgcn_fence(__ATOMIC_ACQUIRE, "agent");
            xb_add(&bar[XB_XGEN(b.x)], 1u);
            asm volatile("s_waitcnt vmcnt(0)" ::: "memory");
        } else {
            XB_SPIN(xb_ld(&bar[XB_XGEN(b.x)]) == gen, bar);
            __builtin_amdgcn_fence(__ATOMIC_ACQUIRE, "agent");
            asm volatile("s_waitcnt vmcnt(0)" ::: "memory");
        }
    }
    __syncthreads();
}


DEVI void run_sub(KP p, int l, int sub, unsigned char* smem) {
    if (sub == 0) phase_norm(p, l);
    else if (sub == 1) {
        KP q = launder(p);
        {
            pg8::Gemm g{q->h, q->WinT + (size_t)l * LDP * 1024, NPR, LDP, 1024}; pg8::StaticOrder S; S.init(NPR, LDP, gdim(), bidx());
            EpiProjPG E{q->proj};
            pg8::gemm_phase<EpiProjPG, pg8::StaticOrder, false>((PG8_LAS unsigned char*)smem, g, S, E, nullptr);
        }
        __syncthreads();
        EpiProj e{q->proj}; gemm_phase(smem, q->h, 1024, q->WinT + (size_t)l * LDP * 1024, 1024, 1, LDP / G_BN, 1024, e, 192, 64);
    }
    else if (sub == 2) { phase_prepass(p, l, smem); phase_prep(p, l, smem); }
    else if (sub == 3) phase_scan(p, l, smem);
    else if (sub == 4) phase_post(p, l);
    else {
        KP q = launder(p);
        {
            pg8::Gemm g{q->obf, q->WoutT + (size_t)l * 1024 * 1536, NPR, 1024, 1536}; pg8::StaticOrder S; S.init(NPR, 1024, gdim(), bidx());
            EpiOutPG E{q->x, l == 0 ? q->x_prompt : q->x, q->mod + (size_t)l * NSEQ * 3072};
            pg8::gemm_phase<EpiOutPG, pg8::StaticOrder, false>((PG8_LAS unsigned char*)smem, g, S, E, nullptr);
        }
        out_gemm_sample(p, l);
    }
}
template <bool kCoop>
__global__ void __launch_bounds__(NT) fwd_kernel(Params p_arg) {
    KP p = (KP)__builtin_amdgcn_kernarg_segment_ptr();
    __shared__ __attribute__((aligned(16))) unsigned char smem[SMEM_BYTES];
    if (kCoop) {
        cg::grid_group grid = cg::this_grid();
        volatile LAS unsigned* xbst = (volatile LAS unsigned*)(LAS unsigned char*)(smem + SMEM_BYTES - 16);
        if (threadIdx.x < 4) xbst[threadIdx.x] = 0u;
        __syncthreads();
        const XcdBarrier xb = xcd_barrier_post(launder(p)->bar, xbst);
        phase_setup(p, smem);
        xcd_barrier(xb);
        if (launder(p)->p0 == 0x7fffffff) grid.sync();
#pragma unroll 1
        for (int l = 0; l < 2; ++l) {
            phase_norm(p, l); xcd_barrier(xb);
            for (int rep = 0; rep < REP_GEMM; ++rep) { run_sub(p, l, 1, smem); xcd_barrier(xb); }
            for (int rep = 0; rep < REP_PRE; ++rep) { phase_prepass(p, l, smem); phase_prep(p, l, smem); xcd_barrier(xb); }
            for (int rep = 0; rep < REP_SCAN; ++rep) { phase_scan(p, l, smem); xcd_barrier(xb); }
            phase_post(p, l); xcd_barrier(xb);
            run_sub(p, l, 5, smem); xcd_barrier(xb);
        }
        phase_final(p);
    } else {
        const int ph = launder(p)->p0;
        if (ph == 0) phase_setup(p, smem);
        else if (ph == 13) phase_final(p);
        else run_sub(p, (ph - 1) / 6, (ph - 1) % 6, smem);
    }
}

extern "C" void kernel_launch(void* const* d_in, const int* in_sizes, int n_in, void* d_out, int out_size, void* d_ws, size_t ws_size, hipStream_t stream) {
    Params hp{};
    const float** pf = (const float**)&hp;
    for (int i = 0; i < 32; ++i) pf[i] = (const float*)d_in[i];
    hp.out = (float*)d_out;
    char* w = (char*)d_ws;
    auto take = [&](size_t bytes) { char* r = w; w += (bytes + 255) & ~(size_t)255; return r; };
    hp.WinT = (bf16_t*)take((size_t)2 * LDP * 1024 * 2);
    hp.WoutT = (bf16_t*)take((size_t)2 * 1024 * 1536 * 2);
    hp.h = (bf16_t*)take((size_t)NRP * 1024 * 2);
    hp.proj = (bf16_t*)take((size_t)NRP * LDP * 2);
    hp.obf = (bf16_t*)take((size_t)NRP * 1536 * 2);
    hp.mod = (float*)take((size_t)2 * NSEQ * 3072 * 4);
    hp.x = (float*)d_out;
    const size_t soff = (size_t)NPR;
    hp.dnq = (float*)take((size_t)128 * 512 * 4) - soff * 512;
    hp.dnk = (float*)take((size_t)128 * 512 * 4) - soff * 512;
    hp.dnv = (float*)take((size_t)128 * 512 * 4) - soff * 512;
    hp.dnbeta = (float*)take((size_t)128 * 4 * 4) - soff * 4;
    hp.dna = (float*)take((size_t)128 * 4 * 4) - soff * 4;
    hp.glf = (float*)take((size_t)128 * 256 * 4) - soff * 256;
    hp.rr = (float*)take((size_t)128 * 512 * 4) - soff * 512;
    hp.rk = (float*)take((size_t)128 * 512 * 4) - soff * 512;
    hp.rv = (float*)take((size_t)128 * 512 * 4) - soff * 512;
    hp.rw = (float*)take((size_t)128 * 512 * 4) - soff * 512;
    hp.rkk = (float*)take((size_t)128 * 512 * 4) - soff * 512;
    hp.rb = (float*)take((size_t)128 * 512 * 4) - soff * 512;
    hp.rbonus = (float*)take((size_t)NR * 512 * 4);
    hp.oraw = (float*)take((size_t)NR * 1536 * 4);
    hp.dnW = (bf16_t*)take((size_t)1024 * 8192 * 2); hp.dnR = (bf16_t*)take((size_t)1024 * 8192 * 2); hp.dnKT = (bf16_t*)take((size_t)1024 * 8192 * 2);
    hp.dnM = (bf16_t*)take((size_t)1024 * 4096 * 2); hp.dnUT = (bf16_t*)take((size_t)1024 * 8192 * 2); hp.dnO1 = (bf16_t*)take((size_t)1024 * 8192 * 2);
    hp.dnVT = (bf16_t*)take((size_t)1024 * 8192 * 2);
    hp.rwW = (bf16_t*)take((size_t)2048 * 4096 * 2); hp.rwR = (bf16_t*)take((size_t)2048 * 4096 * 2); hp.rwKT = (bf16_t*)take((size_t)2048 * 4096 * 2);
    hp.rwBT = (bf16_t*)take((size_t)2048 * 4096 * 2); hp.rwM = (bf16_t*)take((size_t)2048 * 4096 * 2); hp.rwUT = (bf16_t*)take((size_t)2048 * 4096 * 2);
    hp.rwO1 = (bf16_t*)take((size_t)2048 * 4096 * 2); hp.rwVT = (bf16_t*)take((size_t)2048 * 4096 * 2);
    hp.glR = (bf16_t*)take((size_t)1024 * 4096 * 2); hp.glKT = (bf16_t*)take((size_t)1024 * 4096 * 2);
    hp.glO1 = (bf16_t*)take((size_t)1024 * 8192 * 2); hp.glVT = (bf16_t*)take((size_t)1024 * 8192 * 2);
    hp.dnpc = (float*)take((size_t)1024 * 128 * 4); hp.dnav = (float*)take((size_t)1024 * 64 * 4);
    hp.rwpc = (float*)take((size_t)2048 * 64 * 4); hp.glpc = (float*)take((size_t)1024 * 64 * 4);
    hp.bar = (unsigned*)take((size_t)XCD_BAR_WORDS * 4);
    if ((size_t)(w - (char*)d_ws) > ws_size) fprintf(stderr, "workspace too small: need %zu have %zu\n", (size_t)(w - (char*)d_ws), ws_size);
    static int grid_blocks = 0;
    if (!grid_blocks) {
        int dev = 0, cus = 0, per_cu = 0;
        hipGetDevice(&dev);
        hipDeviceGetAttribute(&cus, hipDeviceAttributeMultiprocessorCount, dev);
        hipOccupancyMaxActiveBlocksPerMultiprocessor(&per_cu, fwd_kernel<COOP != 0>, NT, 0);
        if (per_cu < 1) fprintf(stderr, "occupancy query returned %d\n", per_cu);
        grid_blocks = cus;
    }
#if COOP
    hp.p0 = 0; hp.p1 = 14;
    hipMemsetAsync(hp.bar, 0, (size_t)XCD_BAR_WORDS * 4, stream);
    void* args[] = {&hp};
    hipError_t e = hipLaunchCooperativeKernel((void*)fwd_kernel<true>, dim3(grid_blocks), dim3(NT), args, 0, stream);
    if (e != hipSuccess) fprintf(stderr, "cooperative launch failed: %s (grid %d)\n", hipGetErrorString(e), grid_blocks);
#else
    for (int ph = 0; ph < 14; ++ph) {
        hp.p0 = ph; hp.p1 = ph + 1;
        fwd_kernel<false><<<grid_blocks, NT, 0, stream>>>(hp);
    }
#endif
}
```
